# Optimizing an MI355X kernel written in HIP

```python
import math
import jax
import jax.numpy as jnp
from jax import lax
import numpy as np

D_MODEL = 1024
BATCH = 4
SEQ = 8192
DEPTH = 1
DEC_BATCH = 8
DEC_SEQ = 16
PAST_LEN = 4096

CHUNK = 64
Q_BLOCK = 128
NORM_EPS = 1e-6
MIX_WIDTH = D_MODEL
RWKV_WIDTH = MIX_WIDTH // 2
RWKV_HEAD = 64
RWKV_HEADS = RWKV_WIDTH // RWKV_HEAD
W_LORA = 64
A_LORA = 64
G_LORA = 128
RWKV_IN = 3 * RWKV_WIDTH + W_LORA + A_LORA + G_LORA
RW_SPLITS = (RWKV_WIDTH, 2 * RWKV_WIDTH, 3 * RWKV_WIDTH, 3 * RWKV_WIDTH + W_LORA, 3 * RWKV_WIDTH + W_LORA + A_LORA)
GN_EPS = 64e-5
DIFF_WIDTH = MIX_WIDTH - RWKV_WIDTH
DIFF_HEADS = 4
DIFF_HALF = DIFF_WIDTH // DIFF_HEADS // 2
DIFF_KDIM = 2 * DIFF_HALF
DIFF_VDIM = 2 * DIFF_HALF
DIFF_IN = 3 * DIFF_WIDTH
IN_DIM = RWKV_IN + DIFF_IN
ROPE_THETA = 500000.0
ROPE_DIM = DIFF_HALF // 4
D_FF = 2816
FF_CONV = 3

kernel_name = 'hymba_rwkv7_diffattn_convffn_stream_step'


def rms_norm(x, g, eps=NORM_EPS):
    xf = x.astype(jnp.float32)
    y = xf * lax.rsqrt(jnp.mean(xf * xf, axis=-1, keepdims=True) + eps)
    return (y * g.astype(jnp.float32)).astype(x.dtype)


def rope_partial(x, pos):
    half = ROPE_DIM // 2
    inv = ROPE_THETA ** (-jnp.arange(0, ROPE_DIM, 2, dtype=jnp.float32) / ROPE_DIM)
    ang = pos.astype(jnp.float32)[:, None] * inv[None, :]
    cos = jnp.cos(ang)[None, :, None, None, :]
    sin = jnp.sin(ang)[None, :, None, None, :]
    xf = x.astype(jnp.float32)
    x1 = xf[..., :half]
    x2 = xf[..., half:ROPE_DIM]
    out = jnp.concatenate([x1 * cos - x2 * sin, x2 * cos + x1 * sin, xf[..., ROPE_DIM:]], axis=-1)
    return out.astype(x.dtype)


def rwkv7_mix(p, shift_prev, wkv0, lw):
    B, T, _ = p.shape
    H, N = RWKV_HEADS, RWKV_HEAD
    f32 = jnp.float32
    pf = p.astype(f32)
    prev = jnp.concatenate([shift_prev.astype(f32), pf[:, :-1]], axis=1)
    z = pf + (prev - pf) * lw['rw_mu'].astype(f32)
    r, k, v, wl, al, gl = jnp.split(z, RW_SPLITS, axis=-1)
    w_log = -jax.nn.softplus(-(lw['rw_w0'].astype(f32) + jnp.tanh(wl) @ lw['rw_w_w2'].astype(f32))) - 0.5
    decay = jnp.exp(-jnp.exp(w_log))
    a = jax.nn.sigmoid(lw['rw_a0'].astype(f32) + al @ lw['rw_a_w2'].astype(f32))
    g = jax.nn.sigmoid(gl) @ lw['rw_g_w2'].astype(f32)
    kk = (k * lw['rw_k_k'].astype(f32)).reshape(B, T, H, N)
    kk = kk / jnp.maximum(jnp.sqrt(jnp.sum(kk * kk, axis=-1, keepdims=True)), 1e-12)
    k = k * (1.0 + (a - 1.0) * lw['rw_k_a'].astype(f32))
    r, decay, k, v, a = [t.reshape(B, T, H, N) for t in (r, decay, k, v, a)]
    avec = -kk
    bvec = kk * a

    def step(S, inp):
        r_t, w_t, k_t, v_t, a_t, b_t = inp
        sa = jnp.einsum('bhij,bhj->bhi', S, a_t)
        S = S * w_t[:, :, None, :] + sa[..., None] * b_t[:, :, None, :] + v_t[..., None] * k_t[:, :, None, :]
        y_t = jnp.einsum('bhij,bhj->bhi', S, r_t)
        return S, y_t

    xs = tuple(t.transpose(1, 0, 2, 3) for t in (r, decay, k, v, avec, bvec))
    S_T, ys = lax.scan(step, wkv0.astype(f32), xs)
    y = ys.transpose(1, 0, 2, 3)
    mu = jnp.mean(y, axis=-1, keepdims=True)
    var = jnp.mean(jnp.square(y - mu), axis=-1, keepdims=True)
    y = ((y - mu) * lax.rsqrt(var + GN_EPS)).reshape(B, T, RWKV_WIDTH)
    y = y * lw['rw_gn_g'].astype(f32) + lw['rw_gn_b'].astype(f32)
    bonus = jnp.sum(r * k * lw['rw_r_k'].astype(f32), axis=-1, keepdims=True) * v
    y = (y + bonus.reshape(B, T, RWKV_WIDTH)) * g
    return y.astype(p.dtype), S_T, p[:, -1:]


def diff_project(p, pos, lw):
    B, T, _ = p.shape
    q, k, v = jnp.split(p, [DIFF_WIDTH, 2 * DIFF_WIDTH], axis=-1)
    q = q.reshape(B, T, DIFF_HEADS, 2, DIFF_HALF)
    k = k.reshape(B, T, DIFF_HEADS, 2, DIFF_HALF)
    v = v.reshape(B, T, DIFF_HEADS, DIFF_VDIM)
    q = rope_partial(rms_norm(q, lw['df_q_g']), pos)
    k = rope_partial(rms_norm(k, lw['df_k_g']), pos)
    return q, k, v


def diff_attend(q, k, v, q_chunk, k_chunk, lam):
    scale = DIFF_HALF ** -0.5
    s = jnp.einsum('bqhcd,bkhcd->bchqk', q.astype(jnp.float32), k.astype(jnp.float32)) * scale
    mask = k_chunk[None, :] <= q_chunk[:, None]
    s = jnp.where(mask, s, -1e30)
    pr = jax.nn.softmax(s, axis=-1)
    att = pr[:, 0] - lam * pr[:, 1]
    return jnp.einsum('bhqk,bkhd->bqhd', att, v.astype(jnp.float32))


def causal_dwconv(u_pad, w, b):
    T = u_pad.shape[1] - (FF_CONV - 1)
    out = b
    for i in range(FF_CONV):
        out = out + u_pad[:, i:i + T] * w[i]
    return out


def layer_forward(x, pos, past_k, past_v, shift_prev, wkv0, conv_prev, lw, layer_idx):
    B, T, _ = x.shape
    h = rms_norm(x, lw['norm1_g'])
    p = h @ lw['w_in']
    y_rw, wkv_new, shift_new = rwkv7_mix(p[..., :RWKV_IN], shift_prev, wkv0, lw)
    q, k, v = diff_project(p[..., RWKV_IN:], pos, lw)
    lam_init = 0.8 - 0.6 * math.exp(-0.3 * layer_idx)
    f32 = jnp.float32
    lam = (jnp.exp(jnp.sum(lw['df_lq1'].astype(f32) * lw['df_lk1'].astype(f32)))
           - jnp.exp(jnp.sum(lw['df_lq2'].astype(f32) * lw['df_lk2'].astype(f32))) + lam_init)
    q_chunk = pos // CHUNK
    if past_k is None:
        nb = T // Q_BLOCK
        q_blocks = q.reshape(B, nb, Q_BLOCK, DIFF_HEADS, 2, DIFF_HALF).swapaxes(0, 1)
        qc_blocks = q_chunk.reshape(nb, Q_BLOCK)

        def attend_block(args):
            qb, qcb = args
            return diff_attend(qb, k, v, qcb, q_chunk, lam)

        o = lax.map(attend_block, (q_blocks, qc_blocks))
        o = o.swapaxes(0, 1).reshape(B, T, DIFF_HEADS, DIFF_VDIM)
    else:
        P = past_k.shape[1]
        k_all = jnp.concatenate([past_k.reshape(B, P, DIFF_HEADS, 2, DIFF_HALF).astype(k.dtype), k], axis=1)
        v_all = jnp.concatenate([past_v.astype(v.dtype), v], axis=1)
        k_chunk = jnp.concatenate([jnp.arange(P, dtype=jnp.int32) // CHUNK, q_chunk])
        o = diff_attend(q, k_all, v_all, q_chunk, k_chunk, lam)
    o = rms_norm(o, lw['df_subln_g']) * (1.0 - lam_init)
    y_df = o.reshape(B, T, DIFF_WIDTH).astype(x.dtype)
    x = x + jnp.concatenate([y_rw, y_df], axis=-1) @ lw['w_out']
    h2 = rms_norm(x, lw['norm2_g'])
    u = h2 @ lw['w_up']
    u_pad = jnp.concatenate([conv_prev.astype(u.dtype), u], axis=1)
    c = causal_dwconv(u_pad, lw['conv_w'], lw['conv_b'])
    gate, up = jnp.split(c, [D_FF], axis=-1)
    x = x + (jax.nn.silu(gate) * up) @ lw['w_down']
    conv_new = u_pad[:, -(FF_CONV - 1):]
    return x, k.reshape(B, T, DIFF_HEADS, DIFF_KDIM), v, shift_new, wkv_new, conv_new


def setup_inputs(seed: int = 0) -> dict:
    key = jax.random.key(seed)
    ks = list(jax.random.split(key, 40))
    f32 = jnp.float32
    L = DEPTH

    def nrm(shape, s):
        return jax.random.normal(ks.pop(), shape, f32) * s

    def uni(shape, lo, hi):
        return jax.random.uniform(ks.pop(), shape, f32, minval=lo, maxval=hi)

    return {
        'x_prompt': nrm((BATCH, SEQ, D_MODEL), 1.0),
        'x_sample': nrm((DEC_BATCH, DEC_SEQ, D_MODEL), 1.0),
        'cache_k': nrm((L, DEC_BATCH, PAST_LEN, DIFF_HEADS, DIFF_KDIM), 1.0),
        'cache_v': nrm((L, DEC_BATCH, PAST_LEN, DIFF_HEADS, DIFF_VDIM), 1.0),
        'state_shift': nrm((L, DEC_BATCH, 1, RWKV_IN), 1.0),
        'state_wkv': nrm((L, DEC_BATCH, RWKV_HEADS, RWKV_HEAD, RWKV_HEAD), 0.5),
        'state_ffn_conv': nrm((L, DEC_BATCH, FF_CONV - 1, 2 * D_FF), 1.0),
        'norm1_g': 1.0 + nrm((L, D_MODEL), 0.02),
        'w_in': nrm((L, D_MODEL, IN_DIM), D_MODEL ** -0.5),
        'rw_mu': uni((L, RWKV_IN), 0.0, 1.0),
        'rw_w0': uni((L, RWKV_WIDTH), -6.0, 0.0),
        'rw_w_w2': nrm((L, W_LORA, RWKV_WIDTH), 0.1),
        'rw_a0': nrm((L, RWKV_WIDTH), 0.1),
        'rw_a_w2': nrm((L, A_LORA, RWKV_WIDTH), 0.1),
        'rw_g_w2': nrm((L, G_LORA, RWKV_WIDTH), G_LORA ** -0.5),
        'rw_k_k': 0.85 + nrm((L, RWKV_WIDTH), 0.02),
        'rw_k_a': 1.0 + nrm((L, RWKV_WIDTH), 0.02),
        'rw_r_k': nrm((L, RWKV_HEADS, RWKV_HEAD), 0.1),
        'rw_gn_g': 1.0 + nrm((L, RWKV_WIDTH), 0.02),
        'rw_gn_b': nrm((L, RWKV_WIDTH), 0.02),
        'df_q_g': 1.0 + nrm((L, DIFF_HALF), 0.02),
        'df_k_g': 1.0 + nrm((L, DIFF_HALF), 0.02),
        'df_lq1': nrm((L, DIFF_HALF), 0.1),
        'df_lk1': nrm((L, DIFF_HALF), 0.1),
        'df_lq2': nrm((L, DIFF_HALF), 0.1),
        'df_lk2': nrm((L, DIFF_HALF), 0.1),
        'df_subln_g': 1.0 + nrm((L, DIFF_VDIM), 0.02),
        'w_out': nrm((L, MIX_WIDTH, D_MODEL), MIX_WIDTH ** -0.5),
        'norm2_g': 1.0 + nrm((L, D_MODEL), 0.02),
        'w_up': nrm((L, D_MODEL, 2 * D_FF), D_MODEL ** -0.5),
        'conv_w': nrm((L, FF_CONV, 2 * D_FF), 0.5),
        'conv_b': nrm((L, 2 * D_FF), 0.02),
        'w_down': nrm((L, D_FF, D_MODEL), D_FF ** -0.5),
    }


def reference(x_prompt, x_sample, cache_k, cache_v, state_shift, state_wkv, state_ffn_conv,
              norm1_g, w_in, rw_mu, rw_w0, rw_w_w2, rw_a0, rw_a_w2, rw_g_w2, rw_k_k, rw_k_a, rw_r_k,
              rw_gn_g, rw_gn_b, df_q_g, df_k_g, df_lq1, df_lk1, df_lq2, df_lk2, df_subln_g, w_out,
              norm2_g, w_up, conv_w, conv_b, w_down):
    Bp, Tp, _ = x_prompt.shape
    Bs, Ts, _ = x_sample.shape
    P = cache_k.shape[2]
    pos_p = jnp.arange(Tp, dtype=jnp.int32)
    pos_s = P + jnp.arange(Ts, dtype=jnp.int32)
    xp, xs = x_prompt, x_sample
    kp_l, vp_l, shp_l, wkp_l, fcp_l = [], [], [], [], []
    ks_l, vs_l, shs_l, wks_l, fcs_l = [], [], [], [], []
    for l in range(DEPTH):
        lw = {
            'norm1_g': norm1_g[l], 'w_in': w_in[l], 'rw_mu': rw_mu[l], 'rw_w0': rw_w0[l],
            'rw_w_w2': rw_w_w2[l], 'rw_a0': rw_a0[l], 'rw_a_w2': rw_a_w2[l], 'rw_g_w2': rw_g_w2[l],
            'rw_k_k': rw_k_k[l], 'rw_k_a': rw_k_a[l], 'rw_r_k': rw_r_k[l], 'rw_gn_g': rw_gn_g[l],
            'rw_gn_b': rw_gn_b[l], 'df_q_g': df_q_g[l], 'df_k_g': df_k_g[l], 'df_lq1': df_lq1[l],
            'df_lk1': df_lk1[l], 'df_lq2': df_lq2[l], 'df_lk2': df_lk2[l], 'df_subln_g': df_subln_g[l],
            'w_out': w_out[l], 'norm2_g': norm2_g[l], 'w_up': w_up[l], 'conv_w': conv_w[l],
            'conv_b': conv_b[l], 'w_down': w_down[l],
        }
        xp, kp, vp, shp, wkp, fcp = layer_forward(
            xp, pos_p, None, None,
            jnp.zeros((Bp, 1, RWKV_IN), x_prompt.dtype),
            jnp.zeros((Bp, RWKV_HEADS, RWKV_HEAD, RWKV_HEAD), jnp.float32),
            jnp.zeros((Bp, FF_CONV - 1, 2 * D_FF), x_prompt.dtype), lw, l)
        xs, ksn, vsn, shs, wks, fcs = layer_forward(
            xs, pos_s, cache_k[l], cache_v[l], state_shift[l], state_wkv[l], state_ffn_conv[l], lw, l)
        kp_l.append(kp); vp_l.append(vp); shp_l.append(shp); wkp_l.append(wkp); fcp_l.append(fcp)
        ks_l.append(ksn); vs_l.append(vsn); shs_l.append(shs); wks_l.append(wks); fcs_l.append(fcs)
    return (xp, xs,
            jnp.stack(kp_l), jnp.stack(vp_l), jnp.stack(shp_l), jnp.stack(wkp_l), jnp.stack(fcp_l),
            jnp.stack(ks_l), jnp.stack(vs_l), jnp.stack(shs_l), jnp.stack(wks_l), jnp.stack(fcs_l))
```

```cpp
#include <hip/hip_runtime.h>
#include <cstdio>
#include <cstdint>
namespace pg8 {
#define PG8_LAS __attribute__((address_space(3)))
typedef unsigned short bf16_t;
typedef short bf16x8 __attribute__((ext_vector_type(8)));
typedef float f32x4 __attribute__((ext_vector_type(4)));
typedef unsigned u32x4 __attribute__((ext_vector_type(4)));
constexpr int BM = 256, BK = 64, HALF = 128, HTB = HALF * BK * 2  , STAGE_BYTES = 8 * HTB, NXCD = 8, WGM = 8;

__host__ __device__ __forceinline__ int lds_byte(int r, int c) { const int st = (r >> 4) * 2 + (c >> 5), rr = r & 15, cc = c & 31, ob = rr * 64 + cc * 2; return st * 1024 + (ob ^ (((ob >> 9) & 1) << 5)); }
__host__ __device__ __forceinline__ void stage_rc(int b, int& R, int& C) { const int st = b / 1024, sb = b % 1024, swz = sb ^ (((sb >> 9) & 1) << 5); R = (st >> 1) * 16 + swz / 64; C = (st & 1) * 32 + (swz % 64) / 2; }
__host__ __device__ __forceinline__ int perm32(int rho) { const int n = rho >> 4, i = rho & 15; return 8 * (i >> 2) + 4 * n + (i & 3); }

struct Unit { int pm, pn; };
struct Gemm { const bf16_t* A; const bf16_t* Bt; int M, N, K; };

struct StaticOrder {
    int nM, nN, nwg, G, c;
    __host__ __device__ void init(int M, int N, int G_, int c_) { nM = M / BM; nN = N / BM; nwg = nM * nN; G = G_; c = c_; }
    __host__ __device__ bool next(int i, Unit& u) const {
        const long L = (long)i * G + c; if (L >= nwg) return false;
        int wgid = (int)L; { const int q = nwg / NXCD, r = nwg % NXCD, xcd = wgid % NXCD, off = wgid / NXCD; wgid = (xcd < r ? xcd * (q + 1) : r * (q + 1) + (xcd - r) * q) + off; }
        const int nig = WGM * nN, gid = wgid / nig, fm = gid * WGM, gsz = (nM - fm) < WGM ? (nM - fm) : WGM;
        u.pm = fm + ((wgid % nig) % gsz); u.pn = (wgid % nig) / gsz; return true;
    }
    __device__ __forceinline__ void a_ready(const Unit&) const {}
    __device__ __forceinline__ void done(const Unit&) const {}
};


constexpr int MP = 32768, MS = 128, MV = 32896, MPAD = 33024;
constexpr int RWIN = 1792, DFW = 512, FF = 2816, FF2 = 5632, DM = 1024, INDIM = 3328;
constexpr size_t O_YP = 0, O_YS = 33554432, O_KP = 33685504, O_VP = 50462720, O_SHP = 67239936, O_WKVP = 67247104, O_FCP = 67378176,
                 O_KS = 67423232, O_VS = 67488768, O_SHS = 67554304, O_WKVS = 67568640, O_FCS = 67830784, O_END = 67920896;
constexpr float QK_C2 = 0.125f * 1.4426950408889634f;

typedef float f32x2_c __attribute__((ext_vector_type(2))); typedef __bf16 bf16x2_c __attribute__((ext_vector_type(2)));
__device__ __forceinline__ unsigned cvt_pk_bf16(float lo, float hi) { f32x2_c v = {lo, hi}; bf16x2_c b = __builtin_convertvector(v, bf16x2_c); return __builtin_bit_cast(unsigned, b); }
__device__ __forceinline__ u32x4 pack8(const f32x4& v0, const f32x4& v1) { u32x4 w; w.x = cvt_pk_bf16(v0[0], v0[1]); w.y = cvt_pk_bf16(v0[2], v0[3]); w.z = cvt_pk_bf16(v1[0], v1[1]); w.w = cvt_pk_bf16(v1[2], v1[3]); return w; }

struct EpiInProj {
    static constexpr bool PERM = true, AFTER_DRAIN = false;
    bf16_t* Prw; bf16_t* Qb; bf16_t* Kb; bf16_t* Vb; bf16_t* Qs; bf16_t* Ks; bf16_t* Vs; float* out; const float* qg; const float* kg; const float* ropecs;
    __device__ __forceinline__ void operator()(const f32x4 (&acc)[2][2][4][2], const Unit& u, int wr, int wc, int fr, int fq) const {
        const int pn = u.pn, pm = u.pm; const bool samp = (pm == 128);
        if (pn < 7) {
#pragma unroll
            for (int ai = 0; ai < 2; ++ai) {
                if (samp && ai == 1) continue;
#pragma unroll
                for (int m = 0; m < 4; ++m) {
                    const int r = pm * BM + ai * HALF + wr * 64 + m * 16 + fr;
                    const bool last = samp ? (fr == 15) : ((r & 8191) == 8191);
#pragma unroll
                    for (int bj = 0; bj < 2; ++bj) {
                        const int col = pn * BM + bj * HALF + wc * 32 + 8 * fq;
                        const f32x4 v0 = acc[ai][bj][m][0], v1 = acc[ai][bj][m][1];
                        *(u32x4*)(Prw + (size_t)r * RWIN + col) = pack8(v0, v1);
                        if (last) { float* dst = samp ? out + O_SHS + (size_t)((r - MP) >> 4) * RWIN + col : out + O_SHP + (size_t)(r >> 13) * RWIN + col;
                            *(f32x4*)dst = v0; *(f32x4*)(dst + 4) = v1; }
                    }
                }
            }
            return;
        }
        const int tix = pn - 7, which = tix >> 1, G8 = (tix & 1) * 4 + wc;
        f32x4 gv[2][2];
#pragma unroll
        for (int bj = 0; bj < 2; ++bj)
#pragma unroll
            for (int n = 0; n < 2; ++n) gv[bj][n] = (which < 2) ? *(const f32x4*)((which == 0 ? qg : kg) + 32 * bj + 8 * fq + 4 * n) : (f32x4){1.f, 1.f, 1.f, 1.f};
#pragma unroll
        for (int ai = 0; ai < 2; ++ai) {
            if (samp && ai == 1) continue;
#pragma unroll
            for (int m = 0; m < 4; ++m) {
                const int r = pm * BM + ai * HALF + wr * 64 + m * 16 + fr;
                const int rs = r - MP;
                const int pos = samp ? (4096 + (rs & 15)) : (r & 8191);
                f32x4 v[2][2];
#pragma unroll
                for (int bj = 0; bj < 2; ++bj)
#pragma unroll
                    for (int n = 0; n < 2; ++n) v[bj][n] = acc[ai][bj][m][n];
                if (which < 2) {
                    float ss = 0.f;
#pragma unroll
                    for (int bj = 0; bj < 2; ++bj)
#pragma unroll
                        for (int n = 0; n < 2; ++n) ss += (v[bj][n][0] * v[bj][n][0] + v[bj][n][1] * v[bj][n][1]) + (v[bj][n][2] * v[bj][n][2] + v[bj][n][3] * v[bj][n][3]);
                    ss += __shfl_xor(ss, 16); ss += __shfl_xor(ss, 32);
                    const float rstd = 1.0f / sqrtf(ss * (1.0f / 64.0f) + 1e-6f);
#pragma unroll
                    for (int bj = 0; bj < 2; ++bj)
#pragma unroll
                        for (int n = 0; n < 2; ++n) v[bj][n] = v[bj][n] * rstd * gv[bj][n];
                    const float* cs = ropecs + (size_t)pos * 16;
#pragma unroll
                    for (int n = 0; n < 2; ++n) {
                        const f32x4 c4 = *(const f32x4*)(cs + 4 * n), s4 = *(const f32x4*)(cs + 8 + 4 * n);
                        f32x4 o = v[0][n];
#pragma unroll
                        for (int e = 0; e < 4; ++e) {
                            const float own = v[0][n][e], oth = __shfl_xor(own, 16);
                            const float r1 = own * c4[e] - oth * s4[e], r2 = own * c4[e] + oth * s4[e];
                            o[e] = (fq == 0) ? r1 : ((fq == 1) ? r2 : own);
                        }
                        v[0][n] = o;
                    }
                }
                if (which == 0) {
                    bf16_t* qrow = samp ? Qs + ((size_t)(rs >> 4) * 256 + (rs & 15)) * DFW : Qb + (size_t)r * DFW;
#pragma unroll
                    for (int bj = 0; bj < 2; ++bj) *(u32x4*)(qrow + 64 * G8 + 32 * bj + 8 * fq) = pack8(v[bj][0] * QK_C2, v[bj][1] * QK_C2);
                } else {
                    bf16_t* brow; float* frow;
                    if (which == 1) { brow = samp ? Ks + ((size_t)(rs >> 4) * 4224 + 4096 + (rs & 15)) * DFW : Kb + (size_t)r * DFW; frow = samp ? out + O_KS + (size_t)rs * DFW : out + O_KP + (size_t)r * DFW; }
                    else            { brow = samp ? Vs + ((size_t)(rs >> 4) * 4224 + 4096 + (rs & 15)) * DFW : Vb + (size_t)r * DFW; frow = samp ? out + O_VS + (size_t)rs * DFW : out + O_VP + (size_t)r * DFW; }
#pragma unroll
                    for (int bj = 0; bj < 2; ++bj) { const int c0 = 64 * G8 + 32 * bj + 8 * fq;
                        *(u32x4*)(brow + c0) = pack8(v[bj][0], v[bj][1]);
                        *(f32x4*)(frow + c0) = v[bj][0]; *(f32x4*)(frow + c0 + 4) = v[bj][1]; }
                }
            }
        }
    }
};

struct EpiResid {
    static constexpr bool PERM = false, AFTER_DRAIN = false;
    const float* xp; const float* xs; float* out;
    __device__ __forceinline__ void operator()(const f32x4 (&acc)[2][2][4][2], const Unit& u, int wr, int wc, int fr, int fq) const {
        const int col0 = u.pn * BM + wc * 32 + 4 * fq;
#pragma unroll
        for (int ai = 0; ai < 2; ++ai)
#pragma unroll
            for (int m = 0; m < 4; ++m) { const int r = u.pm * BM + ai * HALF + wr * 64 + m * 16 + fr;
                if (r < MV) { const float* xr = (r < MP) ? xp + (size_t)r * DM : xs + (size_t)(r - MP) * DM; float* orow = out + (size_t)r * DM;
#pragma unroll
                    for (int bj = 0; bj < 2; ++bj)
#pragma unroll
                        for (int n = 0; n < 2; ++n) { const int c = col0 + bj * HALF + n * 16; *(f32x4*)(orow + c) = *(const f32x4*)(xr + c) + acc[ai][bj][m][n]; } } }
    }
};
struct EpiAccum {
    static constexpr bool PERM = false, AFTER_DRAIN = false;
    float* out;
    __device__ __forceinline__ void operator()(const f32x4 (&acc)[2][2][4][2], const Unit& u, int wr, int wc, int fr, int fq) const {
        const int col0 = u.pn * BM + wc * 32 + 4 * fq;
#pragma unroll
        for (int ai = 0; ai < 2; ++ai)
#pragma unroll
            for (int m = 0; m < 4; ++m) { const int r = u.pm * BM + ai * HALF + wr * 64 + m * 16 + fr;
                if (r < MV) { float* orow = out + (size_t)r * DM;
#pragma unroll
                    for (int bj = 0; bj < 2; ++bj)
#pragma unroll
                        for (int n = 0; n < 2; ++n) { const int c = col0 + bj * HALF + n * 16; *(f32x4*)(orow + c) = *(const f32x4*)(orow + c) + acc[ai][bj][m][n]; } } }
    }
};
struct EpiUp {
    static constexpr bool PERM = true, AFTER_DRAIN = false;
    bf16_t* U; float* out; int row0;
    __device__ __forceinline__ void operator()(const f32x4 (&acc)[2][2][4][2], const Unit& u, int wr, int wc, int fr, int fq) const {
#pragma unroll
        for (int ai = 0; ai < 2; ++ai)
#pragma unroll
            for (int m = 0; m < 4; ++m) { const int rl = u.pm * BM + ai * HALF + wr * 64 + m * 16 + fr, r = row0 + rl;
                if (r >= MV) continue;
                int slot = -1;
                float* dst = nullptr;
                if (r < MP) { const int t = r & 8191; if (t >= 8190) { slot = t - 8190; dst = out + O_FCP + ((size_t)(r >> 13) * 2 + slot) * FF2; } }
                else { const int rs = r - MP, t = rs & 15; if (t >= 14) { slot = t - 14; dst = out + O_FCS + ((size_t)(rs >> 4) * 2 + slot) * FF2; } }
#pragma unroll
                for (int bj = 0; bj < 2; ++bj) { const int cphys = u.pn * BM + bj * HALF + wc * 32 + 8 * fq;
                    const f32x4 v0 = acc[ai][bj][m][0], v1 = acc[ai][bj][m][1];
                    *(u32x4*)(U + (size_t)rl * FF2 + cphys) = pack8(v0, v1);
                    if (slot >= 0) { const int clog = bj * FF + u.pn * HALF + wc * 32 + 8 * fq; *(f32x4*)(dst + clog) = v0; *(f32x4*)(dst + clog + 4) = v1; } }
            }
    }
};
template <class Epi, class Sched, bool ALIGN_EPI = false, bool SP2 = false>
__device__ __forceinline__ void gemm_phase(PG8_LAS unsigned char* lds, const Gemm g, const Sched& S, const Epi& E) {
    const int tid = threadIdx.x, wid = __builtin_amdgcn_readfirstlane(tid >> 6), lane = tid & 63, wr = wid >> 2, wc = wid & 3, fr = lane & 15, fq = lane >> 4;
    const int K = g.K, nt = K / BK;
    unsigned voffA[2], voffB[2];
#pragma unroll
    for (int i = 0; i < 2; ++i) { int R, C; stage_rc(tid * 16 + i * 8192, R, C); const int Rb = Epi::PERM ? ((R & ~31) + perm32(R & 31)) : R;
        voffA[i] = (unsigned)(R * K + C) * 2u; voffB[i] = (unsigned)(Rb * K + C) * 2u; }
    const size_t kstep = (size_t)(BK * 2);
    const size_t hstep = (size_t)HALF * K * 2;
    const size_t tstep = 2 * hstep;
    const unsigned ldsw = (unsigned)wid * 1024u;
    const int aoff = lds_byte(wr * 64 + fr, fq * 8), boff = lds_byte(wc * 32 + fr, fq * 8);
#define PG8_SA(b, h) (((b) * 2 + (h)) * HTB)
#define PG8_SB(b, h) ((4 + (b) * 2 + (h)) * HTB)
#define PG8_STAGE(bufoff, gbase, voff) do { _Pragma("unroll") for (int _i = 0; _i < 2; ++_i) \
        __builtin_amdgcn_global_load_lds((const unsigned*)((const char*)(gbase) + (voff)[_i]), (PG8_LAS unsigned*)(lds + (bufoff) + ldsw + _i * 8192), 16, 0, 0); } while (0)
#define PG8_LDA(dst, b, h) do { _Pragma("unroll") for (int m = 0; m < 4; ++m) _Pragma("unroll") for (int k = 0; k < 2; ++k) dst[m][k] = *(const PG8_LAS bf16x8*)(lds + PG8_SA(b, h) + aoff + m * 2048 + k * 1024); } while (0)
#define PG8_LDB(dst, b, h) do { _Pragma("unroll") for (int n = 0; n < 2; ++n) _Pragma("unroll") for (int k = 0; k < 2; ++k) dst[n][k] = *(const PG8_LAS bf16x8*)(lds + PG8_SB(b, h) + boff + n * 2048 + k * 1024); } while (0)
#define PG8_MMA(ai, bj, At, Bt) do { __builtin_amdgcn_s_setprio(1); _Pragma("unroll") for (int m = 0; m < 4; ++m) _Pragma("unroll") for (int n = 0; n < 2; ++n) _Pragma("unroll") for (int k = 0; k < 2; ++k) \
        acc[ai][bj][m][n] = __builtin_amdgcn_mfma_f32_16x16x32_bf16(Bt[n][k], At[m][k], acc[ai][bj][m][n], 0, 0, 0); __builtin_amdgcn_s_setprio(0); } while (0)
#define PG8_WAIT_V(n) asm volatile("s_waitcnt vmcnt(" #n ")" ::: "memory")
#define PG8_WAIT_L(n) asm volatile("s_waitcnt lgkmcnt(" #n ")" ::: "memory")
#define PG8_BAR __builtin_amdgcn_s_barrier()
#define PG8_SCHED __builtin_amdgcn_sched_barrier(0)
    Unit cur, nxt; int ui = 0;
    if (!S.next(0, cur)) return;
    f32x4 acc[2][2][4][2];
#pragma unroll
    for (int a = 0; a < 2; ++a)
#pragma unroll
        for (int b = 0; b < 2; ++b)
#pragma unroll
            for (int m = 0; m < 4; ++m)
#pragma unroll
                for (int n = 0; n < 2; ++n) acc[a][b][m][n] = (f32x4){0.f, 0.f, 0.f, 0.f};
    bf16x8 At[4][2], B0[2][2], B1[2][2];
    const char* cA = (const char*)g.A + (size_t)cur.pm * tstep; const char* cB = (const char*)g.Bt + (size_t)cur.pn * tstep;
    S.a_ready(cur);
    if constexpr (SP2) {
        PG8_STAGE(PG8_SB(0, 0), cB, voffB); PG8_STAGE(PG8_SB(0, 1), cB + hstep, voffB); PG8_STAGE(PG8_SA(0, 0), cA, voffA); PG8_STAGE(PG8_SA(0, 1), cA + hstep, voffA);
        if (wr == 1) PG8_BAR;
        PG8_WAIT_V(2); PG8_BAR;
        PG8_STAGE(PG8_SB(1, 0), cB + kstep, voffB); PG8_STAGE(PG8_SA(1, 0), cA + kstep, voffA); PG8_STAGE(PG8_SB(1, 1), cB + hstep + kstep, voffB);
        PG8_WAIT_V(6); PG8_BAR;
    } else {
        PG8_STAGE(PG8_SB(0, 0), cB, voffB); PG8_STAGE(PG8_SA(0, 0), cA, voffA); PG8_STAGE(PG8_SB(0, 1), cB + hstep, voffB); PG8_STAGE(PG8_SA(0, 1), cA + hstep, voffA);
        if (wr == 1) PG8_BAR;
        PG8_WAIT_V(4); PG8_BAR;
        PG8_STAGE(PG8_SB(1, 0), cB + kstep, voffB); PG8_STAGE(PG8_SA(1, 0), cA + kstep, voffA); PG8_STAGE(PG8_SB(1, 1), cB + hstep + kstep, voffB);
        PG8_WAIT_V(6); PG8_BAR;
    }
    for (;;) {
        const bool has_next = S.next(ui + 1, nxt);
        const char* nA = has_next ? (const char*)g.A + (size_t)nxt.pm * tstep : cA; const char* nB = has_next ? (const char*)g.Bt + (size_t)nxt.pn * tstep : cB;
        for (int t = 0; t < nt; t += 2) {
            const bool last = (t == nt - 2);
            const char* a1 = cA + (size_t)(t + 1) * kstep;
            const char* a2 = last ? nA : cA + (size_t)(t + 2) * kstep; const char* b2 = last ? nB : cB + (size_t)(t + 2) * kstep;
            const char* a3 = a2 + kstep; const char* b3 = b2 + kstep;
            if (last && has_next) S.a_ready(nxt);
            if constexpr (SP2) {
            PG8_LDB(B0, 0, 0); PG8_LDB(B1, 0, 1); PG8_SCHED; PG8_LDA(At, 0, 0); PG8_STAGE(PG8_SA(1, 1), a1 + hstep, voffA);
            PG8_WAIT_V(8); PG8_WAIT_L(0); PG8_BAR; PG8_MMA(0, 0, At, B0); PG8_MMA(0, 1, At, B1); PG8_BAR; PG8_SCHED;
            PG8_LDA(At, 0, 1); PG8_STAGE(PG8_SB(0, 0), b2, voffB); PG8_STAGE(PG8_SB(0, 1), b2 + hstep, voffB); PG8_STAGE(PG8_SA(0, 0), a2, voffA);
            PG8_WAIT_V(8); PG8_WAIT_L(0); PG8_BAR; PG8_MMA(1, 0, At, B0); PG8_MMA(1, 1, At, B1); PG8_BAR; PG8_SCHED;
            PG8_LDB(B0, 1, 0); PG8_LDB(B1, 1, 1); PG8_SCHED; PG8_LDA(At, 1, 0); PG8_STAGE(PG8_SA(0, 1), a2 + hstep, voffA);
            PG8_WAIT_V(8); PG8_WAIT_L(0); PG8_BAR; PG8_MMA(0, 0, At, B0); PG8_MMA(0, 1, At, B1); PG8_BAR; PG8_SCHED;
            PG8_LDA(At, 1, 1); PG8_STAGE(PG8_SB(1, 0), b3, voffB); PG8_STAGE(PG8_SB(1, 1), b3 + hstep, voffB); PG8_STAGE(PG8_SA(1, 0), a3, voffA);
            PG8_WAIT_V(8); PG8_WAIT_L(0); PG8_BAR; PG8_MMA(1, 0, At, B0); PG8_MMA(1, 1, At, B1); PG8_BAR; PG8_SCHED;
            } else {
            PG8_LDB(B0, 0, 0); PG8_SCHED; PG8_LDA(At, 0, 0); PG8_STAGE(PG8_SA(1, 1), a1 + hstep, voffA);
            PG8_WAIT_L(8); PG8_BAR; PG8_WAIT_L(0); PG8_MMA(0, 0, At, B0); PG8_BAR; PG8_SCHED;
            PG8_LDB(B1, 0, 1); PG8_STAGE(PG8_SB(0, 0), b2, voffB);
            PG8_BAR; PG8_WAIT_L(0); PG8_MMA(0, 1, At, B1); PG8_BAR;
            PG8_LDA(At, 0, 1); PG8_STAGE(PG8_SA(0, 0), a2, voffA);
            PG8_BAR; PG8_WAIT_L(0); PG8_MMA(1, 0, At, B0); PG8_BAR; PG8_SCHED;
            PG8_STAGE(PG8_SB(0, 1), b2 + hstep, voffB);
            PG8_WAIT_V(6); PG8_BAR; PG8_MMA(1, 1, At, B1); PG8_BAR;
            PG8_LDB(B0, 1, 0); PG8_SCHED; PG8_LDA(At, 1, 0); PG8_STAGE(PG8_SA(0, 1), a2 + hstep, voffA);
            PG8_WAIT_L(8); PG8_BAR; PG8_WAIT_L(0); PG8_MMA(0, 0, At, B0); PG8_BAR; PG8_SCHED;
            PG8_LDB(B1, 1, 1); PG8_STAGE(PG8_SB(1, 0), b3, voffB);
            PG8_BAR; PG8_WAIT_L(0); PG8_MMA(0, 1, At, B1); PG8_BAR;
            PG8_LDA(At, 1, 1); PG8_STAGE(PG8_SA(1, 0), a3, voffA);
            PG8_BAR; PG8_WAIT_L(0); PG8_MMA(1, 0, At, B0); PG8_BAR; PG8_SCHED;
            PG8_STAGE(PG8_SB(1, 1), b3 + hstep, voffB);
            PG8_WAIT_V(6); PG8_BAR; PG8_MMA(1, 1, At, B1); PG8_BAR;
            }
        }
        if constexpr (ALIGN_EPI) { if (wr == 0) PG8_BAR; }
        if constexpr (!Epi::AFTER_DRAIN) { E(acc, cur, wr, wc, fr, fq); S.done(cur); }
        if (!has_next) break;
#pragma unroll
        for (int a = 0; a < 2; ++a)
#pragma unroll
            for (int b = 0; b < 2; ++b)
#pragma unroll
                for (int m = 0; m < 4; ++m)
#pragma unroll
                    for (int n = 0; n < 2; ++n) acc[a][b][m][n] = (f32x4){0.f, 0.f, 0.f, 0.f};
        cur = nxt; cA = nA; cB = nB; ++ui;
        if constexpr (ALIGN_EPI) { if (wr == 1) PG8_BAR; }
    }
    PG8_WAIT_V(0);
    if constexpr (!ALIGN_EPI) { if (wr == 0) PG8_BAR; }
    PG8_BAR;
    if constexpr (Epi::AFTER_DRAIN) { E.fused(acc, cur, wr, wc, fr, fq, lds, wid, lane); S.done(cur); }
#undef PG8_SA
#undef PG8_SB
#undef PG8_STAGE
#undef PG8_LDA
#undef PG8_LDB
#undef PG8_MMA
#undef PG8_WAIT_V
#undef PG8_WAIT_L
#undef PG8_BAR
#undef PG8_SCHED
}
}
#include <hip/hip_bf16.h>
#include <cmath>
namespace attn_body {
using bf16=__hip_bfloat16;
using bf16x8=__attribute__((ext_vector_type(8)))short;
using s16x4=__attribute__((ext_vector_type(4)))short;
using f32x16=__attribute__((ext_vector_type(16)))float;
using u32x4=__attribute__((ext_vector_type(4)))unsigned;
constexpr int D=64,DM=512;
constexpr int NW=8,QBLK=32,QB=QBLK*NW,KVBLK=64;
__device__ __forceinline__ int crow(int r,int hi){return (r&3)+8*(r>>2)+4*hi;}
#define SBAR() __builtin_amdgcn_sched_barrier(0)
__device__ __forceinline__ void cmask(f32x16&p0,f32x16&p1,int jb,int wid,int mode){
  const float NEG=-INFINITY; const bool all=(mode==0)?(jb>(wid>>1)):(jb==3); const bool part=(mode==1)&&(jb==2);
  #pragma unroll
  for(int r=0;r<16;++r){ if(all||(part&&r>=8))p0[r]=NEG; if(all||part)p1[r]=NEG; }
}

constexpr int NSLOT=3, SLOTB=8192;
constexpr int LDS_K=0, LDS_V=NSLOT*SLOTB, LDS_WS=2*NSLOT*SLOTB, LDS_OST=LDS_WS+NW*64*4, LDS_BYTES=LDS_OST+NW*4096;
constexpr float C2=0.125f*1.4426950408889634f;
__device__ __forceinline__ void glds16(const void*gsrc,unsigned lds_dst){unsigned keep;
  asm volatile("s_mov_b32 %0, m0\n\ts_mov_b32 m0, %2\n\ts_nop 0\n\tglobal_load_lds_dwordx4 %1, off\n\ts_mov_b32 m0, %0":"=&s"(keep):"v"(gsrc),"s"(lds_dst):"memory");}
__device__ __forceinline__ float max3f(float a,float b,float c){float r;asm("v_max3_f32 %0, %1, %2, %3":"=v"(r):"v"(a),"v"(b),"v"(c));return r;}
__device__ __forceinline__ float max2f(float a,float b){float r;asm("v_max_f32_e32 %0, %1, %2":"=v"(r):"v"(a),"v"(b));return r;}
__device__ __forceinline__ float fadd_s(float a,float b){float r;asm("v_add_f32_e32 %0, %1, %2":"=v"(r):"v"(a),"v"(b));return r;}
__device__ __forceinline__ float fsub_s(float a,float b){float r;asm("v_sub_f32_e32 %0, %1, %2":"=v"(r):"v"(a),"v"(b));return r;}
typedef float f32x2_t __attribute__((ext_vector_type(2))); typedef __bf16 bf16x2_t __attribute__((ext_vector_type(2)));
__device__ __forceinline__ unsigned cvtpk_s(float lo,float hi){f32x2_t v={lo,hi};bf16x2_t b=__builtin_convertvector(v,bf16x2_t);return __builtin_bit_cast(unsigned,b);}
#define WAIT_BAR(N) asm volatile("s_waitcnt vmcnt(" #N ") lgkmcnt(0)\n\ts_barrier":::"memory")

__device__ __forceinline__ void qkt(f32x16&p0,f32x16&p1,const char*Kslot,const bf16x8*qr,const f32x16&negm,int r32,int hi){
  const char*kb=Kslot+hi*1024+r32*16;
  #pragma unroll
  for(int d0=0;d0<4;++d0){
    const bf16x8 b0=*reinterpret_cast<const bf16x8*>(kb+d0*2048);
    const bf16x8 b1=*reinterpret_cast<const bf16x8*>(kb+d0*2048+512);
    if(d0==0){p0=__builtin_amdgcn_mfma_f32_32x32x16_bf16(b0,qr[0],negm,0,0,0);p1=__builtin_amdgcn_mfma_f32_32x32x16_bf16(b1,qr[0],negm,0,0,0);}
    else{p0=__builtin_amdgcn_mfma_f32_32x32x16_bf16(b0,qr[d0],p0,0,0,0);p1=__builtin_amdgcn_mfma_f32_32x32x16_bf16(b1,qr[d0],p1,0,0,0);}}
}
typedef __attribute__((address_space(3))) const char* lds_cptr;
typedef short v4i16_t __attribute__((ext_vector_type(4)));
__device__ __forceinline__ void kload8(bf16x8*kf,lds_cptr kp){
  kf[0]=*(const __attribute__((address_space(3))) bf16x8*)(kp);      kf[1]=*(const __attribute__((address_space(3))) bf16x8*)(kp+512);
  kf[2]=*(const __attribute__((address_space(3))) bf16x8*)(kp+2048); kf[3]=*(const __attribute__((address_space(3))) bf16x8*)(kp+2560);
  kf[4]=*(const __attribute__((address_space(3))) bf16x8*)(kp+4096); kf[5]=*(const __attribute__((address_space(3))) bf16x8*)(kp+4608);
  kf[6]=*(const __attribute__((address_space(3))) bf16x8*)(kp+6144); kf[7]=*(const __attribute__((address_space(3))) bf16x8*)(kp+6656);
}
__device__ __forceinline__ void kload2(bf16x8*kf,lds_cptr kp,int j){ kf[2*j]=*(const __attribute__((address_space(3))) bf16x8*)(kp+j*2048); kf[2*j+1]=*(const __attribute__((address_space(3))) bf16x8*)(kp+j*2048+512); }
__device__ __forceinline__ s16x4 vtr(lds_cptr p){ return __builtin_bit_cast(s16x4,__builtin_amdgcn_ds_read_tr16_b64_v4i16((__attribute__((address_space(3))) v4i16_t*)p)); }
__device__ __forceinline__ float rowmax(const f32x16&p0,const f32x16&p1){
  float a=max3f(p0[0],p0[1],p1[0]),b=max3f(p0[2],p0[3],p1[1]);a=max3f(a,p1[2],p1[3]);
  #pragma unroll
  for(int r=4;r<16;r+=4){a=max3f(a,p0[r],p0[r+1]);b=max3f(b,p0[r+2],p0[r+3]);a=max3f(a,p1[r],p1[r+1]);b=max3f(b,p1[r+2],p1[r+3]);}
  const float m=max2f(a,b);
  auto rr=__builtin_amdgcn_permlane32_swap(__float_as_uint(m),__float_as_uint(m),false,false);
  return max2f(__uint_as_float(rr[0]),__uint_as_float(rr[1]));
}
__device__ __forceinline__ void pv(f32x16*o,int vb,bf16x8 pa0,bf16x8 pa1,bf16x8 pa2,bf16x8 pa3){
  #pragma unroll
  for(int d0=0;d0<2;++d0){s16x4 lo[4],hi[4];
    #pragma unroll
    for(int ks=0;ks<4;++ks){
      asm volatile("ds_read_b64_tr_b16 %0,%1 offset:%c2":"=&v"(lo[ks]):"v"(vb),"i"(d0*4096+ks*1024):"memory");
      asm volatile("ds_read_b64_tr_b16 %0,%1 offset:%c2":"=&v"(hi[ks]):"v"(vb),"i"(d0*4096+ks*1024+512):"memory");}
    asm volatile("s_waitcnt lgkmcnt(0)":::"memory");SBAR();
    #define PK(k) (bf16x8){lo[k][0],lo[k][1],lo[k][2],lo[k][3],hi[k][0],hi[k][1],hi[k][2],hi[k][3]}
    o[d0]=__builtin_amdgcn_mfma_f32_32x32x16_bf16(pa0,PK(0),o[d0],0,0,0);
    o[d0]=__builtin_amdgcn_mfma_f32_32x32x16_bf16(pa1,PK(1),o[d0],0,0,0);
    o[d0]=__builtin_amdgcn_mfma_f32_32x32x16_bf16(pa2,PK(2),o[d0],0,0,0);
    o[d0]=__builtin_amdgcn_mfma_f32_32x32x16_bf16(pa3,PK(3),o[d0],0,0,0);
    #undef PK
  }
}

#ifndef ATTN_STORE16
#define ATTN_STORE16(p,v) (*(u32x4*)(p)=(v))
#endif
template<int THRL> __device__ __forceinline__ void attn_unit(const bf16*Qu,const bf16*__restrict__ Ku,const bf16*__restrict__ Vu,bf16*Ou,const int NT,const int mode,char*shm){
  const int tid=threadIdx.x,lane=tid&63,r32=lane&31,hi=lane>>5; const int wid=__builtin_amdgcn_readfirstlane(tid>>6);
  const bf16*Qw=Qu+(long)(wid*QBLK)*DM;
  const bf16*Kh=Ku,*Vh=Vu;
  const unsigned lds0=(unsigned)(uintptr_t)shm;
  float*wsf=(float*)(shm+LDS_WS)+wid*64;
  const bf16*ksrc=Kh+(long)lane*DM+wid*8;
  const bf16*vsrc=Vh+(long)(16*(wid&3)+(lane>>2))*DM+(wid>>2)*32+(lane&3)*8;
  const unsigned kdst=lds0+LDS_K+wid*1024, vdst=lds0+LDS_V+wid*1024;
  #define DMA_K(t,slot) glds16(ksrc+(long)(t)*KVBLK*DM,(unsigned)__builtin_amdgcn_readfirstlane(kdst+(slot)))
  #define DMA_V(t,slot) glds16(vsrc+(long)(t)*KVBLK*DM,(unsigned)__builtin_amdgcn_readfirstlane(vdst+(slot)))
  const int vb0=(int)(lds0+LDS_V)+((lane>>4)&1)*32+(lane&3)*8+(4*hi+((lane&15)>>2))*64;
  const char*Kbase=shm+LDS_K; bf16x8 kf[8];
  const lds_cptr shm3=(lds_cptr)shm; const lds_cptr kp0=shm3+LDS_K+hi*1024+r32*16; const lds_cptr vp0=shm3+LDS_V+((lane>>4)&1)*32+(lane&3)*8+(4*hi+((lane&15)>>2))*64;
  DMA_K(0,0);DMA_V(0,0);DMA_K(1,SLOTB);
  bf16x8 qr[4];
  #pragma unroll
  for(int d0=0;d0<4;++d0)qr[d0]=*reinterpret_cast<const bf16x8*>(&Qw[(long)r32*DM+d0*16+hi*8]);
  float mhat=0.f,l_reg=0.f;f32x16 o[2];o[0]=f32x16{};o[1]=f32x16{};f32x16 negm=f32x16{};asm volatile("":"+v"(negm));
  const int qrel=wid*QBLK+r32;
  #define CMASK(P0,P1,t) do{int jb_=(t)-(NT-4); if(jb_>=0)cmask(P0,P1,jb_,wid,mode);}while(0)
  bool resc=false;
  #define START(P0,P1) do{ const float rm=rowmax(P0,P1); resc=false; \
    { const float dl=rm; mhat=fadd_s(mhat,dl); \
      _Pragma("unroll") for(int r=0;r<16;++r){P0[r]=fsub_s(P0[r],dl);P1[r]=fsub_s(P1[r],dl);} \
      _Pragma("unroll") for(int r=0;r<16;++r)negm[r]=-mhat; asm volatile("":"+v"(negm)); } \
    _Pragma("unroll") for(int r=0;r<16;++r)P0[r]=__builtin_amdgcn_exp2f(P0[r]); }while(0)
  #define RESC() do{ if(resc){ asm volatile("s_waitcnt lgkmcnt(0)":::"memory"); \
      _Pragma("unroll") for(int d_=0;d_<2;++d_) _Pragma("unroll") for(int r=0;r<16;++r)o[d_][r]*=wsf[crow(r,hi)]; } }while(0)
  f32x16 pA0,pA1,pB0,pB1;
  int sl_prev=0,sl_cur=0,sl_next=SLOTB;
  #define ROT() do{sl_prev=sl_cur;sl_cur=sl_next;sl_next=(sl_next==(NSLOT-1)*SLOTB)?0:sl_next+SLOTB;}while(0)
  DMA_K(2,2*SLOTB);
  WAIT_BAR(3);
  qkt(pA0,pA1,Kbase,qr,negm,r32,hi);asm volatile("s_nop 15\n\ts_nop 7":"+v"(pA0),"+v"(pA1));CMASK(pA0,pA1,0);
  START(pA0,pA1);
  _Pragma("unroll") for(int r=0;r<16;++r)pA1[r]=__builtin_amdgcn_exp2f(pA1[r]);
  WAIT_BAR(0);
  DMA_K(3,0);DMA_V(1,SLOTB);
  ROT();
  kload8(kf,kp0+sl_cur);
  WAIT_BAR(2);
  s16x4 vlo[8],vhi[8]; u32x4 pw0,pw1,pw2,pw3;
  #define PKW(P,B) cvtpk_s(P[B],P[B+1])
  #define PAF(k) __builtin_bit_cast(bf16x8,pw##k)
  #define VFR(i) (bf16x8){vlo[i][0],vlo[i][1],vlo[i][2],vlo[i][3],vhi[i][0],vhi[i][1],vhi[i][2],vhi[i][3]}
  #define PIN(x) asm volatile("":"+v"(x))
  #define MX3(a,b,c) __builtin_fmaxf(__builtin_fmaxf((a),(b)),(c))
  #define GAPA(MF,A0,A1,A2,A3,W0,W1,PW) do{ MF; sacc+=A0; sacc+=A1; sacc+=A2; sacc+=A3; PIN(sacc); W0; W1; PIN(PW); SBAR(); }while(0)
  #define EX(v) __builtin_amdgcn_exp2f(v)
  #define GAPB(MF,X,B) do{ MF; X[B]=EX(X[B]); X[B+1]=EX(X[B+1]); X[B+2]=EX(X[B+2]); X[B+3]=EX(X[B+3]); PIN(X); SBAR(); }while(0)
  #define VRD(i) do{ vlo[i]=vtr(vp_+(((i)>>2)*4096+((i)&3)*1024)); vhi[i]=vtr(vp_+(((i)>>2)*4096+((i)&3)*1024+512)); }while(0)
  #define KRD(G,j) do{ if(G){ kload2(kf,kp0+sl_next,j); SBAR(); } }while(0)
  #define STEP(C0,C1,P0,P1,t,GK,GV,GL) do{ SBAR(); \
    const lds_cptr vp_=vp0+sl_prev; \
    VRD(0); SBAR(); float sacc=(P0[0]+P0[1]); \
    GAPA(C0=__builtin_amdgcn_mfma_f32_32x32x16_bf16(kf[0],qr[0],negm,0,0,0), P0[2],P0[3],P0[4],P0[5],     pw0[0]=PKW(P0,0), pw0[1]=PKW(P0,2), pw0); \
    VRD(4); SBAR(); GAPA(C1=__builtin_amdgcn_mfma_f32_32x32x16_bf16(kf[1],qr[0],negm,0,0,0), P0[6],P0[7],P0[8],P0[9],     pw0[2]=PKW(P0,4), pw0[3]=PKW(P0,6), pw0); \
    VRD(1); SBAR(); GAPA(C0=__builtin_amdgcn_mfma_f32_32x32x16_bf16(kf[2],qr[1],C0,0,0,0),   P0[10],P0[11],P0[12],P0[13], pw1[0]=PKW(P0,8), pw1[1]=PKW(P0,10), pw1); \
    VRD(5); SBAR(); GAPA(C1=__builtin_amdgcn_mfma_f32_32x32x16_bf16(kf[3],qr[1],C1,0,0,0),   P0[14],P0[15],P1[0],P1[1],   pw1[2]=PKW(P0,12),pw1[3]=PKW(P0,14), pw1); \
    VRD(2); SBAR(); GAPA(C0=__builtin_amdgcn_mfma_f32_32x32x16_bf16(kf[4],qr[2],C0,0,0,0),   P1[2],P1[3],P1[4],P1[5],     pw2[0]=PKW(P1,0), pw2[1]=PKW(P1,2), pw2); \
    VRD(6); SBAR(); GAPA(C1=__builtin_amdgcn_mfma_f32_32x32x16_bf16(kf[5],qr[2],C1,0,0,0),   P1[6],P1[7],P1[8],P1[9],     pw2[2]=PKW(P1,4), pw2[3]=PKW(P1,6), pw2); \
    VRD(3); SBAR(); GAPA(C0=__builtin_amdgcn_mfma_f32_32x32x16_bf16(kf[6],qr[3],C0,0,0,0),   P1[10],P1[11],P1[12],P1[13], pw3[0]=PKW(P1,8), pw3[1]=PKW(P1,10), pw3); \
    VRD(7); SBAR(); GAPA(C1=__builtin_amdgcn_mfma_f32_32x32x16_bf16(kf[7],qr[3],C1,0,0,0),   P1[14],P1[15],0.f,0.f,       pw3[2]=PKW(P1,12),pw3[3]=PKW(P1,14), pw3); \
    l_reg+=sacc; \
    if(GK){DMA_K((t)+3,sl_cur);} if(GV){DMA_V((t)+1,sl_next);} \
    CMASK(C0,C1,t); \
    { float a=MX3(C0[0],C0[1],C1[0]),b=MX3(C0[2],C0[3],C1[1]); a=MX3(a,C1[2],C1[3]); \
      _Pragma("unroll") for(int r=4;r<16;r+=4){a=MX3(a,C0[r],C0[r+1]);b=MX3(b,C0[r+2],C0[r+3]);a=MX3(a,C1[r],C1[r+1]);b=MX3(b,C1[r+2],C1[r+3]);} \
      float rm=__builtin_fmaxf(a,b); { auto rr=__builtin_amdgcn_permlane32_swap(__float_as_uint(rm),__float_as_uint(rm),false,false); rm=__builtin_fmaxf(__uint_as_float(rr[0]),__uint_as_float(rr[1])); } \
      resc=false; \
      if(__builtin_expect(__any(rm>(float)THRL),0)){ const float dl=__builtin_fmaxf(rm,0.f); mhat+=dl; \
        _Pragma("unroll") for(int r=0;r<16;++r){C0[r]-=dl;C1[r]-=dl;} \
        _Pragma("unroll") for(int r=0;r<16;++r)negm[r]=-mhat; asm volatile("":"+v"(negm)); \
        const float f=__builtin_amdgcn_exp2f(-dl); l_reg*=f; if(hi==0)wsf[r32]=f; resc=true; } } \
    SBAR(); \
    GAPB(o[0]=__builtin_amdgcn_mfma_f32_32x32x16_bf16(PAF(0),VFR(0),o[0],0,0,0), C0,0); \
    GAPB(o[1]=__builtin_amdgcn_mfma_f32_32x32x16_bf16(PAF(0),VFR(4),o[1],0,0,0), C0,4); \
    KRD(GL,0); GAPB(o[0]=__builtin_amdgcn_mfma_f32_32x32x16_bf16(PAF(1),VFR(1),o[0],0,0,0), C0,8); \
    KRD(GL,1); GAPB(o[1]=__builtin_amdgcn_mfma_f32_32x32x16_bf16(PAF(1),VFR(5),o[1],0,0,0), C0,12); \
    KRD(GL,2); GAPB(o[0]=__builtin_amdgcn_mfma_f32_32x32x16_bf16(PAF(2),VFR(2),o[0],0,0,0), C1,0); \
    KRD(GL,3); GAPB(o[1]=__builtin_amdgcn_mfma_f32_32x32x16_bf16(PAF(2),VFR(6),o[1],0,0,0), C1,4); \
    GAPB(o[0]=__builtin_amdgcn_mfma_f32_32x32x16_bf16(PAF(3),VFR(3),o[0],0,0,0), C1,8); \
    GAPB(o[1]=__builtin_amdgcn_mfma_f32_32x32x16_bf16(PAF(3),VFR(7),o[1],0,0,0), C1,12); \
    }while(0)
  int t=1;
  #undef CMASK
  #define CMASK(P0,P1,t) do{}while(0)
  for(;t+5<NT;t+=2){
    STEP(pB0,pB1,pA0,pA1,t,true,true,true);     WAIT_BAR(2); RESC(); ROT();
    STEP(pA0,pA1,pB0,pB1,t+1,true,true,true);   WAIT_BAR(2); RESC(); ROT();
  }
  #undef CMASK
  #define CMASK(P0,P1,t) do{int jb_=(t)-(NT-4); if(jb_>=0)cmask(P0,P1,jb_,wid,mode);}while(0)
  #define ENDW(tt) do{ if((tt)+3<NT){WAIT_BAR(2);} else if((tt)+2<NT){WAIT_BAR(1);} else {WAIT_BAR(0);} }while(0)
  for(;t+1<NT;t+=2){
    STEP(pB0,pB1,pA0,pA1,t,(t+3<NT),(t+1<NT),(t+1<NT));       ENDW(t);   RESC(); ROT();
    STEP(pA0,pA1,pB0,pB1,t+1,(t+4<NT),(t+2<NT),(t+2<NT));     ENDW(t+1); RESC(); ROT();
  }
  STEP(pB0,pB1,pA0,pA1,NT-1,false,false,false); RESC();
  { float sacc=pB0[0]+pB0[1]; _Pragma("unroll") for(int r=2;r<16;++r)sacc+=pB0[r]; _Pragma("unroll") for(int r=0;r<16;++r)sacc+=pB1[r]; l_reg+=sacc;
    pw0=(u32x4){PKW(pB0,0),PKW(pB0,2),PKW(pB0,4),PKW(pB0,6)};pw1=(u32x4){PKW(pB0,8),PKW(pB0,10),PKW(pB0,12),PKW(pB0,14)};pw2=(u32x4){PKW(pB1,0),PKW(pB1,2),PKW(pB1,4),PKW(pB1,6)};pw3=(u32x4){PKW(pB1,8),PKW(pB1,10),PKW(pB1,12),PKW(pB1,14)};
    SBAR(); pv(o,vb0+sl_cur,PAF(0),PAF(1),PAF(2),PAF(3)); }
  #undef PKW
  #undef PAF
  #undef VFR
  #undef PIN
  #undef MX3
  #undef GAPA
  #undef GAPB
  #undef EX
  #undef VRD
  #undef KRD
  #undef STEP
  #undef ENDW
  {auto rr=__builtin_amdgcn_permlane32_swap(__float_as_uint(l_reg),__float_as_uint(l_reg),false,false);l_reg=__uint_as_float(rr[0])+__uint_as_float(rr[1]);}
  if(hi==0)wsf[32+r32]=l_reg;asm volatile("s_waitcnt lgkmcnt(0)":::"memory");
  float rli[16];
  #pragma unroll
  for(int r=0;r<16;++r)rli[r]=__builtin_amdgcn_rcpf(wsf[32+crow(r,hi)]);
  bf16*Ow=Ou+(long)(wid*QBLK)*DM;
  { bf16*stg=(bf16*)(shm+LDS_OST)+wid*2048;
    #pragma unroll
    for(int r=0;r<16;++r){const int orow=crow(r,hi);
      #pragma unroll
      for(int d0=0;d0<2;++d0)stg[orow*64+d0*32+r32]=__float2bfloat16(o[d0][r]*rli[r]);}
    asm volatile("s_waitcnt lgkmcnt(0)":::"memory");
    #pragma unroll
    for(int i=0;i<4;++i){const int row=i*8+(lane>>3),ch=lane&7; const u32x4 v=*(const u32x4*)(stg+row*64+ch*8); ATTN_STORE16(Ow+(long)row*DM+ch*8,v);} }
  asm volatile("s_waitcnt lgkmcnt(0)\n\ts_barrier":::"memory");
  #undef DMA_K
  #undef DMA_V
  #undef CMASK
  #undef START
  #undef RESC
  #undef ROT
}
constexpr int ATTN_LDS_BYTES=LDS_BYTES;

#undef SBAR
#undef WAIT_BAR
}
#define GAS __attribute__((address_space(1)))
#define LAS __attribute__((address_space(3)))
typedef unsigned short bf16;
typedef unsigned v4u __attribute__((ext_vector_type(4)));
typedef float f32x4 __attribute__((ext_vector_type(4)));
typedef short bf16x8 __attribute__((ext_vector_type(8)));
typedef GAS unsigned gu32;
typedef GAS unsigned long long gu64;
#define RLX_AGENT __ATOMIC_RELAXED, __HIP_MEMORY_SCOPE_AGENT
#define LDS_WAIT() asm volatile("s_waitcnt lgkmcnt(0)" ::: "memory")
#define VM_WAIT() asm volatile("s_waitcnt vmcnt(0)" ::: "memory")
__device__ __forceinline__ unsigned long long rt() { return __builtin_amdgcn_s_memrealtime(); }
__device__ __forceinline__ unsigned f2bf(float f) { unsigned u = __builtin_bit_cast(unsigned, f); return (u + 0x7fffu + ((u >> 16) & 1u)) >> 16; }
__device__ __forceinline__ unsigned pk2(float lo, float hi) { return f2bf(lo) | (f2bf(hi) << 16); }

#define XB_TMO      128
#define XB_XCNT(j)  (256  + 64 * (j))
#define XB_XSUB(j)  (1280 + 64 * (j))
#define XB_XGEN(j)  (2304 + 64 * (j))
#define XB_TOP      3328
#define XB_TOPGEN   3392
#define XCD_BAR_WORDS 3456
#define XB_SPIN_CAP (1u << 18)

__device__ __forceinline__ unsigned xb_ld(unsigned* p)              { return __hip_atomic_load(p, __ATOMIC_RELAXED, __HIP_MEMORY_SCOPE_AGENT); }
__device__ __forceinline__ unsigned xb_add(unsigned* p, unsigned v) { return __hip_atomic_fetch_add(p, v, __ATOMIC_RELAXED, __HIP_MEMORY_SCOPE_AGENT); }
__device__ __forceinline__ unsigned xb_xcc_id() { return (unsigned)__builtin_amdgcn_s_getreg((3 << 11) | 20) & 0xFu; }
#define XB_SPIN(cond, bar) do { unsigned _sp = 0; while (cond) { __builtin_amdgcn_s_sleep(1); \
    if ((++_sp & 255u) == 0u) { if (xb_ld(&(bar)[XB_TMO])) break; if (_sp > XB_SPIN_CAP) { atomicAdd(&(bar)[XB_TMO], 1u); break; } } } } while (0)

struct XcdBarrier {
    unsigned* bar; unsigned x;
    volatile LAS unsigned* st;
};

__device__ __forceinline__ XcdBarrier xcd_barrier_post(unsigned* bar, volatile LAS unsigned* st) {
    XcdBarrier b; b.bar = bar; b.x = xb_xcc_id(); b.st = st;
    if (threadIdx.x == 0) (void)xb_add(&bar[XB_XCNT(b.x)], 1u);
    return b;
}
__device__ __forceinline__ void xcd_barrier_complete(unsigned* bar, unsigned x, unsigned& nloc, unsigned& nx) {
    const unsigned G = gridDim.x * gridDim.y * gridDim.z;
    unsigned sum, cnt, mine, sp = 0u;
    for (;;) {
        sum = 0u; cnt = 0u; mine = 0u;
#pragma unroll
        for (unsigned j = 0; j < 16; ++j) { const unsigned c = xb_ld(&bar[XB_XCNT(j)]); sum += c; cnt += (c > 0u) ? 1u : 0u; mine = (j == x) ? c : mine; }
        if (sum == G) break;
        __builtin_amdgcn_s_sleep(1);
        if ((++sp & 255u) == 0u) { if (xb_ld(&bar[XB_TMO])) break; if (sp > XB_SPIN_CAP) { atomicAdd(&bar[XB_TMO], 1u); break; } }
    }
    nloc = mine > 0u ? mine : 1u; nx = cnt > 0u ? cnt : 1u;
}

__device__ __forceinline__ void xcd_barrier(const XcdBarrier& b) {
    asm volatile("s_waitcnt vmcnt(0)" ::: "memory");
    __syncthreads();
    if (threadIdx.x == 0) {
        unsigned* bar = b.bar;
        __builtin_amdgcn_s_waitcnt(0);
        unsigned nloc = b.st[0], nx = b.st[1];
        if (nloc == 0u) { xcd_barrier_complete(bar, b.x, nloc, nx); b.st[0] = nloc; b.st[1] = nx; }
        const unsigned old = xb_add(&bar[XB_XSUB(b.x)], 1u);
        const unsigned gen = old / nloc;
        if (old + 1u == (gen + 1u) * nloc) {
            __builtin_amdgcn_fence(__ATOMIC_RELEASE, "agent");
            asm volatile("s_waitcnt vmcnt(0)" ::: "memory");
            const unsigned og = xb_add(&bar[XB_TOP], 1u);
            const unsigned tg = og / nx;
            if (og + 1u == (tg + 1u) * nx) xb_add(&bar[XB_TOPGEN], 1u);
            else XB_SPIN(xb_ld(&bar[XB_TOPGEN]) == tg, bar);
            __builtin_amdgcn_fence(__ATOMIC_ACQUIRE, "agent");
            xb_add(&bar[XB_XGEN(b.x)], 1u);
            asm volatile("s_waitcnt vmcnt(0)" ::: "memory");
        } else {
            XB_SPIN(xb_ld(&bar[XB_XGEN(b.x)]) == gen, bar);
            __builtin_amdgcn_fence(__ATOMIC_ACQUIRE, "agent");
            asm volatile("s_waitcnt vmcnt(0)" ::: "memory");
        }
    }
    __syncthreads();
}

constexpr int NWAVES = 8;
using pg8::MP; using pg8::MS; using pg8::MV; using pg8::MPAD; using pg8::RWIN; using pg8::DFW; using pg8::FF; using pg8::FF2; using pg8::DM; using pg8::INDIM;
using pg8::O_YP; using pg8::O_YS; using pg8::O_KP; using pg8::O_VP; using pg8::O_SHP; using pg8::O_WKVP; using pg8::O_FCP; using pg8::O_KS; using pg8::O_VS; using pg8::O_SHS; using pg8::O_WKVS; using pg8::O_FCS;
typedef unsigned u32x2 __attribute__((ext_vector_type(2)));
typedef float f32x2 __attribute__((ext_vector_type(2)));

constexpr size_t MiB = 1u << 20;
constexpr size_t WS_CTL = 0, CTL_ZERO_BYTES = 1 * MiB;
constexpr size_t WS_WIN = 2 * MiB, WS_WOUT = 9 * MiB, WS_WUP = 11 * MiB, WS_WDN = 22 * MiB;
constexpr size_t WS_WWT = 28 * MiB, WS_WAT = WS_WWT + 65536, WS_WGT = WS_WAT + 65536;
constexpr size_t WS_ROPE = 28 * MiB + 512 * 1024;
constexpr size_t WS_XN = 30 * MiB;
constexpr size_t WS_PRW = 95 * MiB;
constexpr size_t WS_QB = 208 * MiB, WS_KB = 240 * MiB, WS_VB = 272 * MiB;
constexpr size_t WS_QS = 304 * MiB, WS_KS = 306 * MiB, WS_VS = 339 * MiB;
constexpr size_t WS_MT2 = 372 * MiB;
constexpr size_t WS_END = 512 * MiB;
constexpr int CW_TMO = 0, CW_CODE = 1, CW_BAR = 4096;

constexpr int RING_OFF = 0, RING_BYTES = 131072;
constexpr int LDSCTL_OFF = 143360, MISC_OFF = LDSCTL_OFF + 320;
constexpr int LDS_BYTES = 147456;

struct Frame {
    LAS unsigned char* lds;
    volatile LAS unsigned* MISC;
    gu32* ctl;
    int tid, lane, wave;
    int vcu, G;
    __device__ __forceinline__ const float* inp(int i) const { return ((const float* const __attribute__((address_space(4)))*)__builtin_amdgcn_kernarg_segment_ptr())[i]; }
    float* out;
    unsigned char* ws;
};
enum { I_XP = 0, I_XS, I_CK, I_CV, I_SSH, I_SWKV, I_SFC, I_N1G, I_WIN, I_MU, I_W0, I_WW2, I_A0, I_AW2, I_GW2, I_KK, I_KA, I_RK, I_GNG, I_GNB,
       I_QG, I_KG, I_LQ1, I_LK1, I_LQ2, I_LK2, I_SUBG, I_WOUT, I_N2G, I_WUP, I_CW, I_CB, I_WDN };

__device__ __forceinline__ float wave_sum(float v) {
#pragma unroll
    for (int o = 1; o < 64; o <<= 1) v += __shfl_xor(v, o);
    return v;
}

__device__ __forceinline__ void p0_transpose_item(const float* W, int K, int N, bf16* WT, int k0, int n0_src, int n0_dst, const float* gain, LAS float* scr, int lane) {
#pragma unroll 8
    for (int i = 0; i < 32; ++i) { const int kk = 2 * i + (lane >> 5); float w = W[(size_t)(k0 + kk) * N + n0_src + (lane & 31)]; if (gain) w *= gain[k0 + kk]; scr[kk * 33 + (lane & 31)] = w; }
    LDS_WAIT(); asm volatile("" ::: "memory");
    const int c = lane & 7;
#pragma unroll
    for (int j = 0; j < 4; ++j) { const int n = (lane >> 3) + 8 * j; const LAS float* s = scr + (8 * c) * 33 + n;
        v4u o; o.x = pk2(s[0 * 33], s[1 * 33]); o.y = pk2(s[2 * 33], s[3 * 33]); o.z = pk2(s[4 * 33], s[5 * 33]); o.w = pk2(s[6 * 33], s[7 * 33]);
        *(GAS v4u*)(WT + (size_t)(n0_dst + n) * K + k0 + 8 * c) = o; }
    LDS_WAIT(); asm volatile("" ::: "memory");
}
__device__ __forceinline__ void rms_row_to_bf16(int lane, const float* xrow, bf16* orow) {
    const GAS f32x4* xr = (const GAS f32x4*)xrow + lane;
    f32x4 v[4]; float s = 0.f;
#pragma unroll
    for (int j = 0; j < 4; ++j) { v[j] = xr[64 * j]; s += (v[j].x * v[j].x + v[j].y * v[j].y) + (v[j].z * v[j].z + v[j].w * v[j].w); }
    const float rstd = 1.f / sqrtf(wave_sum(s) * (1.f / 1024.f) + 1e-6f);
    GAS unsigned long long* o8 = (GAS unsigned long long*)orow + lane;
#pragma unroll
    for (int j = 0; j < 4; ++j) o8[64 * j] = (unsigned long long)pk2(v[j].x * rstd, v[j].y * rstd) | ((unsigned long long)pk2(v[j].z * rstd, v[j].w * rstd) << 32);
}
__device__ __forceinline__ void sincos_d(double a, float& sn, float& cs) {
    const double k = __builtin_rint(a * 0.3183098861837907);
    const double r = __builtin_fma(-k, 3.141592653589793, a) - k * 1.2246467991473532e-16;
    const double r2 = r * r;
    double s = -1.0 / 121645100408832000.0;
    s = s * r2 + 1.0 / 355687428096000.0;
    s = s * r2 - 1.0 / 1307674368000.0;
    s = s * r2 + 1.0 / 6227020800.0;
    s = s * r2 - 1.0 / 39916800.0;
    s = s * r2 + 1.0 / 362880.0;
    s = s * r2 - 1.0 / 5040.0;
    s = s * r2 + 1.0 / 120.0;
    s = s * r2 - 1.0 / 6.0;
    s = s * r2 + 1.0; s = s * r;
    double c = -1.0 / 6402373705728000.0;
    c = c * r2 + 1.0 / 20922789888000.0;
    c = c * r2 - 1.0 / 87178291200.0;
    c = c * r2 + 1.0 / 479001600.0;
    c = c * r2 - 1.0 / 3628800.0;
    c = c * r2 + 1.0 / 40320.0;
    c = c * r2 - 1.0 / 720.0;
    c = c * r2 + 1.0 / 24.0;
    c = c * r2 - 0.5;
    c = c * r2 + 1.0;
    const bool odd = (((long long)k) & 1) != 0;
    sn = (float)(odd ? -s : s); cs = (float)(odd ? -c : c);
}
__device__ __forceinline__ void p0_prologue(Frame& F) {
    LAS float* scr = (LAS float*)(F.lds + RING_OFF + F.wave * 16384);
    const int gw = F.vcu * NWAVES + F.wave, NGW = F.G * NWAVES;
    bf16* Win_t = (bf16*)(F.ws + WS_WIN); bf16* Wout_t = (bf16*)(F.ws + WS_WOUT); bf16* Wup_t = (bf16*)(F.ws + WS_WUP); bf16* Wdn_t = (bf16*)(F.ws + WS_WDN);
    constexpr int I_IN = 16 * 104, I_OUT = 16 * 32, I_UP = 16 * 176, I_DN = 44 * 32, NITEMS = I_IN + I_OUT + I_UP + I_DN;
    for (int it = gw; it < NITEMS; it += NGW) {
        int r = it;
        if (r < I_IN) { const int kb = r / 104, nb = r % 104, pn = nb >> 3, pb = nb & 7; const int sb = (pn < 7) ? nb : 8 * pn + 2 * (pb & 3) + (pb >> 2);
            p0_transpose_item(F.inp(I_WIN), 1024, INDIM, Win_t, 64 * kb, 32 * sb, 32 * nb, F.inp(I_N1G), scr, F.lane); continue; } r -= I_IN;
        if (r < I_OUT) { const int kb = r / 32, nb = r % 32; p0_transpose_item(F.inp(I_WOUT), 1024, 1024, Wout_t, 64 * kb, 32 * nb, 32 * nb, nullptr, scr, F.lane); continue; } r -= I_OUT;
        if (r < I_UP) { const int kb = r / 176, nb = r % 176, pn = nb >> 3, pb = nb & 7; const int sb = (pb >> 2) * 88 + 4 * pn + (pb & 3);
            p0_transpose_item(F.inp(I_WUP), 1024, FF2, Wup_t, 64 * kb, 32 * sb, 32 * nb, F.inp(I_N2G), scr, F.lane); continue; } r -= I_UP;
        { const int kb = r / 32, nb = r % 32; p0_transpose_item(F.inp(I_WDN), FF, 1024, Wdn_t, 64 * kb, 32 * nb, 32 * nb, nullptr, scr, F.lane); }
    }
    bf16* XN = (bf16*)(F.ws + WS_XN);
    for (int m = gw; m < MPAD; m += NGW) {
        if (m < MP) rms_row_to_bf16(F.lane, F.inp(I_XP) + (size_t)m * DM, XN + (size_t)m * DM);
        else if (m < MV) rms_row_to_bf16(F.lane, F.inp(I_XS) + (size_t)(m - MP) * DM, XN + (size_t)m * DM);
        else { GAS v4u* o = (GAS v4u*)(XN + (size_t)m * DM) + F.lane; o[0] = (v4u){0u, 0u, 0u, 0u}; o[64] = (v4u){0u, 0u, 0u, 0u}; }
    }
    const int gt = (F.vcu * NWAVES + F.wave) * 64 + F.lane, NGT = NGW * 64;
    {   bf16* Ks = (bf16*)(F.ws + WS_KS); bf16* Vs = (bf16*)(F.ws + WS_VS);
        constexpr int NIT = 8 * 4096 * 64;
        for (int it = gt; it < 2 * NIT; it += NGT) {
            const int w = it >= NIT, i = w ? it - NIT : it; const int rowi = i >> 6, ch = i & 63, b = rowi >> 12, p = rowi & 4095;
            const GAS f32x4* src = (const GAS f32x4*)((w ? F.inp(I_CV) : F.inp(I_CK)) + (size_t)rowi * 512 + ch * 8);
            const f32x4 a = src[0], c = src[1];
            v4u o; o.x = pk2(a.x, a.y); o.y = pk2(a.z, a.w); o.z = pk2(c.x, c.y); o.w = pk2(c.z, c.w);
            *(GAS v4u*)((w ? Vs : Ks) + ((size_t)b * 4224 + p) * 512 + ch * 8) = o;
        }
        constexpr int NZ = 8 * 112 * 64;
        for (int it = gt; it < 2 * NZ; it += NGT) { const int w = it >= NZ, i = w ? it - NZ : it; const int rowi = i >> 6, ch = i & 63, b = rowi / 112, p = 4112 + rowi % 112;
            *(GAS v4u*)((w ? Vs : Ks) + ((size_t)b * 4224 + p) * 512 + ch * 8) = (v4u){0u, 0u, 0u, 0u}; }
        bf16* Qs = (bf16*)(F.ws + WS_QS);
        constexpr int NQ = 8 * 240 * 64;
        for (int it = gt; it < NQ; it += NGT) { const int rowi = it >> 6, ch = it & 63, b = rowi / 240, p = 16 + rowi % 240;
            *(GAS v4u*)(Qs + ((size_t)b * 256 + p) * 512 + ch * 8) = (v4u){0u, 0u, 0u, 0u}; }
    }
    {   bf16* WwT = (bf16*)(F.ws + WS_WWT); bf16* WaT = (bf16*)(F.ws + WS_WAT); bf16* WgT = (bf16*)(F.ws + WS_WGT);
        for (int it = gt; it < 512 * 64; it += NGT) { const int ch = it >> 6, m = it & 63; WwT[it] = (bf16)f2bf(F.inp(I_WW2)[(size_t)m * 512 + ch]); WaT[it] = (bf16)f2bf(F.inp(I_AW2)[(size_t)m * 512 + ch]); }
        for (int it = gt; it < 512 * 128; it += NGT) { const int ch = it >> 7, m = it & 127; WgT[it] = (bf16)f2bf(F.inp(I_GW2)[(size_t)m * 512 + ch]); }
    }
    {   float* cs = (float*)(F.ws + WS_ROPE);
        for (int it = gt; it < 8192 * 8; it += NGT) { const int pos = it >> 3, i = it & 7;
            const double inv = i == 0 ? 1.0 : i == 1 ? 0.19392274474868576 : i == 2 ? 0.03760603093086393 : i == 3 ? 0.007292664737217109 : i == 4 ? 0.001414213562373095 : i == 5 ? 0.0002742481756762073 : i == 6 ? 5.318295896944988e-05 : 1.031338537721246e-05;
            float sn, c; sincos_d((double)pos * inv, sn, c); cs[pos * 16 + i] = c; cs[pos * 16 + 8 + i] = sn; }
    }
}

namespace rw {
constexpr int NUNIT = 4096 + 64;
constexpr int TP = 72, TB = 64 * TP * 2;
constexpr int GP = 136;
constexpr int MD_BYTES = 9216 + 17408;
constexpr size_t WS_QT = 372 * MiB, WS_YL = 409 * MiB, WS_S0 = 442 * MiB;
constexpr size_t WS_G = WS_XN, WS_E1 = WS_XN + (size_t)MPAD * 512 * 2;
constexpr int MISC = 14 * TB;
static_assert(MISC + 2304 <= LDSCTL_OFF, "rwkv LDS map");
static_assert(WS_S0 + (size_t)NUNIT * 9216 <= WS_END && WS_QT + (size_t)NUNIT * 9216 <= WS_YL && WS_YL + (size_t)NUNIT * 8192 <= WS_S0, "rwkv ws map");
static_assert((size_t)NUNIT * MD_BYTES <= (size_t)33554432 * 4, "MD records fit the y_prompt region of d_out");

typedef unsigned short ub16;
#define RW_TILE(i) ((LAS ub16*)(lds + (i) * rw::TB))
__device__ __forceinline__ float sigmoidf_(float x) { return 1.0f / (1.0f + __expf(-x)); }
typedef float f32x2_t __attribute__((ext_vector_type(2))); typedef __bf16 bf16x2_t __attribute__((ext_vector_type(2)));
__device__ __forceinline__ unsigned cvtpk(float lo, float hi) { f32x2_t v = {lo, hi}; bf16x2_t b = __builtin_convertvector(v, bf16x2_t); return __builtin_bit_cast(unsigned, b); }
__device__ __forceinline__ float bflo(unsigned w) { return __uint_as_float(w << 16); }
__device__ __forceinline__ float bfhi(unsigned w) { return __uint_as_float(w & 0xffff0000u); }
__device__ __forceinline__ f32x4 unpack4(u32x2 w) { return (f32x4){bflo(w.x), bfhi(w.x), bflo(w.y), bfhi(w.y)}; }
__device__ __forceinline__ u32x2 pack4(f32x4 v) { u32x2 w; w.x = cvtpk(v[0], v[1]); w.y = cvtpk(v[2], v[3]); return w; }

template <int KS>
__device__ __forceinline__ void mm(f32x4 (&acc)[2], const LAS ub16* A, int lda, const LAS ub16* Bt, int ldb, int mt, int nh, int fr, int fq) {
#pragma unroll
    for (int ks = 0; ks < KS; ++ks) {
        const bf16x8 af = *(const LAS bf16x8*)(A + (16 * mt + fr) * lda + 32 * ks + 8 * fq);
#pragma unroll
        for (int nt = 0; nt < 2; ++nt) {
            const bf16x8 bfr = *(const LAS bf16x8*)(Bt + (32 * nh + 16 * nt + fr) * ldb + 32 * ks + 8 * fq);
            acc[nt] = __builtin_amdgcn_mfma_f32_16x16x32_bf16(bfr, af, acc[nt], 0, 0, 0);
        }
    }
}
#define RW_ZERO(acc) do { acc[0] = (f32x4){0.f, 0.f, 0.f, 0.f}; acc[1] = (f32x4){0.f, 0.f, 0.f, 0.f}; } while (0)
#define RW_BAR() do { asm volatile("s_waitcnt lgkmcnt(0)" ::: "memory"); __syncthreads(); } while (0)
#ifdef DBG_R1CHK
#define RW_CHK(acc, bit) do { bool ok_ = true; _Pragma("unroll") for (int q_ = 0; q_ < 2; ++q_) _Pragma("unroll") for (int e_ = 0; e_ < 4; ++e_) ok_ = ok_ && (fabsf(acc[q_][e_]) < 1e30f); if (!ok_) atomicOr((unsigned*)(F.ctl + 9), (unsigned)(bit)); } while (0)
#else
#define RW_CHK(acc, bit) do {} while (0)
#endif
__device__ __forceinline__ void st_tile(LAS ub16* T, const f32x4 (&acc)[2], int m, int n0) {
#pragma unroll
    for (int nt = 0; nt < 2; ++nt) *(LAS u32x2*)(T + m * TP + n0 + 16 * nt) = pack4(acc[nt]);
}

__device__ __forceinline__ void r1_unit(Frame& F, int u) {
    LAS unsigned char* lds = F.lds;
    const int tid = F.tid, w = F.wave, lane = F.lane, mt = w >> 1, nh = w & 1, fr = lane & 15, fq = lane >> 4;
    const bool samp = u >= 4096; const int us = u - 4096;
    const int sb = samp ? (us >> 3) : (u >> 10), h = samp ? (us & 7) : ((u >> 7) & 7), c = samp ? 0 : (u & 127);
    const int row0 = samp ? (MP + 16 * sb) : (sb * 8192 + 64 * c);
    const ub16* Prw = (const ub16*)(F.ws + WS_PRW);
    const int t = 16 * mt + fr, n0 = 32 * nh + 4 * fq;
    const bool valid = !samp || t < 16;
    const bool hasprev = samp ? (t > 0) : (c > 0 || t > 0);
    f32x4 r_[2], k_[2], v_[2];
    {
        const ub16* pr = Prw + (size_t)(row0 + t) * RWIN + h * 64 + n0;
#pragma unroll
        for (int nt = 0; nt < 2; ++nt) {
#pragma unroll
            for (int x = 0; x < 3; ++x) {
                const int col = x * 512 + h * 64 + n0 + 16 * nt;
                const f32x4 cur = unpack4(*(const GAS u32x2*)(pr + x * 512 + 16 * nt));
                f32x4 prv;
                if (hasprev) prv = unpack4(*(const GAS u32x2*)(pr - RWIN + x * 512 + 16 * nt));
                else if (samp) prv = *(const GAS f32x4*)(F.inp(I_SSH) + (size_t)sb * RWIN + col);
                else prv = (f32x4){0.f, 0.f, 0.f, 0.f};
                const f32x4 mu = *(const GAS f32x4*)(F.inp(I_MU) + col);
                const f32x4 z = cur + (prv - cur) * mu;
                if (x == 0) r_[nt] = z; else if (x == 1) k_[nt] = z; else v_[nt] = z;
            }
        }
    }
    {
        const int tl = tid >> 3, cg = tid & 7;
        const bool hp = samp ? (tl > 0) : (c > 0 || tl > 0);
        const ub16* pr = Prw + (size_t)(row0 + tl) * RWIN + 1536 + 32 * cg;
        LAS ub16* dst = (cg < 2) ? RW_TILE(0) + tl * TP + 32 * cg : (cg < 4) ? RW_TILE(1) + tl * TP + 32 * (cg - 2) : RW_TILE(2) + tl * GP + 32 * (cg - 4);
#pragma unroll
        for (int q = 0; q < 4; ++q) {
            const v4u cw = *(const GAS v4u*)(pr + 8 * q);
            float cur[8] = {bflo(cw.x), bfhi(cw.x), bflo(cw.y), bfhi(cw.y), bflo(cw.z), bfhi(cw.z), bflo(cw.w), bfhi(cw.w)};
            float prv[8];
            if (hp) { const v4u pw = *(const GAS v4u*)(pr - RWIN + 8 * q); prv[0] = bflo(pw.x); prv[1] = bfhi(pw.x); prv[2] = bflo(pw.y); prv[3] = bfhi(pw.y); prv[4] = bflo(pw.z); prv[5] = bfhi(pw.z); prv[6] = bflo(pw.w); prv[7] = bfhi(pw.w); }
            else if (samp) { const f32x4 a = *(const GAS f32x4*)(F.inp(I_SSH) + (size_t)sb * RWIN + 1536 + 32 * cg + 8 * q), b = *(const GAS f32x4*)(F.inp(I_SSH) + (size_t)sb * RWIN + 1536 + 32 * cg + 8 * q + 4);
                prv[0] = a[0]; prv[1] = a[1]; prv[2] = a[2]; prv[3] = a[3]; prv[4] = b[0]; prv[5] = b[1]; prv[6] = b[2]; prv[7] = b[3]; }
            else {
#pragma unroll
                for (int e = 0; e < 8; ++e) prv[e] = 0.f; }
            const f32x4 m0 = *(const GAS f32x4*)(F.inp(I_MU) + 1536 + 32 * cg + 8 * q), m1 = *(const GAS f32x4*)(F.inp(I_MU) + 1536 + 32 * cg + 8 * q + 4);
            float z[8];
#pragma unroll
            for (int e = 0; e < 8; ++e) { const float mu = e < 4 ? m0[e] : m1[e - 4]; z[e] = cur[e] + (prv[e] - cur[e]) * mu;
                if (cg < 2) { const float ex = __expf(2.0f * z[e]); z[e] = 1.0f - 2.0f / (ex + 1.0f); }
                else if (cg >= 4) z[e] = sigmoidf_(z[e]); }
            v4u o; o.x = cvtpk(z[0], z[1]); o.y = cvtpk(z[2], z[3]); o.z = cvtpk(z[4], z[5]); o.w = cvtpk(z[6], z[7]);
            *(LAS v4u*)(dst + 8 * q) = o;
        }
        const int wrow = tid >> 3, wch = tid & 7;
        *(LAS v4u*)(RW_TILE(4) + wrow * TP + 8 * wch) = *(const GAS v4u*)((const ub16*)(F.ws + WS_WWT) + (size_t)(h * 64 + wrow) * 64 + 8 * wch);
        *(LAS v4u*)(RW_TILE(5) + wrow * TP + 8 * wch) = *(const GAS v4u*)((const ub16*)(F.ws + WS_WAT) + (size_t)(h * 64 + wrow) * 64 + 8 * wch);
        *(LAS v4u*)(RW_TILE(6) + wrow * GP + 8 * wch) = *(const GAS v4u*)((const ub16*)(F.ws + WS_WGT) + (size_t)(h * 64 + wrow) * 128 + 8 * wch);
        *(LAS v4u*)(RW_TILE(6) + wrow * GP + 64 + 8 * wch) = *(const GAS v4u*)((const ub16*)(F.ws + WS_WGT) + (size_t)(h * 64 + wrow) * 128 + 64 + 8 * wch);
    }
    RW_BAR();
    f32x4 lwa[2], laa[2], ga[2];
    RW_ZERO(lwa); RW_ZERO(laa); RW_ZERO(ga);
    mm<2>(lwa, RW_TILE(0), TP, RW_TILE(4), TP, mt, nh, fr, fq);
    mm<2>(laa, RW_TILE(1), TP, RW_TILE(5), TP, mt, nh, fr, fq);
    mm<4>(ga, RW_TILE(2), GP, RW_TILE(6), GP, mt, nh, fr, fq);
    LAS float* red = (LAS float*)(lds + MISC); LAS float* tot = red + 256; LAS float* gC = tot + 256;
    f32x4 lw[2], a_[2], kk[2], kp[2], g_[2], L[2];
    float ssq = 0.f, bcs = 0.f;
#pragma unroll
    for (int nt = 0; nt < 2; ++nt) {
        const int hc = h * 64 + n0 + 16 * nt;
        const f32x4 w0 = *(const GAS f32x4*)(F.inp(I_W0) + hc), a0 = *(const GAS f32x4*)(F.inp(I_A0) + hc), kkg = *(const GAS f32x4*)(F.inp(I_KK) + hc), kag = *(const GAS f32x4*)(F.inp(I_KA) + hc), rk = *(const GAS f32x4*)(F.inp(I_RK) + hc);
#pragma unroll
        for (int e = 0; e < 4; ++e) {
            float lwv = -0.6065306597126334f * sigmoidf_(w0[e] + lwa[nt][e]);
            float av = sigmoidf_(a0[e] + laa[nt][e]);
            float kr = k_[nt][e] * kkg[e];
            float kpv = k_[nt][e] * (1.0f + (av - 1.0f) * kag[e]);
            float gv = ga[nt][e];
            if (!valid) { lwv = 0.f; kr = 0.f; kpv = 0.f; gv = 0.f; r_[nt][e] = 0.f; v_[nt][e] = 0.f; }
            lw[nt][e] = lwv; a_[nt][e] = av; kk[nt][e] = kr; kp[nt][e] = kpv; g_[nt][e] = gv;
            ssq += kr * kr; bcs += r_[nt][e] * kpv * rk[e];
            float x = lwv;
#pragma unroll
            for (int d = 1; d < 16; d <<= 1) { const float y = __shfl_up(x, d, 16); if (fr >= d) x += y; }
            L[nt][e] = x;
            if (fr == 15) tot[mt * 64 + n0 + 16 * nt + e] = x;
        }
    }
    ssq += __shfl_xor(ssq, 16); ssq += __shfl_xor(ssq, 32); bcs += __shfl_xor(bcs, 16); bcs += __shfl_xor(bcs, 32);
    if (fq == 0) { red[((mt * 2 + nh) * 16 + fr) * 2] = ssq; red[((mt * 2 + nh) * 16 + fr) * 2 + 1] = bcs; }
    RW_BAR();
    {
        const float ss = red[((mt * 2 + 0) * 16 + fr) * 2] + red[((mt * 2 + 1) * 16 + fr) * 2], bc = red[((mt * 2 + 0) * 16 + fr) * 2 + 1] + red[((mt * 2 + 1) * 16 + fr) * 2 + 1];
        const float rn = 1.0f / fmaxf(sqrtf(ss), 1e-12f);
        ub16* Gb = (ub16*)(F.ws + WS_G); ub16* E1b = (ub16*)(F.ws + WS_E1);
        f32x4 Rq[2];
#pragma unroll
        for (int nt = 0; nt < 2; ++nt) {
            const int ch = n0 + 16 * nt, hc = h * 64 + ch;
            const f32x4 t0 = *(const LAS f32x4*)(tot + ch), t1 = *(const LAS f32x4*)(tot + 64 + ch), t2 = *(const LAS f32x4*)(tot + 128 + ch), t3 = *(const LAS f32x4*)(tot + 192 + ch);
            const f32x4 gng = *(const GAS f32x4*)(F.inp(I_GNG) + hc), gnb = *(const GAS f32x4*)(F.inp(I_GNB) + hc);
            f32x4 Gv, Ev, vAc, vRc, vBc, vKc;
#pragma unroll
            for (int e = 0; e < 4; ++e) {
                const float off = (mt > 0 ? t0[e] : 0.f) + (mt > 1 ? t1[e] : 0.f) + (mt > 2 ? t2[e] : 0.f);
                const float Lt = L[nt][e] + off, Lp = Lt - lw[nt][e], Lmid = t0[e] + t1[e], LC = Lmid + t2[e] + t3[e];
                const float kkn = kk[nt][e] * rn, bv = kkn * a_[nt][e];
                Gv[e] = g_[nt][e] * gng[e]; Ev[e] = (gnb[e] + bc * v_[nt][e]) * g_[nt][e];
                vAc[e] = -kkn * __expf(Lp - Lmid); vRc[e] = r_[nt][e] * __expf(Lt - Lmid);
                const float em = __expf(Lmid - Lt); vBc[e] = bv * em; vKc[e] = kp[nt][e] * em;
                const float ec = __expf(LC - Lt);
                const int chn = ch + e;
                RW_TILE(4)[chn * TP + t] = (ub16)f2bf(-kkn * __expf(Lp));
                RW_TILE(5)[chn * TP + t] = (ub16)f2bf(bv * ec);
                RW_TILE(6)[chn * TP + t] = (ub16)f2bf(kp[nt][e] * ec);
                RW_TILE(7)[chn * TP + t] = (ub16)f2bf(v_[nt][e]);
                Rq[nt][e] = r_[nt][e] * __expf(Lt);
                if (t == 0) gC[chn] = __expf(LC);
            }
#ifdef DBG_R1CHK
            { bool o1 = true, o2 = true, o3 = true, o4 = true, o5 = true, o6 = true;
              for (int e = 0; e < 4; ++e) { o1 = o1 && fabsf(lw[nt][e]) < 1e30f && fabsf(a_[nt][e]) < 1e30f; o2 = o2 && fabsf(L[nt][e]) < 1e30f; o3 = o3 && fabsf(vAc[e]) < 1e30f; o4 = o4 && fabsf(vRc[e]) < 1e30f; o5 = o5 && fabsf(vBc[e]) < 1e30f; o6 = o6 && fabsf(vKc[e]) < 1e30f; }
              unsigned bits = (o1 ? 0u : 0x100u) | (o2 ? 0u : 0x200u) | (o3 ? 0u : 0x400u) | (o4 ? 0u : 0x800u) | (o5 ? 0u : 0x1000u) | (o6 ? 0u : 0x2000u) | ((fabsf(rn) < 1e30f) ? 0u : 0x4000u) | ((fabsf(bc) < 1e30f) ? 0u : 0x8000u);
              if (bits) atomicOr((unsigned*)(F.ctl + 9), bits); }
              { float mx = 0.f; for (int e = 0; e < 4; ++e) mx = fmaxf(mx, fmaxf(fmaxf(fabsf(vAc[e]), fabsf(vBc[e])), fmaxf(fabsf(vRc[e]), fabsf(vKc[e])))); atomicMax((unsigned*)(F.ctl + 10), __float_as_uint(mx)); float ml = 0.f; for (int e = 0; e < 4; ++e) ml = fmaxf(ml, fabsf(L[nt][e] + 0.f)); atomicMax((unsigned*)(F.ctl + 11), __float_as_uint(ml)); }
#endif
            *(LAS u32x2*)(RW_TILE(0) + t * TP + ch) = pack4(vAc); *(LAS u32x2*)(RW_TILE(1) + t * TP + ch) = pack4(vRc);
            *(LAS u32x2*)(RW_TILE(2) + t * TP + ch) = pack4(vBc); *(LAS u32x2*)(RW_TILE(3) + t * TP + ch) = pack4(vKc);
            if (valid) { *(GAS u32x2*)(Gb + (size_t)(row0 + t) * 512 + hc) = pack4(Gv); *(GAS u32x2*)(E1b + (size_t)(row0 + t) * 512 + hc) = pack4(Ev); }
        }
        RW_BAR();
        const int m = 16 * mt + fr;
        f32x4 acc[2];
        {   RW_ZERO(acc); mm<2>(acc, RW_TILE(0), TP, RW_TILE(2), TP, mt, nh, fr, fq);
            f32x4 tv[2];
#pragma unroll
            for (int nt = 0; nt < 2; ++nt)
#pragma unroll
                for (int e = 0; e < 4; ++e) { const int n = n0 + 16 * nt + e; acc[nt][e] = (n < m) ? acc[nt][e] : 0.f; tv[nt][e] = acc[nt][e] + ((n == m) ? 1.0f : 0.f); }
#ifdef DBG_R1CHK
            { float mx = 0.f; for (int q_ = 0; q_ < 2; ++q_) for (int e = 0; e < 4; ++e) mx = fmaxf(mx, fabsf(acc[q_][e])); atomicMax((unsigned*)(F.ctl + 13), __float_as_uint(mx)); }
#endif
            RW_CHK(acc, 1u); st_tile(RW_TILE(8), acc, m, n0); st_tile(RW_TILE(13), tv, m, n0); }
        {   RW_ZERO(acc); mm<2>(acc, RW_TILE(2), TP, RW_TILE(0), TP, mt, nh, fr, fq);
#pragma unroll
            for (int nt = 0; nt < 2; ++nt)
#pragma unroll
                for (int e = 0; e < 4; ++e) { const int n = n0 + 16 * nt + e; acc[nt][e] = (n > m) ? acc[nt][e] : 0.f; }
            st_tile(RW_TILE(9), acc, m, n0); }
        {   RW_ZERO(acc); mm<2>(acc, RW_TILE(0), TP, RW_TILE(3), TP, mt, nh, fr, fq);
#pragma unroll
            for (int nt = 0; nt < 2; ++nt)
#pragma unroll
                for (int e = 0; e < 4; ++e) { const int n = n0 + 16 * nt + e; acc[nt][e] = (n < m) ? acc[nt][e] : 0.f; }
            RW_CHK(acc, 2u); st_tile(RW_TILE(10), acc, m, n0); }
        {   RW_ZERO(acc); mm<2>(acc, RW_TILE(1), TP, RW_TILE(2), TP, mt, nh, fr, fq);
#pragma unroll
            for (int nt = 0; nt < 2; ++nt)
#pragma unroll
                for (int e = 0; e < 4; ++e) { const int n = n0 + 16 * nt + e; acc[nt][e] = (n <= m) ? acc[nt][e] : 0.f; }
            RW_CHK(acc, 4u); st_tile(RW_TILE(11), acc, m, n0); }
        {   RW_ZERO(acc); mm<2>(acc, RW_TILE(1), TP, RW_TILE(3), TP, mt, nh, fr, fq);
#pragma unroll
            for (int nt = 0; nt < 2; ++nt)
#pragma unroll
                for (int e = 0; e < 4; ++e) { const int n = n0 + 16 * nt + e; acc[nt][e] = (n <= m) ? acc[nt][e] : 0.f; }
            RW_CHK(acc, 8u); st_tile(RW_TILE(12), acc, m, n0); }
        RW_BAR();
#ifdef DBG_R1CHK
#define DBG_TMAX(To) do { float mx_ = 0.f; for (int q_ = 0; q_ < 2; ++q_) for (int e_ = 0; e_ < 4; ++e_) { const float a_ = fabsf(acc[q_][e_]); mx_ = fmaxf(mx_, (a_ == a_) ? a_ : 3e38f); } atomicMax((unsigned*)(F.ctl + 14 + dbg_round), __float_as_uint(mx_)); ++dbg_round; } while (0)
        int dbg_round = 0;
#else
#define DBG_TMAX(To) do {} while (0)
#endif
#define RW_ROUND(Pi, PTi, Ti, Po, PTo, To, LAST) do { \
            if (!(LAST)) { RW_ZERO(acc); mm<2>(acc, RW_TILE(Pi), TP, RW_TILE(PTi), TP, mt, nh, fr, fq); st_tile(RW_TILE(Po), acc, m, n0); } \
            RW_ZERO(acc); mm<2>(acc, RW_TILE(PTi), TP, RW_TILE(Pi), TP, mt, nh, fr, fq); st_tile(RW_TILE(PTo), acc, m, n0); \
            RW_BAR(); \
            acc[0] = unpack4(*(const LAS u32x2*)(RW_TILE(Ti) + m * TP + n0)); acc[1] = unpack4(*(const LAS u32x2*)(RW_TILE(Ti) + m * TP + n0 + 16)); \
            mm<2>(acc, RW_TILE(Ti), TP, RW_TILE(PTo), TP, mt, nh, fr, fq); RW_CHK(acc, 16u); DBG_TMAX(To); st_tile(RW_TILE(To), acc, m, n0); \
            RW_BAR(); } while (0)
        RW_ROUND(8, 9, 13, 0, 1, 2, false);
        RW_ROUND(0, 1, 2, 8, 9, 13, false);
        RW_ROUND(8, 9, 13, 0, 1, 2, false);
        RW_ROUND(0, 1, 2, 8, 9, 13, false);
        RW_ROUND(8, 9, 13, 0, 1, 2, true);
#undef RW_ROUND
        RW_ZERO(acc); mm<2>(acc, RW_TILE(4), TP, RW_TILE(2), TP, mt, nh, fr, fq); RW_CHK(acc, 32u); st_tile(RW_TILE(3), acc, m, n0);
        RW_ZERO(acc); mm<2>(acc, RW_TILE(7), TP, RW_TILE(10), TP, mt, nh, fr, fq); RW_CHK(acc, 64u); st_tile(RW_TILE(0), acc, m, n0);
        RW_BAR();
        RW_ZERO(acc); mm<2>(acc, RW_TILE(0), TP, RW_TILE(2), TP, mt, nh, fr, fq); RW_CHK(acc, 128u); st_tile(RW_TILE(8), acc, m, n0);
        RW_BAR();
        unsigned char* md = (unsigned char*)F.out + (size_t)u * MD_BYTES;
        {
            RW_ZERO(acc); mm<2>(acc, RW_TILE(5), TP, RW_TILE(3), TP, mt, nh, fr, fq);
#pragma unroll
            for (int nt = 0; nt < 2; ++nt) {
#pragma unroll
                for (int e = 0; e < 4; ++e) { const int n = n0 + 16 * nt + e; if (n == m) acc[nt][e] += gC[n]; }
                *(GAS u32x2*)((ub16*)md + m * TP + n0 + 16 * nt) = pack4(acc[nt]); } }
        {
            RW_ZERO(acc); mm<2>(acc, RW_TILE(8), TP, RW_TILE(5), TP, mt, nh, fr, fq); mm<2>(acc, RW_TILE(7), TP, RW_TILE(6), TP, mt, nh, fr, fq);
#pragma unroll
            for (int nt = 0; nt < 2; ++nt) *(GAS f32x4*)((float*)(md + 9216) + m * 68 + n0 + 16 * nt) = acc[nt]; }
        {
            acc[0] = Rq[0]; acc[1] = Rq[1]; mm<2>(acc, RW_TILE(11), TP, RW_TILE(3), TP, mt, nh, fr, fq);
            ub16* qt = (ub16*)(F.ws + WS_QT) + (size_t)u * (64 * TP);
#pragma unroll
            for (int nt = 0; nt < 2; ++nt) *(GAS u32x2*)(qt + m * TP + n0 + 16 * nt) = pack4(acc[nt]); }
        {
            RW_ZERO(acc); mm<2>(acc, RW_TILE(11), TP, RW_TILE(8), TP, mt, nh, fr, fq); mm<2>(acc, RW_TILE(12), TP, RW_TILE(7), TP, mt, nh, fr, fq);
            ub16* yl = (ub16*)(F.ws + WS_YL) + (size_t)u * 4096;
#pragma unroll
            for (int nt = 0; nt < 2; ++nt) *(GAS u32x2*)(yl + m * 64 + n0 + 16 * nt) = pack4(acc[nt]); }
        RW_BAR();
    }
}

__device__ __forceinline__ void r2_chain(Frame& F, int chain) {
    LAS unsigned char* lds = F.lds;
    const int tid = F.tid, w = F.wave, lane = F.lane, fr = lane & 15, fq = lane >> 4;
    const bool samp = chain >= 32; const int nsteps = samp ? 1 : 128; const int u0 = samp ? 4096 + (chain - 32) : chain * 128;
    const unsigned char* rec0 = (const unsigned char*)F.out + (size_t)u0 * MD_BYTES;
    constexpr int NPIECE = MD_BYTES / 16;
    v4u q[6][4];
#define R2_LOAD(k, step) do { _Pragma("unroll") for (int i_ = 0; i_ < 4; ++i_) { const int p_ = tid + 512 * i_; if (p_ < NPIECE) q[k][i_] = *(const GAS v4u*)(rec0 + (size_t)(step) * MD_BYTES + 16 * p_); } } while (0)
#pragma unroll
    for (int k = 0; k < 6; ++k) if (k < nsteps) R2_LOAD(k, k);
    f32x4 S[4];
    {   const int cs = chain - 32;
#pragma unroll
        for (int nt = 0; nt < 4; ++nt) S[nt] = (samp && w < 4) ? *(const GAS f32x4*)(F.inp(I_SWKV) + (size_t)cs * 4096 + (16 * w + fr) * 64 + 16 * nt + 4 * fq) : (f32x4){0.f, 0.f, 0.f, 0.f};
    }
    LAS ub16* stg = (LAS ub16*)(lds + 2 * MD_BYTES) + w * (16 * TP);
    ub16* S0b = (ub16*)(F.ws + WS_S0);
#define R2_STEP(k) do { const int c_ = c0 + (k); if (c_ < nsteps) { \
        LAS unsigned char* slot = lds + (c_ & 1) * MD_BYTES; \
        _Pragma("unroll") for (int i_ = 0; i_ < 4; ++i_) { const int p_ = tid + 512 * i_; if (p_ < NPIECE) *(LAS v4u*)(slot + 16 * p_) = q[k][i_]; } \
        if (c_ + 6 < nsteps) R2_LOAD(k, c_ + 6); \
        RW_BAR(); \
        if (w < 4) { \
            ub16* s0 = S0b + (size_t)(u0 + c_) * (64 * TP) + (16 * w + fr) * TP + 4 * fq; \
            _Pragma("unroll") for (int nt = 0; nt < 4; ++nt) { const u32x2 pk = pack4(S[nt]); *(GAS u32x2*)(s0 + 16 * nt) = pk; *(LAS u32x2*)(stg + fr * TP + 16 * nt + 4 * fq) = pk; } \
            asm volatile("s_waitcnt lgkmcnt(0)" ::: "memory"); \
            const bf16x8 sa0 = *(const LAS bf16x8*)(stg + fr * TP + 8 * fq), sa1 = *(const LAS bf16x8*)(stg + fr * TP + 32 + 8 * fq); \
            _Pragma("unroll") for (int nt = 0; nt < 4; ++nt) { \
                f32x4 acc_ = *(const LAS f32x4*)(slot + 9216 + ((16 * w + fr) * 68 + 16 * nt + 4 * fq) * 4); \
                const bf16x8 mb0 = *(const LAS bf16x8*)((LAS ub16*)slot + (16 * nt + fr) * TP + 8 * fq), mb1 = *(const LAS bf16x8*)((LAS ub16*)slot + (16 * nt + fr) * TP + 32 + 8 * fq); \
                acc_ = __builtin_amdgcn_mfma_f32_16x16x32_bf16(mb0, sa0, acc_, 0, 0, 0); acc_ = __builtin_amdgcn_mfma_f32_16x16x32_bf16(mb1, sa1, acc_, 0, 0, 0); S[nt] = acc_; } \
        } } } while (0)
    for (int c0 = 0; c0 < nsteps; c0 += 6) { R2_STEP(0); R2_STEP(1); R2_STEP(2); R2_STEP(3); R2_STEP(4); R2_STEP(5); }
#undef R2_STEP
#undef R2_LOAD
    if (w < 4) {
        float* dst = samp ? F.out + O_WKVS + (size_t)(chain - 32) * 4096 : F.out + O_WKVP + (size_t)chain * 4096;
#pragma unroll
        for (int nt = 0; nt < 4; ++nt) *(GAS f32x4*)(dst + (16 * w + fr) * 64 + 16 * nt + 4 * fq) = S[nt];
    }
    RW_BAR();
}

__device__ __forceinline__ void r3_unit(Frame& F, int u, ub16* YMIX) {
    LAS unsigned char* lds = F.lds;
    const int tid = F.tid, w = F.wave, lane = F.lane, mt = w >> 1, nh = w & 1, fr = lane & 15, fq = lane >> 4;
    const bool samp = u >= 4096; const int us = u - 4096;
    const int sb = samp ? (us >> 3) : (u >> 10), h = samp ? (us & 7) : ((u >> 7) & 7), c = samp ? 0 : (u & 127);
    const int row0 = samp ? (MP + 16 * sb) : (sb * 8192 + 64 * c);
    const unsigned char* qt = F.ws + WS_QT + (size_t)u * 9216; const unsigned char* s0 = F.ws + WS_S0 + (size_t)u * 9216;
    *(LAS v4u*)(lds + 16 * tid) = *(const GAS v4u*)(qt + 16 * tid); *(LAS v4u*)(lds + TB + 16 * tid) = *(const GAS v4u*)(s0 + 16 * tid);
    if (tid < 64) { *(LAS v4u*)(lds + 16 * (tid + 512)) = *(const GAS v4u*)(qt + 16 * (tid + 512)); *(LAS v4u*)(lds + TB + 16 * (tid + 512)) = *(const GAS v4u*)(s0 + 16 * (tid + 512)); }
    const int t = 16 * mt + fr, n0 = 32 * nh + 4 * fq;
    const bool valid = !samp || t < 16;
    f32x4 acc[2];
    {   const ub16* yl = (const ub16*)(F.ws + WS_YL) + (size_t)u * 4096 + t * 64 + n0;
        acc[0] = unpack4(*(const GAS u32x2*)yl); acc[1] = unpack4(*(const GAS u32x2*)(yl + 16)); }
    RW_BAR();
    mm<2>(acc, RW_TILE(0), TP, RW_TILE(1), TP, mt, nh, fr, fq);
    float s1 = 0.f, s2 = 0.f;
#pragma unroll
    for (int nt = 0; nt < 2; ++nt)
#pragma unroll
        for (int e = 0; e < 4; ++e) { s1 += acc[nt][e]; s2 += acc[nt][e] * acc[nt][e]; }
    s1 += __shfl_xor(s1, 16); s1 += __shfl_xor(s1, 32); s2 += __shfl_xor(s2, 16); s2 += __shfl_xor(s2, 32);
    LAS float* red = (LAS float*)(lds + MISC);
    if (fq == 0) { red[((mt * 2 + nh) * 16 + fr) * 2] = s1; red[((mt * 2 + nh) * 16 + fr) * 2 + 1] = s2; }
    RW_BAR();
    const float a1 = red[((mt * 2 + 0) * 16 + fr) * 2] + red[((mt * 2 + 1) * 16 + fr) * 2], a2 = red[((mt * 2 + 0) * 16 + fr) * 2 + 1] + red[((mt * 2 + 1) * 16 + fr) * 2 + 1];
    const float mean = a1 * (1.0f / 64.0f), var = fmaxf(a2 * (1.0f / 64.0f) - mean * mean, 0.f), rstd = 1.0f / sqrtf(var + 64e-5f);
    if (valid) {
        const ub16* Gb = (const ub16*)(F.ws + WS_G) + (size_t)(row0 + t) * 512 + h * 64 + n0; const ub16* Eb = (const ub16*)(F.ws + WS_E1) + (size_t)(row0 + t) * 512 + h * 64 + n0;
#pragma unroll
        for (int nt = 0; nt < 2; ++nt) { const f32x4 G = unpack4(*(const GAS u32x2*)(Gb + 16 * nt)), E = unpack4(*(const GAS u32x2*)(Eb + 16 * nt));
            const f32x4 y = (acc[nt] - mean) * rstd * G + E;
            *(GAS u32x2*)(YMIX + (size_t)(row0 + t) * DM + h * 64 + n0 + 16 * nt) = pack4(y); }
    }
    RW_BAR();
}
#undef RW_TILE
}

constexpr size_t WS_O0 = WS_PRW, WS_O1 = WS_PRW + 32 * MiB, WS_OS0 = WS_PRW + 64 * MiB, WS_OS1 = WS_PRW + 66 * MiB;
constexpr size_t WS_YMIX = WS_QB;
static_assert(WS_OS1 + 2 * MiB <= WS_QB && WS_YMIX + (size_t)MPAD * 1024 * 2 <= WS_QS, "ws overlays");
__device__ __forceinline__ void attn_phase(Frame& F, char* ldsg) {
    using attn_body::bf16;
    const bf16* Qb = (const bf16*)(F.ws + WS_QB); const bf16* Kb = (const bf16*)(F.ws + WS_KB); const bf16* Vb = (const bf16*)(F.ws + WS_VB);
    const int v = F.vcu, g = v >> 3, s = v & 7;
    for (int set = 0; set < 2; ++set) {
        const int pr = g + 32 * set, vh = pr & 1, c = (pr >> 1) & 1, bh = pr >> 2, b = bh >> 2, h = bh & 3;
        bf16* Ob = (bf16*)(F.ws + (c ? WS_O1 : WS_O0));
        for (int i = 0; i < 4; ++i) {
            const int qb = (i == 0) ? s : (i == 1) ? 15 - s : (i == 2) ? 16 + s : 31 - s;
            const size_t rq = (size_t)b * 8192 + (size_t)qb * 256, rk = (size_t)b * 8192;
            attn_body::attn_unit<8>(Qb + rq * 512 + h * 128 + c * 64, Kb + rk * 512 + h * 128 + c * 64, Vb + rk * 512 + h * 128 + vh * 64, Ob + rq * 512 + h * 128 + vh * 64, 4 * qb + 4, 0, ldsg);
        }
    }
    if (v >= 128) {
        const int idx = v - 128, vh = idx & 1, c = (idx >> 1) & 1, h = (idx >> 2) & 3, b = idx >> 4;
        const bf16* Qs = (const bf16*)(F.ws + WS_QS); const bf16* Ks = (const bf16*)(F.ws + WS_KS); const bf16* Vs = (const bf16*)(F.ws + WS_VS);
        bf16* Os = (bf16*)(F.ws + (c ? WS_OS1 : WS_OS0));
        attn_body::attn_unit<8>(Qs + (size_t)b * 256 * 512 + h * 128 + c * 64, Ks + (size_t)b * 4224 * 512 + h * 128 + c * 64, Vs + (size_t)b * 4224 * 512 + h * 128 + vh * 64,
                                Os + (size_t)b * 256 * 512 + h * 128 + vh * 64, 66, 1, ldsg);
    }
}

__device__ __forceinline__ void combine_rows(Frame& F) {
    const int gw = F.vcu * NWAVES + F.wave, NGW = F.G * NWAVES, lane = F.lane;
    float d1 = F.inp(I_LQ1)[lane] * F.inp(I_LK1)[lane], d2 = F.inp(I_LQ2)[lane] * F.inp(I_LK2)[lane];
    d1 = wave_sum(d1); d2 = wave_sum(d2);
    const float lam = __expf(d1) - __expf(d2) + 0.2f;
    const f32x4 g0 = *(const GAS f32x4*)(F.inp(I_SUBG) + (lane & 15) * 8), g1 = *(const GAS f32x4*)(F.inp(I_SUBG) + (lane & 15) * 8 + 4);
    bf16* YMIX = (bf16*)(F.ws + WS_YMIX);
    for (int r = gw; r < MV; r += NGW) {
        const bf16 *o0, *o1;
        if (r < MP) { o0 = (const bf16*)(F.ws + WS_O0) + (size_t)r * 512; o1 = (const bf16*)(F.ws + WS_O1) + (size_t)r * 512; }
        else { const int rs = r - MP; const size_t ro = ((size_t)(rs >> 4) * 256 + (rs & 15)) * 512; o0 = (const bf16*)(F.ws + WS_OS0) + ro; o1 = (const bf16*)(F.ws + WS_OS1) + ro; }
        const v4u a = *(const GAS v4u*)(o0 + lane * 8), b = *(const GAS v4u*)(o1 + lane * 8);
        float d[8];
        d[0] = rw::bflo(a.x) - lam * rw::bflo(b.x); d[1] = rw::bfhi(a.x) - lam * rw::bfhi(b.x); d[2] = rw::bflo(a.y) - lam * rw::bflo(b.y); d[3] = rw::bfhi(a.y) - lam * rw::bfhi(b.y);
        d[4] = rw::bflo(a.z) - lam * rw::bflo(b.z); d[5] = rw::bfhi(a.z) - lam * rw::bfhi(b.z); d[6] = rw::bflo(a.w) - lam * rw::bflo(b.w); d[7] = rw::bfhi(a.w) - lam * rw::bfhi(b.w);
        float ss = 0.f;
#pragma unroll
        for (int e = 0; e < 8; ++e) ss += d[e] * d[e];
        ss += __shfl_xor(ss, 1); ss += __shfl_xor(ss, 2); ss += __shfl_xor(ss, 4); ss += __shfl_xor(ss, 8);
        const float sc = 0.8f / sqrtf(ss * (1.0f / 128.0f) + 1e-6f);
        v4u o; o.x = rw::cvtpk(d[0] * sc * g0[0], d[1] * sc * g0[1]); o.y = rw::cvtpk(d[2] * sc * g0[2], d[3] * sc * g0[3]); o.z = rw::cvtpk(d[4] * sc * g1[0], d[5] * sc * g1[1]); o.w = rw::cvtpk(d[6] * sc * g1[2], d[7] * sc * g1[3]);
        *(GAS v4u*)(YMIX + (size_t)r * DM + 512 + lane * 8) = o;
    }
    for (int r = MV + gw; r < MPAD; r += NGW) { GAS v4u* o = (GAS v4u*)(YMIX + (size_t)r * DM) + lane; o[0] = (v4u){0u, 0u, 0u, 0u}; o[64] = (v4u){0u, 0u, 0u, 0u}; }
}

constexpr size_t WS_U = 95 * MiB, WS_ACT = 274 * MiB;
constexpr int UROWS_A = 16384, UROWS_B = MPAD - 16384;
static_assert(WS_U + (size_t)UROWS_B * FF2 * 2 <= WS_ACT && WS_ACT + (size_t)MPAD * FF * 2 <= WS_END, "ffn ws map");
__device__ __forceinline__ void h2_rows(Frame& F) {
    const int gw = F.vcu * NWAVES + F.wave, NGW = F.G * NWAVES;
    bf16* H2 = (bf16*)(F.ws + WS_XN);
    for (int m = gw; m < MPAD; m += NGW) {
        if (m < MV) rms_row_to_bf16(F.lane, F.out + (size_t)m * DM, H2 + (size_t)m * DM);
        else { GAS v4u* o = (GAS v4u*)(H2 + (size_t)m * DM) + F.lane; o[0] = (v4u){0u, 0u, 0u, 0u}; o[64] = (v4u){0u, 0u, 0u, 0u}; }
    }
}
__device__ __forceinline__ void conv_act_rows(Frame& F, int row0, int nrows) {
    const size_t gt = (size_t)(F.vcu * NWAVES + F.wave) * 64 + F.lane, NGT = (size_t)F.G * NWAVES * 64;
    const bf16* U = (const bf16*)(F.ws + WS_U); bf16* ACT = (bf16*)(F.ws + WS_ACT);
    const float* cw = F.inp(I_CW); const float* cb = F.inp(I_CB);
    const size_t nitems = (size_t)nrows * 352;
    for (size_t it = gt; it < nitems; it += NGT) {
        const int rl = (int)(it / 352), jc = (int)(it % 352), j = jc * 8, r = row0 + rl;
        v4u o = (v4u){0u, 0u, 0u, 0u};
        if (r < MV) {
            const bool samp = r >= MP; const int t = samp ? ((r - MP) & 15) : (r & 8191); const int sb = samp ? ((r - MP) >> 4) : 0;
            const int pc = 256 * (j >> 7) + (j & 127);
            float cg[8], cu[8];
#pragma unroll
            for (int e = 0; e < 8; ++e) { cg[e] = cb[j + e]; cu[e] = cb[FF + j + e]; }
#pragma unroll
            for (int tap = 0; tap < 3; ++tap) {
                const int tt = t - 2 + tap;
                float ug[8], uu[8];
                if (tt >= 0) { const bf16* ur = U + (size_t)(rl - 2 + tap) * FF2 + pc; const v4u a = *(const GAS v4u*)ur, b = *(const GAS v4u*)(ur + 128);
                    ug[0] = rw::bflo(a.x); ug[1] = rw::bfhi(a.x); ug[2] = rw::bflo(a.y); ug[3] = rw::bfhi(a.y); ug[4] = rw::bflo(a.z); ug[5] = rw::bfhi(a.z); ug[6] = rw::bflo(a.w); ug[7] = rw::bfhi(a.w);
                    uu[0] = rw::bflo(b.x); uu[1] = rw::bfhi(b.x); uu[2] = rw::bflo(b.y); uu[3] = rw::bfhi(b.y); uu[4] = rw::bflo(b.z); uu[5] = rw::bfhi(b.z); uu[6] = rw::bflo(b.w); uu[7] = rw::bfhi(b.w); }
                else if (samp) { const float* st = F.inp(I_SFC) + ((size_t)sb * 2 + (2 + tt)) * FF2;
#pragma unroll
                    for (int e = 0; e < 8; ++e) { ug[e] = st[j + e]; uu[e] = st[FF + j + e]; } }
                else {
#pragma unroll
                    for (int e = 0; e < 8; ++e) { ug[e] = 0.f; uu[e] = 0.f; } }
#pragma unroll
                for (int e = 0; e < 8; ++e) { cg[e] += ug[e] * cw[(size_t)tap * FF2 + j + e]; cu[e] += uu[e] * cw[(size_t)tap * FF2 + FF + j + e]; }
            }
            float a[8];
#pragma unroll
            for (int e = 0; e < 8; ++e) a[e] = cg[e] / (1.0f + __expf(-cg[e])) * cu[e];
            o.x = rw::cvtpk(a[0], a[1]); o.y = rw::cvtpk(a[2], a[3]); o.z = rw::cvtpk(a[4], a[5]); o.w = rw::cvtpk(a[6], a[7]);
        }
        *(GAS v4u*)(ACT + (size_t)r * FF + j) = o;
    }
}

#ifndef MK_PH_HI
#define MK_PH_HI 99
#endif
struct Args { const float* in[33]; float* out; unsigned char* ws; int ph_lo, ph_hi, li, pad; };
__global__ void __launch_bounds__(NWAVES * 64, 2) hymba_fwd(Args args) {
    extern __shared__ __attribute__((aligned(16))) unsigned char lds[];
    Frame F;
    F.lds = (LAS unsigned char*)lds;
    F.MISC = (volatile LAS unsigned*)(F.lds + MISC_OFF);
    F.tid = threadIdx.x; F.lane = F.tid & 63; F.wave = __builtin_amdgcn_readfirstlane(F.tid >> 6);
    F.G = gridDim.x; { const int bx = blockIdx.x; F.vcu = (F.G % 8 == 0) ? (bx % 8) * (F.G / 8) + bx / 8 : bx; }
    F.ws = args.ws; F.out = args.out; F.ctl = (gu32*)(args.ws + WS_CTL);
    for (int u = F.tid; u < (LDS_BYTES - LDSCTL_OFF) / 4; u += NWAVES * 64) ((LAS unsigned*)(F.lds + LDSCTL_OFF))[u] = 0u;
    __syncthreads();
    XcdBarrier bar = xcd_barrier_post((unsigned*)(F.ctl + CW_BAR), F.MISC + 8);
    const int lo = args.ph_lo, hi = args.ph_hi;
#define IN(k) (lo <= (k) && (k) < hi)
#define GRID_BAR() xcd_barrier(bar)

    if (IN(0)) { p0_prologue(F); GRID_BAR(); }

    if (IN(1)) {
        pg8::Gemm g{(const bf16*)(F.ws + WS_XN), (const bf16*)(F.ws + WS_WIN), MPAD, INDIM, 1024}; pg8::StaticOrder S; S.init(MPAD, INDIM, F.G, (int)blockIdx.x);
        pg8::EpiInProj E{(bf16*)(F.ws + WS_PRW), (bf16*)(F.ws + WS_QB), (bf16*)(F.ws + WS_KB), (bf16*)(F.ws + WS_VB), (bf16*)(F.ws + WS_QS), (bf16*)(F.ws + WS_KS), (bf16*)(F.ws + WS_VS),
                         F.out, F.inp(I_QG), F.inp(I_KG), (const float*)(F.ws + WS_ROPE)};
        pg8::gemm_phase<pg8::EpiInProj, pg8::StaticOrder, true, true>(F.lds + RING_OFF, g, S, E);
        GRID_BAR();
    }
    if (IN(2)) {
        for (int u = F.vcu; u < rw::NUNIT; u += F.G) rw::r1_unit(F, u);
        GRID_BAR();
    }
    if (IN(3)) {
#ifndef DBG_SKIP_R2
        if (F.vcu < 96) rw::r2_chain(F, F.vcu);
#endif
#ifndef DBG_SKIP_ATTN
        attn_phase(F, (char*)lds + RING_OFF);
#endif
        GRID_BAR();
    }
    if (IN(4)) {
        for (int u = F.vcu; u < rw::NUNIT; u += F.G) rw::r3_unit(F, u, (rw::ub16*)(F.ws + WS_YMIX));
        combine_rows(F);
        GRID_BAR();
    }
    if (IN(5)) {
        pg8::Gemm g{(const bf16*)(F.ws + WS_YMIX), (const bf16*)(F.ws + WS_WOUT), MPAD, 1024, 1024}; pg8::StaticOrder S; S.init(MPAD, 1024, F.G, (int)blockIdx.x);
        pg8::EpiResid E{F.inp(I_XP), F.inp(I_XS), F.out};
        pg8::gemm_phase<pg8::EpiResid, pg8::StaticOrder, true, true>(F.lds + RING_OFF, g, S, E);
        GRID_BAR();
    }
    if (IN(6)) { h2_rows(F); GRID_BAR(); }
#pragma unroll 1
    for (int blk = 0; blk < 2; ++blk) {
        const int row0 = blk ? UROWS_A : 0, nrows = blk ? UROWS_B : UROWS_A;
        if (IN(7 + 2 * blk)) {
            pg8::Gemm g{(const bf16*)(F.ws + WS_XN) + (size_t)row0 * DM, (const bf16*)(F.ws + WS_WUP), nrows, FF2, 1024}; pg8::StaticOrder S; S.init(nrows, FF2, F.G, (int)blockIdx.x);
            pg8::EpiUp E{(bf16*)(F.ws + WS_U), F.out, row0};
            pg8::gemm_phase<pg8::EpiUp, pg8::StaticOrder, true, true>(F.lds + RING_OFF, g, S, E);
            GRID_BAR();
        }
        if (IN(8 + 2 * blk)) { conv_act_rows(F, row0, nrows); GRID_BAR(); }
    }
    if (IN(11)) {
        pg8::Gemm g{(const bf16*)(F.ws + WS_ACT), (const bf16*)(F.ws + WS_WDN), MPAD, 1024, FF}; pg8::StaticOrder S; S.init(MPAD, 1024, F.G, (int)blockIdx.x);
        pg8::EpiAccum E{F.out};
        pg8::gemm_phase<pg8::EpiAccum, pg8::StaticOrder, true, true>(F.lds + RING_OFF, g, S, E);
    }
#ifdef PHASES_REST_DEFINED
    PHASES_REST
#endif
#undef IN
}

extern "C" void kernel_launch(void* const* d_in, const int* in_sizes, int n_in, void* d_out, int out_size, void* d_ws, size_t ws_size, hipStream_t stream) {
    static int grid = 0;
    if (grid == 0) {
        if (n_in != 33 || in_sizes[0] != MP * DM || (size_t)out_size != pg8::O_END || ws_size < WS_END) {
            fprintf(stderr, "kernel_launch: unexpected problem: n_in %d in0 %d out %d ws %zu (need %zu)\n", n_in, n_in > 0 ? in_sizes[0] : -1, out_size, ws_size, (size_t)WS_END); grid = -1; return; }
        int dev = 0, cus = 0, per_cu = 0;
        if (hipGetDevice(&dev) != hipSuccess || hipDeviceGetAttribute(&cus, hipDeviceAttributeMultiprocessorCount, dev) != hipSuccess) { fprintf(stderr, "kernel_launch: device query failed\n"); grid = -1; return; }
        if (hipFuncSetAttribute((const void*)hymba_fwd, hipFuncAttributeMaxDynamicSharedMemorySize, LDS_BYTES) != hipSuccess) { fprintf(stderr, "kernel_launch: hipFuncSetAttribute failed\n"); grid = -1; return; }
        if (hipOccupancyMaxActiveBlocksPerMultiprocessor(&per_cu, (const void*)hymba_fwd, NWAVES * 64, LDS_BYTES) != hipSuccess || per_cu < 1) { fprintf(stderr, "kernel_launch: occupancy query says %d blocks per CU\n", per_cu); per_cu = 1; }
        (void)hipGetLastError();
        grid = cus;
        fprintf(stderr, "kernel_launch: grid %d (per_cu %d)\n", grid, per_cu);
    }
    if (grid < 0) return;
    if (hipMemsetAsync((char*)d_ws + WS_CTL, 0, CTL_ZERO_BYTES, stream) != hipSuccess) { fprintf(stderr, "kernel_launch: memset failed\n"); return; }
    Args a{};
    for (int i = 0; i < 33; ++i) a.in[i] = (const float*)d_in[i];
    a.out = (float*)d_out; a.ws = (unsigned char*)d_ws; a.ph_lo = 0; a.ph_hi = MK_PH_HI; a.li = 0; a.pad = 0;
    void* kargs[] = {&a};
    hipError_t e = hipLaunchCooperativeKernel((const void*)hymba_fwd, dim3(grid), dim3(NWAVES * 64), kargs, LDS_BYTES, stream);
    if (e != hipSuccess) fprintf(stderr, "kernel_launch: cooperative launch failed: %s (grid %d)\n", hipGetErrorString(e), grid);
}
```

```cpp
#include <hip/hip_runtime.h>
#ifndef DBG_R1_CUT
#define DBG_R1_CUT 99
#endif
#ifndef DBG_KMASK
#define DBG_KMASK (-1)
#endif
#include <cstdio>
#include <cstdint>
namespace pg8 {
#define PG8_LAS __attribute__((address_space(3)))
typedef unsigned short bf16_t;
typedef short bf16x8 __attribute__((ext_vector_type(8)));
typedef float f32x4 __attribute__((ext_vector_type(4)));
typedef unsigned u32x4 __attribute__((ext_vector_type(4)));
constexpr int BM = 256, BK = 64, HALF = 128, HTB = HALF * BK * 2  , STAGE_BYTES = 8 * HTB, NXCD = 8, WGM = 8;

__host__ __device__ __forceinline__ int lds_byte(int r, int c) { const int st = (r >> 4) * 2 + (c >> 5), rr = r & 15, cc = c & 31, ob = rr * 64 + cc * 2; return st * 1024 + (ob ^ (((ob >> 9) & 1) << 5)); }
__host__ __device__ __forceinline__ void stage_rc(int b, int& R, int& C) { const int st = b / 1024, sb = b % 1024, swz = sb ^ (((sb >> 9) & 1) << 5); R = (st >> 1) * 16 + swz / 64; C = (st & 1) * 32 + (swz % 64) / 2; }
__host__ __device__ __forceinline__ int perm32(int rho) { const int n = rho >> 4, i = rho & 15; return 8 * (i >> 2) + 4 * n + (i & 3); }

struct Unit { int pm, pn; };
struct Gemm { const bf16_t* A; const bf16_t* Bt; int M, N, K; };

struct StaticOrder {
    int nM, nN, nwg, G, c;
    __host__ __device__ void init(int M, int N, int G_, int c_) { nM = M / BM; nN = N / BM; nwg = nM * nN; G = G_; c = c_; }
    __host__ __device__ bool next(int i, Unit& u) const {
        const long L = (long)i * G + c; if (L >= nwg) return false;
        int wgid = (int)L; { const int q = nwg / NXCD, r = nwg % NXCD, xcd = wgid % NXCD, off = wgid / NXCD; wgid = (xcd < r ? xcd * (q + 1) : r * (q + 1) + (xcd - r) * q) + off; }
        const int nig = WGM * nN, gid = wgid / nig, fm = gid * WGM, gsz = (nM - fm) < WGM ? (nM - fm) : WGM;
        u.pm = fm + ((wgid % nig) % gsz); u.pn = (wgid % nig) / gsz; return true;
    }
    __device__ __forceinline__ void a_ready(const Unit&) const {}
    __device__ __forceinline__ void done(const Unit&) const {}
};
struct RowTileOrder {
    int pm, nN, c;
    __host__ __device__ bool next(int i, Unit& u) const { if (i > 0 || c >= nN) return false; u.pm = pm; u.pn = c; return true; }
    __device__ __forceinline__ void a_ready(const Unit&) const {}
    __device__ __forceinline__ void done(const Unit&) const {}
};


constexpr int MP = 32768, MS = 128, MV = 32896, MPAD = 33024;
constexpr int RWIN = 1792, DFW = 512, FF = 2816, FF2 = 5632, DM = 1024, INDIM = 3328;
constexpr size_t O_YP = 0, O_YS = 33554432, O_KP = 33685504, O_VP = 50462720, O_SHP = 67239936, O_WKVP = 67247104, O_FCP = 67378176,
                 O_KS = 67423232, O_VS = 67488768, O_SHS = 67554304, O_WKVS = 67568640, O_FCS = 67830784, O_END = 67920896;
constexpr float QK_C2 = 0.125f * 1.4426950408889634f;

typedef float f32x2_c __attribute__((ext_vector_type(2))); typedef __bf16 bf16x2_c __attribute__((ext_vector_type(2)));
__device__ __forceinline__ unsigned cvt_pk_bf16(float lo, float hi) { f32x2_c v = {lo, hi}; bf16x2_c b = __builtin_convertvector(v, bf16x2_c); return __builtin_bit_cast(unsigned, b); }
__device__ __forceinline__ u32x4 pack8(const f32x4& v0, const f32x4& v1) { u32x4 w; w.x = cvt_pk_bf16(v0[0], v0[1]); w.y = cvt_pk_bf16(v0[2], v0[3]); w.z = cvt_pk_bf16(v1[0], v1[1]); w.w = cvt_pk_bf16(v1[2], v1[3]); return w; }

struct EpiInProj {
    static constexpr bool PERM = true, AFTER_DRAIN = false;
    bf16_t* Prw; bf16_t* Qb; bf16_t* Kb; bf16_t* Vb; bf16_t* Qs; bf16_t* Ks; bf16_t* Vs; float* out; const float* qg; const float* kg; const float* ropecs;
    __device__ __forceinline__ void operator()(const f32x4 (&acc)[2][2][4][2], const Unit& u, int wr, int wc, int fr, int fq) const {
        const int pn = u.pn, pm = u.pm; const bool samp = (pm == 128);
        if (pn < 7) {
#pragma unroll
            for (int ai = 0; ai < 2; ++ai) {
                if (samp && ai == 1) continue;
#pragma unroll
                for (int m = 0; m < 4; ++m) {
                    const int r = pm * BM + ai * HALF + wr * 64 + m * 16 + fr;
                    const bool last = samp ? (fr == 15) : ((r & 8191) == 8191);
#pragma unroll
                    for (int bj = 0; bj < 2; ++bj) {
                        const int col = pn * BM + bj * HALF + wc * 32 + 8 * fq;
                        const f32x4 v0 = acc[ai][bj][m][0], v1 = acc[ai][bj][m][1];
                        *(u32x4*)(Prw + (size_t)r * RWIN + col) = pack8(v0, v1);
                        if (last) { float* dst = samp ? out + O_SHS + (size_t)((r - MP) >> 4) * RWIN + col : out + O_SHP + (size_t)(r >> 13) * RWIN + col;
                            *(f32x4*)dst = v0; *(f32x4*)(dst + 4) = v1; }
                    }
                }
            }
            return;
        }
        const int tix = pn - 7, which = tix >> 1, G8 = (tix & 1) * 4 + wc;
        f32x4 gv[2][2];
#pragma unroll
        for (int bj = 0; bj < 2; ++bj)
#pragma unroll
            for (int n = 0; n < 2; ++n) gv[bj][n] = (which < 2) ? *(const f32x4*)((which == 0 ? qg : kg) + 32 * bj + 8 * fq + 4 * n) : (f32x4){1.f, 1.f, 1.f, 1.f};
#pragma unroll
        for (int ai = 0; ai < 2; ++ai) {
            if (samp && ai == 1) continue;
#pragma unroll
            for (int m = 0; m < 4; ++m) {
                const int r = pm * BM + ai * HALF + wr * 64 + m * 16 + fr;
                const int rs = r - MP;
                const int pos = samp ? (4096 + (rs & 15)) : (r & 8191);
                f32x4 v[2][2];
#pragma unroll
                for (int bj = 0; bj < 2; ++bj)
#pragma unroll
                    for (int n = 0; n < 2; ++n) v[bj][n] = acc[ai][bj][m][n];
                if (which < 2) {
                    float ss = 0.f;
#pragma unroll
                    for (int bj = 0; bj < 2; ++bj)
#pragma unroll
                        for (int n = 0; n < 2; ++n) ss += (v[bj][n][0] * v[bj][n][0] + v[bj][n][1] * v[bj][n][1]) + (v[bj][n][2] * v[bj][n][2] + v[bj][n][3] * v[bj][n][3]);
                    ss += __shfl_xor(ss, 16); ss += __shfl_xor(ss, 32);
                    const float rstd = __builtin_amdgcn_rsqf(ss * (1.0f / 64.0f) + 1e-6f);
#pragma unroll
                    for (int bj = 0; bj < 2; ++bj)
#pragma unroll
                        for (int n = 0; n < 2; ++n) v[bj][n] = v[bj][n] * rstd * gv[bj][n];
                    const float* cs = ropecs + (size_t)pos * 16;
#pragma unroll
                    for (int n = 0; n < 2; ++n) {
                        const f32x4 c4 = *(const f32x4*)(cs + 4 * n), s4 = *(const f32x4*)(cs + 8 + 4 * n);
                        f32x4 o = v[0][n];
#pragma unroll
                        for (int e = 0; e < 4; ++e) {
                            const float own = v[0][n][e], oth = __shfl_xor(own, 16);
                            const float r1 = own * c4[e] - oth * s4[e], r2 = own * c4[e] + oth * s4[e];
                            o[e] = (fq == 0) ? r1 : ((fq == 1) ? r2 : own);
                        }
                        v[0][n] = o;
                    }
                }
                if (which == 0) {
                    bf16_t* qrow = samp ? Qs + ((size_t)(rs >> 4) * 256 + (rs & 15)) * DFW : Qb + (size_t)r * DFW;
#pragma unroll
                    for (int bj = 0; bj < 2; ++bj) *(u32x4*)(qrow + 64 * G8 + 32 * bj + 8 * fq) = pack8(v[bj][0] * QK_C2, v[bj][1] * QK_C2);
                } else {
                    bf16_t* brow; float* frow;
                    if (which == 1) { brow = samp ? Ks + ((size_t)(rs >> 4) * 4224 + 4096 + (rs & 15)) * DFW : Kb + (size_t)r * DFW; frow = samp ? out + O_KS + (size_t)rs * DFW : out + O_KP + (size_t)r * DFW; }
                    else            { brow = samp ? Vs + ((size_t)(rs >> 4) * 4224 + 4096 + (rs & 15)) * DFW : Vb + (size_t)r * DFW; frow = samp ? out + O_VS + (size_t)rs * DFW : out + O_VP + (size_t)r * DFW; }
#pragma unroll
                    for (int bj = 0; bj < 2; ++bj) { const int c0 = 64 * G8 + 32 * bj + 8 * fq;
                        *(u32x4*)(brow + c0) = pack8(v[bj][0], v[bj][1]);
                        *(f32x4*)(frow + c0) = v[bj][0]; *(f32x4*)(frow + c0 + 4) = v[bj][1]; }
                }
            }
        }
    }
};

struct EpiResid {
    static constexpr bool PERM = false, AFTER_DRAIN = false;
    const float* xp; const float* xs; float* out;
    __device__ __forceinline__ void operator()(const f32x4 (&acc)[2][2][4][2], const Unit& u, int wr, int wc, int fr, int fq) const {
        const int col0 = u.pn * BM + wc * 32 + 4 * fq;
#pragma unroll
        for (int ai = 0; ai < 2; ++ai)
#pragma unroll
            for (int m = 0; m < 4; ++m) { const int r = u.pm * BM + ai * HALF + wr * 64 + m * 16 + fr;
                if (r < MV) { const float* xr = (r < MP) ? xp + (size_t)r * DM : xs + (size_t)(r - MP) * DM; float* orow = out + (size_t)r * DM;
#pragma unroll
                    for (int bj = 0; bj < 2; ++bj)
#pragma unroll
                        for (int n = 0; n < 2; ++n) { const int c = col0 + bj * HALF + n * 16; *(f32x4*)(orow + c) = *(const f32x4*)(xr + c) + acc[ai][bj][m][n]; } } }
    }
};
struct EpiAccum {
    static constexpr bool PERM = false, AFTER_DRAIN = false;
    float* out;
    __device__ __forceinline__ void operator()(const f32x4 (&acc)[2][2][4][2], const Unit& u, int wr, int wc, int fr, int fq) const {
        const int col0 = u.pn * BM + wc * 32 + 4 * fq;
#pragma unroll
        for (int ai = 0; ai < 2; ++ai)
#pragma unroll
            for (int m = 0; m < 4; ++m) { const int r = u.pm * BM + ai * HALF + wr * 64 + m * 16 + fr;
                if (r < MV) { float* orow = out + (size_t)r * DM;
#pragma unroll
                    for (int bj = 0; bj < 2; ++bj)
#pragma unroll
                        for (int n = 0; n < 2; ++n) { const int c = col0 + bj * HALF + n * 16; *(f32x4*)(orow + c) = *(const f32x4*)(orow + c) + acc[ai][bj][m][n]; } } }
    }
};
__device__ __forceinline__ float dpp_ror1(float x) { return __builtin_bit_cast(float, __builtin_amdgcn_update_dpp(0, __builtin_bit_cast(int, x), 0x121, 0xf, 0xf, false)); }
__device__ __forceinline__ float dpp_ror2(float x) { return __builtin_bit_cast(float, __builtin_amdgcn_update_dpp(0, __builtin_bit_cast(int, x), 0x122, 0xf, 0xf, false)); }
__device__ __forceinline__ float dpp_shr1(float old, float x) { return __builtin_bit_cast(float, __builtin_amdgcn_update_dpp(__builtin_bit_cast(int, old), __builtin_bit_cast(int, x), 0x111, 0xf, 0xf, false)); }
__device__ __forceinline__ float dpp_shr2(float old, float x) { return __builtin_bit_cast(float, __builtin_amdgcn_update_dpp(__builtin_bit_cast(int, old), __builtin_bit_cast(int, x), 0x112, 0xf, 0xf, false)); }
template <int CTRL> __device__ __forceinline__ float dppz(float x) { return __builtin_bit_cast(float, __builtin_amdgcn_update_dpp(0, __builtin_bit_cast(int, x), CTRL, 0xf, 0xf, true)); }
struct EpiUpConv {
    static constexpr bool PERM = true, AFTER_DRAIN = false;
    bf16_t* ACT; float* out; float* Hraw; float* Hs; const float* cw; const float* cb; PG8_LAS float* halo;
    __device__ __forceinline__ void save_row(float* d, int c, const f32x4 (&a)[2][2][4][2], int ai, int m) const {
#pragma unroll
        for (int bj = 0; bj < 2; ++bj) { *(f32x4*)(d + c + bj * HALF) = a[ai][bj][m][0]; *(f32x4*)(d + c + bj * HALF + 4) = a[ai][bj][m][1]; }
    }
    __device__ __forceinline__ void operator()(const f32x4 (&acc)[2][2][4][2], const Unit& u, int wr, int wc, int fr, int fq) const {
        const int pm = u.pm, pn = u.pn; const bool samp = (pm == 128);
        const int cphys = pn * BM + wc * 32 + 8 * fq;
        if (fr >= 14) {
#pragma unroll
            for (int ai = 0; ai < 2; ++ai)
#pragma unroll
                for (int bj = 0; bj < 2; ++bj)
#pragma unroll
                    for (int n = 0; n < 2; ++n) *(PG8_LAS f32x4*)(halo + ((2 * ai + wr) * 2 + (fr - 14)) * 256 + bj * HALF + wc * 32 + 8 * fq + 4 * n) = acc[ai][bj][3][n];
        }
        if (wr == 0 && fr < 2) save_row(Hraw + ((size_t)pm * 4 + fr) * FF2, cphys, acc, 0, 0);
        if (wr == 1 && fr >= 14) { save_row(Hraw + ((size_t)pm * 4 + (fr - 12)) * FF2, cphys, acc, 1, 3);
            if (!samp && (pm & 31) == 31) { float* d = out + O_FCP + ((size_t)(pm >> 5) * 2 + (fr - 14)) * FF2; const int cl = pn * HALF + wc * 32 + 8 * fq;
#pragma unroll
                for (int bj = 0; bj < 2; ++bj) { *(f32x4*)(d + cl + bj * FF) = acc[1][bj][3][0]; *(f32x4*)(d + cl + bj * FF + 4) = acc[1][bj][3][1]; } } }
        if (samp) {
#pragma unroll
            for (int m = 0; m < 4; ++m) {
                if (fr < 2) save_row(Hs + ((size_t)(wr * 4 + m) * 2 + fr) * FF2, cphys, acc, 0, m);
                if (fr >= 14) { float* d = out + O_FCS + ((size_t)(wr * 4 + m) * 2 + (fr - 14)) * FF2; const int cl = pn * HALF + wc * 32 + 8 * fq;
#pragma unroll
                    for (int bj = 0; bj < 2; ++bj) { *(f32x4*)(d + cl + bj * FF) = acc[0][bj][m][0]; *(f32x4*)(d + cl + bj * FF + 4) = acc[0][bj][m][1]; } }
            }
        }
        asm volatile("s_waitcnt lgkmcnt(0)" ::: "memory"); __builtin_amdgcn_s_barrier(); asm volatile("" ::: "memory");
#pragma unroll
        for (int n = 0; n < 2; ++n) {
            const int j0 = pn * HALF + wc * 32 + 8 * fq + 4 * n;
            const f32x4 wg0 = *(const f32x4*)(cw + j0), wg1 = *(const f32x4*)(cw + FF2 + j0), wg2 = *(const f32x4*)(cw + 2 * FF2 + j0), bg = *(const f32x4*)(cb + j0);
            const f32x4 wu0 = *(const f32x4*)(cw + FF + j0), wu1 = *(const f32x4*)(cw + FF2 + FF + j0), wu2 = *(const f32x4*)(cw + 2 * FF2 + FF + j0), bu = *(const f32x4*)(cb + FF + j0);
#pragma unroll
            for (int ai = 0; ai < 2; ++ai) {
                const int idx = 2 * ai + wr;
                f32x4 pg = (f32x4){0.f, 0.f, 0.f, 0.f}, pu = (f32x4){0.f, 0.f, 0.f, 0.f};
                if (idx > 0 && fr >= 14) { const PG8_LAS float* hp = halo + ((idx - 1) * 2 + (fr - 14)) * 256 + wc * 32 + 8 * fq + 4 * n; pg = *(const PG8_LAS f32x4*)hp; pu = *(const PG8_LAS f32x4*)(hp + HALF); }
#pragma unroll
                for (int m = 0; m < 4; ++m) {
                    const f32x4 cg = acc[ai][0][m][n], cu = acc[ai][1][m][n];
                    f32x4 a;
#pragma unroll
                    for (int e = 0; e < 4; ++e) {
                        float xg = fmaf(wg2[e], cg[e], bg[e]), xu = fmaf(wu2[e], cu[e], bu[e]);
                        xg = fmaf(dppz<0x111>(cg[e]), wg1[e], xg); xu = fmaf(dppz<0x111>(cu[e]), wu1[e], xu);
                        xg = fmaf(dppz<0x10F>(pg[e]), wg1[e], xg); xu = fmaf(dppz<0x10F>(pu[e]), wu1[e], xu);
                        xg = fmaf(dppz<0x112>(cg[e]), wg0[e], xg); xu = fmaf(dppz<0x112>(cu[e]), wu0[e], xu);
                        xg = fmaf(dppz<0x10E>(pg[e]), wg0[e], xg); xu = fmaf(dppz<0x10E>(pu[e]), wu0[e], xu);
                        a[e] = xg * __builtin_amdgcn_rcpf(1.0f + __expf(-xg)) * xu;
                    }
                    pg = cg; pu = cu;
                    const int r = pm * BM + ai * HALF + wr * 64 + m * 16 + fr;
                    if (r < MV) { typedef unsigned u32x2_ __attribute__((ext_vector_type(2))); u32x2_ w; w.x = cvt_pk_bf16(a[0], a[1]); w.y = cvt_pk_bf16(a[2], a[3]); *(u32x2_*)(ACT + (size_t)r * FF + j0) = w; }
                    __builtin_amdgcn_sched_barrier(0);
                }
            }
        }
    }
};
template <class Epi, class Sched, bool ALIGN_EPI = false, bool SP2 = false, bool HALF_ROWS = false>
__device__ __forceinline__ void gemm_phase(PG8_LAS unsigned char* lds, const Gemm g, const Sched& S, const Epi& E) {
    const int tid = threadIdx.x, wid = __builtin_amdgcn_readfirstlane(tid >> 6), lane = tid & 63, wr = wid >> 2, wc = wid & 3, fr = lane & 15, fq = lane >> 4;
    const int K = g.K, nt = K / BK;
    unsigned voffA[2], voffB[2];
#pragma unroll
    for (int i = 0; i < 2; ++i) { int R, C; stage_rc(tid * 16 + i * 8192, R, C); const int Rb = Epi::PERM ? ((R & ~31) + perm32(R & 31)) : R;
        voffA[i] = (unsigned)(R * K + C) * 2u; voffB[i] = (unsigned)(Rb * K + C) * 2u; }
    const size_t kstep = (size_t)(BK * 2);
    const size_t hstep = (size_t)HALF * K * 2;
    const size_t tstep = 2 * hstep;
    const unsigned ldsw = (unsigned)wid * 1024u;
    const int aoff = lds_byte(wr * 64 + fr, fq * 8), boff = lds_byte(wc * 32 + fr, fq * 8);
#define PG8_SA(b, h) (((b) * 2 + (h)) * HTB)
#define PG8_SB(b, h) ((4 + (b) * 2 + (h)) * HTB)
#define PG8_STAGE(bufoff, gbase, voff) do { _Pragma("unroll") for (int _i = 0; _i < 2; ++_i) \
        __builtin_amdgcn_global_load_lds((const unsigned*)((const char*)(gbase) + (voff)[_i]), (PG8_LAS unsigned*)(lds + (bufoff) + ldsw + _i * 8192), 16, 0, 0); } while (0)
#define PG8_LDA(dst, b, h) do { _Pragma("unroll") for (int m = 0; m < 4; ++m) _Pragma("unroll") for (int k = 0; k < 2; ++k) dst[m][k] = *(const PG8_LAS bf16x8*)(lds + PG8_SA(b, h) + aoff + m * 2048 + k * 1024); } while (0)
#define PG8_LDB(dst, b, h) do { _Pragma("unroll") for (int n = 0; n < 2; ++n) _Pragma("unroll") for (int k = 0; k < 2; ++k) dst[n][k] = *(const PG8_LAS bf16x8*)(lds + PG8_SB(b, h) + boff + n * 2048 + k * 1024); } while (0)
#define PG8_MMA(ai, bj, At, Bt) do { __builtin_amdgcn_s_setprio(1); _Pragma("unroll") for (int m = 0; m < 4; ++m) _Pragma("unroll") for (int n = 0; n < 2; ++n) _Pragma("unroll") for (int k = 0; k < 2; ++k) \
        acc[ai][bj][m][n] = __builtin_amdgcn_mfma_f32_16x16x32_bf16(Bt[n][k], At[m][k], acc[ai][bj][m][n], 0, 0, 0); __builtin_amdgcn_s_setprio(0); } while (0)
#define PG8_WAIT_V(n) asm volatile("s_waitcnt vmcnt(" #n ")" ::: "memory")
#define PG8_WAIT_L(n) asm volatile("s_waitcnt lgkmcnt(" #n ")" ::: "memory")
#define PG8_BAR __builtin_amdgcn_s_barrier()
#define PG8_SCHED __builtin_amdgcn_sched_barrier(0)
    Unit cur, nxt; int ui = 0;
    if (!S.next(0, cur)) return;
    f32x4 acc[2][2][4][2];
#pragma unroll
    for (int a = 0; a < 2; ++a)
#pragma unroll
        for (int b = 0; b < 2; ++b)
#pragma unroll
            for (int m = 0; m < 4; ++m)
#pragma unroll
                for (int n = 0; n < 2; ++n) acc[a][b][m][n] = (f32x4){0.f, 0.f, 0.f, 0.f};
    bf16x8 At[4][2], B0[2][2], B1[2][2];
    const char* cA = (const char*)g.A + (size_t)cur.pm * tstep; const char* cB = (const char*)g.Bt + (size_t)cur.pn * tstep;
    S.a_ready(cur);
    if constexpr (SP2) {
        PG8_STAGE(PG8_SB(0, 0), cB, voffB); PG8_STAGE(PG8_SB(0, 1), cB + hstep, voffB); PG8_STAGE(PG8_SA(0, 0), cA, voffA); PG8_STAGE(PG8_SA(0, 1), cA + hstep, voffA);
        if (wr == 1) PG8_BAR;
        PG8_WAIT_V(2); PG8_BAR;
        PG8_STAGE(PG8_SB(1, 0), cB + kstep, voffB); PG8_STAGE(PG8_SA(1, 0), cA + kstep, voffA); PG8_STAGE(PG8_SB(1, 1), cB + hstep + kstep, voffB);
        PG8_WAIT_V(6); PG8_BAR;
    } else {
        PG8_STAGE(PG8_SB(0, 0), cB, voffB); PG8_STAGE(PG8_SA(0, 0), cA, voffA); PG8_STAGE(PG8_SB(0, 1), cB + hstep, voffB); PG8_STAGE(PG8_SA(0, 1), cA + hstep, voffA);
        if (wr == 1) PG8_BAR;
        PG8_WAIT_V(4); PG8_BAR;
        PG8_STAGE(PG8_SB(1, 0), cB + kstep, voffB); PG8_STAGE(PG8_SA(1, 0), cA + kstep, voffA); PG8_STAGE(PG8_SB(1, 1), cB + hstep + kstep, voffB);
        PG8_WAIT_V(6); PG8_BAR;
    }
    for (;;) {
        const bool has_next = S.next(ui + 1, nxt);
        const char* nA = has_next ? (const char*)g.A + (size_t)nxt.pm * tstep : cA; const char* nB = has_next ? (const char*)g.Bt + (size_t)nxt.pn * tstep : cB;
        for (int t = 0; t < nt; t += 2) {
            const bool last = (t == nt - 2);
            const char* a1 = cA + (size_t)(t + 1) * kstep;
            const char* a2 = last ? nA : cA + (size_t)(t + 2) * kstep; const char* b2 = last ? nB : cB + (size_t)(t + 2) * kstep;
            const char* a3 = a2 + kstep; const char* b3 = b2 + kstep;
            if (last && has_next) S.a_ready(nxt);
            if constexpr (SP2) {
            PG8_LDB(B0, 0, 0); PG8_LDB(B1, 0, 1); PG8_SCHED; PG8_LDA(At, 0, 0); PG8_STAGE(PG8_SA(1, 1), a1 + hstep, voffA);
            PG8_WAIT_V(8); PG8_WAIT_L(0); PG8_BAR; PG8_MMA(0, 0, At, B0); PG8_MMA(0, 1, At, B1); PG8_BAR; PG8_SCHED;
            PG8_LDA(At, 0, 1); PG8_STAGE(PG8_SB(0, 0), b2, voffB); PG8_STAGE(PG8_SB(0, 1), b2 + hstep, voffB); PG8_STAGE(PG8_SA(0, 0), a2, voffA);
            PG8_WAIT_V(8); PG8_WAIT_L(0); PG8_BAR; if constexpr (!HALF_ROWS) { PG8_MMA(1, 0, At, B0); PG8_MMA(1, 1, At, B1); } PG8_BAR; PG8_SCHED;
            PG8_LDB(B0, 1, 0); PG8_LDB(B1, 1, 1); PG8_SCHED; PG8_LDA(At, 1, 0); PG8_STAGE(PG8_SA(0, 1), a2 + hstep, voffA);
            PG8_WAIT_V(8); PG8_WAIT_L(0); PG8_BAR; PG8_MMA(0, 0, At, B0); PG8_MMA(0, 1, At, B1); PG8_BAR; PG8_SCHED;
            PG8_LDA(At, 1, 1); PG8_STAGE(PG8_SB(1, 0), b3, voffB); PG8_STAGE(PG8_SB(1, 1), b3 + hstep, voffB); PG8_STAGE(PG8_SA(1, 0), a3, voffA);
            PG8_WAIT_V(8); PG8_WAIT_L(0); PG8_BAR; if constexpr (!HALF_ROWS) { PG8_MMA(1, 0, At, B0); PG8_MMA(1, 1, At, B1); } PG8_BAR; PG8_SCHED;
            } else {
            PG8_LDB(B0, 0, 0); PG8_SCHED; PG8_LDA(At, 0, 0); PG8_STAGE(PG8_SA(1, 1), a1 + hstep, voffA);
            PG8_WAIT_L(8); PG8_BAR; PG8_WAIT_L(0); PG8_MMA(0, 0, At, B0); PG8_BAR; PG8_SCHED;
            PG8_LDB(B1, 0, 1); PG8_STAGE(PG8_SB(0, 0), b2, voffB);
            PG8_BAR; PG8_WAIT_L(0); PG8_MMA(0, 1, At, B1); PG8_BAR;
            PG8_LDA(At, 0, 1); PG8_STAGE(PG8_SA(0, 0), a2, voffA);
            PG8_BAR; PG8_WAIT_L(0); PG8_MMA(1, 0, At, B0); PG8_BAR; PG8_SCHED;
            PG8_STAGE(PG8_SB(0, 1), b2 + hstep, voffB);
            PG8_WAIT_V(6); PG8_BAR; PG8_MMA(1, 1, At, B1); PG8_BAR;
            PG8_LDB(B0, 1, 0); PG8_SCHED; PG8_LDA(At, 1, 0); PG8_STAGE(PG8_SA(0, 1), a2 + hstep, voffA);
            PG8_WAIT_L(8); PG8_BAR; PG8_WAIT_L(0); PG8_MMA(0, 0, At, B0); PG8_BAR; PG8_SCHED;
            PG8_LDB(B1, 1, 1); PG8_STAGE(PG8_SB(1, 0), b3, voffB);
            PG8_BAR; PG8_WAIT_L(0); PG8_MMA(0, 1, At, B1); PG8_BAR;
            PG8_LDA(At, 1, 1); PG8_STAGE(PG8_SA(1, 0), a3, voffA);
            PG8_BAR; PG8_WAIT_L(0); PG8_MMA(1, 0, At, B0); PG8_BAR; PG8_SCHED;
            PG8_STAGE(PG8_SB(1, 1), b3 + hstep, voffB);
            PG8_WAIT_V(6); PG8_BAR; PG8_MMA(1, 1, At, B1); PG8_BAR;
            }
        }
        if constexpr (ALIGN_EPI) { if (wr == 0) PG8_BAR; }
        if constexpr (!Epi::AFTER_DRAIN) { E(acc, cur, wr, wc, fr, fq); S.done(cur); }
        if (!has_next) break;
#pragma unroll
        for (int a = 0; a < 2; ++a)
#pragma unroll
            for (int b = 0; b < 2; ++b)
#pragma unroll
                for (int m = 0; m < 4; ++m)
#pragma unroll
                    for (int n = 0; n < 2; ++n) acc[a][b][m][n] = (f32x4){0.f, 0.f, 0.f, 0.f};
        cur = nxt; cA = nA; cB = nB; ++ui;
        if constexpr (ALIGN_EPI) { if (wr == 1) PG8_BAR; }
    }
    PG8_WAIT_V(0);
    if constexpr (!ALIGN_EPI) { if (wr == 0) PG8_BAR; }
    PG8_BAR;
    if constexpr (Epi::AFTER_DRAIN) { E.fused(acc, cur, wr, wc, fr, fq, lds, wid, lane); S.done(cur); }
#undef PG8_SA
#undef PG8_SB
#undef PG8_STAGE
#undef PG8_LDA
#undef PG8_LDB
#undef PG8_MMA
#undef PG8_WAIT_V
#undef PG8_WAIT_L
#undef PG8_BAR
#undef PG8_SCHED
}
}
#include <hip/hip_bf16.h>
#include <cmath>
namespace attn_body {
using bf16=__hip_bfloat16;
using bf16x8=__attribute__((ext_vector_type(8)))short;
using s16x4=__attribute__((ext_vector_type(4)))short;
using f32x16=__attribute__((ext_vector_type(16)))float;
using u32x4=__attribute__((ext_vector_type(4)))unsigned;
constexpr int D=64,DM=512;
constexpr int NW=8,QBLK=32,QB=QBLK*NW,KVBLK=64;
__device__ __forceinline__ int crow(int r,int hi){return (r&3)+8*(r>>2)+4*hi;}
#define SBAR() __builtin_amdgcn_sched_barrier(0)
__device__ __forceinline__ void cmask(f32x16&p0,f32x16&p1,int jb,int wid,int mode){
  const float NEG=-INFINITY; const bool all=(mode==0)?(jb>(wid>>1)):(jb==3); const bool part=(mode==1)&&(jb==2);
  #pragma unroll
  for(int r=0;r<16;++r){ if(all||(part&&r>=8))p0[r]=NEG; if(all||part)p1[r]=NEG; }
}

constexpr int NSLOT=3, SLOTB=8192;
constexpr int LDS_K=0, LDS_V=NSLOT*SLOTB, LDS_WS=2*NSLOT*SLOTB, LDS_OST=LDS_WS+NW*64*4, LDS_BYTES=LDS_OST+NW*4096;
constexpr float C2=0.125f*1.4426950408889634f;
__device__ __forceinline__ void glds16(const void*gsrc,unsigned lds_dst){unsigned keep;
  asm volatile("s_mov_b32 %0, m0\n\ts_mov_b32 m0, %2\n\ts_nop 0\n\tglobal_load_lds_dwordx4 %1, off\n\ts_mov_b32 m0, %0":"=&s"(keep):"v"(gsrc),"s"(lds_dst):"memory");}
__device__ __forceinline__ float max3f(float a,float b,float c){float r;asm("v_max3_f32 %0, %1, %2, %3":"=v"(r):"v"(a),"v"(b),"v"(c));return r;}
__device__ __forceinline__ float max2f(float a,float b){float r;asm("v_max_f32_e32 %0, %1, %2":"=v"(r):"v"(a),"v"(b));return r;}
__device__ __forceinline__ float fadd_s(float a,float b){float r;asm("v_add_f32_e32 %0, %1, %2":"=v"(r):"v"(a),"v"(b));return r;}
__device__ __forceinline__ float fsub_s(float a,float b){float r;asm("v_sub_f32_e32 %0, %1, %2":"=v"(r):"v"(a),"v"(b));return r;}
typedef float f32x2_t __attribute__((ext_vector_type(2))); typedef __bf16 bf16x2_t __attribute__((ext_vector_type(2)));
__device__ __forceinline__ unsigned cvtpk_s(float lo,float hi){f32x2_t v={lo,hi};bf16x2_t b=__builtin_convertvector(v,bf16x2_t);return __builtin_bit_cast(unsigned,b);}
#define WAIT_BAR(N) asm volatile("s_waitcnt vmcnt(" #N ") lgkmcnt(0)\n\ts_barrier":::"memory")

__device__ __forceinline__ void qkt(f32x16&p0,f32x16&p1,const char*Kslot,const bf16x8*qr,const f32x16&negm,int r32,int hi){
  const char*kb=Kslot+hi*1024+r32*16;
  #pragma unroll
  for(int d0=0;d0<4;++d0){
    const bf16x8 b0=*reinterpret_cast<const bf16x8*>(kb+d0*2048);
    const bf16x8 b1=*reinterpret_cast<const bf16x8*>(kb+d0*2048+512);
    if(d0==0){p0=__builtin_amdgcn_mfma_f32_32x32x16_bf16(b0,qr[0],negm,0,0,0);p1=__builtin_amdgcn_mfma_f32_32x32x16_bf16(b1,qr[0],negm,0,0,0);}
    else{p0=__builtin_amdgcn_mfma_f32_32x32x16_bf16(b0,qr[d0],p0,0,0,0);p1=__builtin_amdgcn_mfma_f32_32x32x16_bf16(b1,qr[d0],p1,0,0,0);}}
}
typedef __attribute__((address_space(3))) const char* lds_cptr;
typedef short v4i16_t __attribute__((ext_vector_type(4)));
__device__ __forceinline__ void kload8(bf16x8*kf,lds_cptr kp){
  kf[0]=*(const __attribute__((address_space(3))) bf16x8*)(kp);      kf[1]=*(const __attribute__((address_space(3))) bf16x8*)(kp+512);
  kf[2]=*(const __attribute__((address_space(3))) bf16x8*)(kp+2048); kf[3]=*(const __attribute__((address_space(3))) bf16x8*)(kp+2560);
  kf[4]=*(const __attribute__((address_space(3))) bf16x8*)(kp+4096); kf[5]=*(const __attribute__((address_space(3))) bf16x8*)(kp+4608);
  kf[6]=*(const __attribute__((address_space(3))) bf16x8*)(kp+6144); kf[7]=*(const __attribute__((address_space(3))) bf16x8*)(kp+6656);
}
__device__ __forceinline__ void kload2(bf16x8*kf,lds_cptr kp,int j){ kf[2*j]=*(const __attribute__((address_space(3))) bf16x8*)(kp+j*2048); kf[2*j+1]=*(const __attribute__((address_space(3))) bf16x8*)(kp+j*2048+512); }
__device__ __forceinline__ s16x4 vtr(lds_cptr p){ return __builtin_bit_cast(s16x4,__builtin_amdgcn_ds_read_tr16_b64_v4i16((__attribute__((address_space(3))) v4i16_t*)p)); }
__device__ __forceinline__ float rowmax(const f32x16&p0,const f32x16&p1){
  float a=max3f(p0[0],p0[1],p1[0]),b=max3f(p0[2],p0[3],p1[1]);a=max3f(a,p1[2],p1[3]);
  #pragma unroll
  for(int r=4;r<16;r+=4){a=max3f(a,p0[r],p0[r+1]);b=max3f(b,p0[r+2],p0[r+3]);a=max3f(a,p1[r],p1[r+1]);b=max3f(b,p1[r+2],p1[r+3]);}
  const float m=max2f(a,b);
  auto rr=__builtin_amdgcn_permlane32_swap(__float_as_uint(m),__float_as_uint(m),false,false);
  return max2f(__uint_as_float(rr[0]),__uint_as_float(rr[1]));
}
__device__ __forceinline__ void pv(f32x16*o,int vb,bf16x8 pa0,bf16x8 pa1,bf16x8 pa2,bf16x8 pa3){
  #pragma unroll
  for(int d0=0;d0<2;++d0){s16x4 lo[4],hi[4];
    #pragma unroll
    for(int ks=0;ks<4;++ks){
      asm volatile("ds_read_b64_tr_b16 %0,%1 offset:%c2":"=&v"(lo[ks]):"v"(vb),"i"(d0*4096+ks*1024):"memory");
      asm volatile("ds_read_b64_tr_b16 %0,%1 offset:%c2":"=&v"(hi[ks]):"v"(vb),"i"(d0*4096+ks*1024+512):"memory");}
    asm volatile("s_waitcnt lgkmcnt(0)":::"memory");SBAR();
    #define PK(k) (bf16x8){lo[k][0],lo[k][1],lo[k][2],lo[k][3],hi[k][0],hi[k][1],hi[k][2],hi[k][3]}
    o[d0]=__builtin_amdgcn_mfma_f32_32x32x16_bf16(pa0,PK(0),o[d0],0,0,0);
    o[d0]=__builtin_amdgcn_mfma_f32_32x32x16_bf16(pa1,PK(1),o[d0],0,0,0);
    o[d0]=__builtin_amdgcn_mfma_f32_32x32x16_bf16(pa2,PK(2),o[d0],0,0,0);
    o[d0]=__builtin_amdgcn_mfma_f32_32x32x16_bf16(pa3,PK(3),o[d0],0,0,0);
    #undef PK
  }
}

#ifndef ATTN_STORE16
#define ATTN_STORE16(p,v) (*(u32x4*)(p)=(v))
#endif
template<int THRL> __device__ __forceinline__ void attn_unit(const bf16*Qu,const bf16*__restrict__ Ku,const bf16*__restrict__ Vu,bf16*Ou,const int NT,const int mode,char*shm){
  const int tid=threadIdx.x,lane=tid&63,r32=lane&31,hi=lane>>5; const int wid=__builtin_amdgcn_readfirstlane(tid>>6);
  const bf16*Qw=Qu+(long)(wid*QBLK)*DM;
  const bf16*Kh=Ku,*Vh=Vu;
  const unsigned lds0=(unsigned)(uintptr_t)shm;
  float*wsf=(float*)(shm+LDS_WS)+wid*64;
  const bf16*ksrc=Kh+(long)lane*DM+wid*8;
  const bf16*vsrc=Vh+(long)(16*(wid&3)+(lane>>2))*DM+(wid>>2)*32+(lane&3)*8;
  const unsigned kdst=lds0+LDS_K+wid*1024, vdst=lds0+LDS_V+wid*1024;
  #define DMA_K(t,slot) glds16(ksrc+(long)(t)*KVBLK*DM,(unsigned)__builtin_amdgcn_readfirstlane(kdst+(slot)))
  #define DMA_V(t,slot) glds16(vsrc+(long)(t)*KVBLK*DM,(unsigned)__builtin_amdgcn_readfirstlane(vdst+(slot)))
  const int vb0=(int)(lds0+LDS_V)+((lane>>4)&1)*32+(lane&3)*8+(4*hi+((lane&15)>>2))*64;
  const char*Kbase=shm+LDS_K; bf16x8 kf[8];
  const lds_cptr shm3=(lds_cptr)shm; const lds_cptr kp0=shm3+LDS_K+hi*1024+r32*16; const lds_cptr vp0=shm3+LDS_V+((lane>>4)&1)*32+(lane&3)*8+(4*hi+((lane&15)>>2))*64;
  DMA_K(0,0);DMA_V(0,0);DMA_K(1,SLOTB);
  bf16x8 qr[4];
  #pragma unroll
  for(int d0=0;d0<4;++d0)qr[d0]=*reinterpret_cast<const bf16x8*>(&Qw[(long)r32*DM+d0*16+hi*8]);
  float mhat=0.f,l_reg=0.f;f32x16 o[2];o[0]=f32x16{};o[1]=f32x16{};f32x16 negm=f32x16{};asm volatile("":"+v"(negm));
  const int qrel=wid*QBLK+r32;
  #define CMASK(P0,P1,t) do{int jb_=(t)-(NT-4); if(jb_>=0)cmask(P0,P1,jb_,wid,mode);}while(0)
  bool resc=false;
  #define START(P0,P1) do{ const float rm=rowmax(P0,P1); resc=false; \
    { const float dl=rm; mhat=fadd_s(mhat,dl); \
      _Pragma("unroll") for(int r=0;r<16;++r){P0[r]=fsub_s(P0[r],dl);P1[r]=fsub_s(P1[r],dl);} \
      _Pragma("unroll") for(int r=0;r<16;++r)negm[r]=-mhat; asm volatile("":"+v"(negm)); } \
    _Pragma("unroll") for(int r=0;r<16;++r)P0[r]=__builtin_amdgcn_exp2f(P0[r]); }while(0)
  #define RESC() do{ if(resc){ asm volatile("s_waitcnt lgkmcnt(0)":::"memory"); \
      _Pragma("unroll") for(int d_=0;d_<2;++d_) _Pragma("unroll") for(int r=0;r<16;++r)o[d_][r]*=wsf[crow(r,hi)]; } }while(0)
  f32x16 pA0,pA1,pB0,pB1;
  int sl_prev=0,sl_cur=0,sl_next=SLOTB;
  #define ROT() do{sl_prev=sl_cur;sl_cur=sl_next;sl_next=(sl_next==(NSLOT-1)*SLOTB)?0:sl_next+SLOTB;}while(0)
  DMA_K(2,2*SLOTB);
  WAIT_BAR(3);
  qkt(pA0,pA1,Kbase,qr,negm,r32,hi);asm volatile("s_nop 15\n\ts_nop 7":"+v"(pA0),"+v"(pA1));CMASK(pA0,pA1,0);
  START(pA0,pA1);
  _Pragma("unroll") for(int r=0;r<16;++r)pA1[r]=__builtin_amdgcn_exp2f(pA1[r]);
  WAIT_BAR(0);
  DMA_K(3,0);DMA_V(1,SLOTB);
  ROT();
  kload8(kf,kp0+sl_cur);
  WAIT_BAR(2);
  s16x4 vlo[8],vhi[8]; u32x4 pw0,pw1,pw2,pw3;
  #define PKW(P,B) cvtpk_s(P[B],P[B+1])
  #define PAF(k) __builtin_bit_cast(bf16x8,pw##k)
  #define VFR(i) (bf16x8){vlo[i][0],vlo[i][1],vlo[i][2],vlo[i][3],vhi[i][0],vhi[i][1],vhi[i][2],vhi[i][3]}
  #define PIN(x) asm volatile("":"+v"(x))
  #define MX3(a,b,c) __builtin_fmaxf(__builtin_fmaxf((a),(b)),(c))
  #define GAPA(MF,A0,A1,A2,A3,W0,W1,PW) do{ MF; sacc+=A0; sacc+=A1; sacc+=A2; sacc+=A3; PIN(sacc); W0; W1; PIN(PW); SBAR(); }while(0)
  #define EX(v) __builtin_amdgcn_exp2f(v)
  #define GAPB(MF,X,B) do{ MF; X[B]=EX(X[B]); X[B+1]=EX(X[B+1]); X[B+2]=EX(X[B+2]); X[B+3]=EX(X[B+3]); PIN(X); SBAR(); }while(0)
  #define VRD(i) do{ vlo[i]=vtr(vp_+(((i)>>2)*4096+((i)&3)*1024)); vhi[i]=vtr(vp_+(((i)>>2)*4096+((i)&3)*1024+512)); }while(0)
  #define KRD(G,j) do{ if(G){ kload2(kf,kp0+sl_next,j); SBAR(); } }while(0)
  #define STEP(C0,C1,P0,P1,t,GK,GV,GL) do{ SBAR(); \
    const lds_cptr vp_=vp0+sl_prev; \
    VRD(0); SBAR(); float sacc=(P0[0]+P0[1]); \
    GAPA(C0=__builtin_amdgcn_mfma_f32_32x32x16_bf16(kf[0],qr[0],negm,0,0,0), P0[2],P0[3],P0[4],P0[5],     pw0[0]=PKW(P0,0), pw0[1]=PKW(P0,2), pw0); \
    VRD(4); SBAR(); GAPA(C1=__builtin_amdgcn_mfma_f32_32x32x16_bf16(kf[1],qr[0],negm,0,0,0), P0[6],P0[7],P0[8],P0[9],     pw0[2]=PKW(P0,4), pw0[3]=PKW(P0,6), pw0); \
    VRD(1); SBAR(); GAPA(C0=__builtin_amdgcn_mfma_f32_32x32x16_bf16(kf[2],qr[1],C0,0,0,0),   P0[10],P0[11],P0[12],P0[13], pw1[0]=PKW(P0,8), pw1[1]=PKW(P0,10), pw1); \
    VRD(5); SBAR(); GAPA(C1=__builtin_amdgcn_mfma_f32_32x32x16_bf16(kf[3],qr[1],C1,0,0,0),   P0[14],P0[15],P1[0],P1[1],   pw1[2]=PKW(P0,12),pw1[3]=PKW(P0,14), pw1); \
    VRD(2); SBAR(); GAPA(C0=__builtin_amdgcn_mfma_f32_32x32x16_bf16(kf[4],qr[2],C0,0,0,0),   P1[2],P1[3],P1[4],P1[5],     pw2[0]=PKW(P1,0), pw2[1]=PKW(P1,2), pw2); \
    VRD(6); SBAR(); GAPA(C1=__builtin_amdgcn_mfma_f32_32x32x16_bf16(kf[5],qr[2],C1,0,0,0),   P1[6],P1[7],P1[8],P1[9],     pw2[2]=PKW(P1,4), pw2[3]=PKW(P1,6), pw2); \
    VRD(3); SBAR(); GAPA(C0=__builtin_amdgcn_mfma_f32_32x32x16_bf16(kf[6],qr[3],C0,0,0,0),   P1[10],P1[11],P1[12],P1[13], pw3[0]=PKW(P1,8), pw3[1]=PKW(P1,10), pw3); \
    VRD(7); SBAR(); GAPA(C1=__builtin_amdgcn_mfma_f32_32x32x16_bf16(kf[7],qr[3],C1,0,0,0),   P1[14],P1[15],0.f,0.f,       pw3[2]=PKW(P1,12),pw3[3]=PKW(P1,14), pw3); \
    l_reg+=sacc; \
    if(GK){DMA_K((t)+3,sl_cur);} if(GV){DMA_V((t)+1,sl_next);} \
    CMASK(C0,C1,t); \
    { float a=MX3(C0[0],C0[1],C1[0]),b=MX3(C0[2],C0[3],C1[1]); a=MX3(a,C1[2],C1[3]); \
      _Pragma("unroll") for(int r=4;r<16;r+=4){a=MX3(a,C0[r],C0[r+1]);b=MX3(b,C0[r+2],C0[r+3]);a=MX3(a,C1[r],C1[r+1]);b=MX3(b,C1[r+2],C1[r+3]);} \
      float rm=__builtin_fmaxf(a,b); { auto rr=__builtin_amdgcn_permlane32_swap(__float_as_uint(rm),__float_as_uint(rm),false,false); rm=__builtin_fmaxf(__uint_as_float(rr[0]),__uint_as_float(rr[1])); } \
      resc=false; \
      if(__builtin_expect(__any(rm>(float)THRL),0)){ const float dl=__builtin_fmaxf(rm,0.f); mhat+=dl; \
        _Pragma("unroll") for(int r=0;r<16;++r){C0[r]-=dl;C1[r]-=dl;} \
        _Pragma("unroll") for(int r=0;r<16;++r)negm[r]=-mhat; asm volatile("":"+v"(negm)); \
        const float f=__builtin_amdgcn_exp2f(-dl); l_reg*=f; if(hi==0)wsf[r32]=f; resc=true; } } \
    SBAR(); \
    GAPB(o[0]=__builtin_amdgcn_mfma_f32_32x32x16_bf16(PAF(0),VFR(0),o[0],0,0,0), C0,0); \
    GAPB(o[1]=__builtin_amdgcn_mfma_f32_32x32x16_bf16(PAF(0),VFR(4),o[1],0,0,0), C0,4); \
    KRD(GL,0); GAPB(o[0]=__builtin_amdgcn_mfma_f32_32x32x16_bf16(PAF(1),VFR(1),o[0],0,0,0), C0,8); \
    KRD(GL,1); GAPB(o[1]=__builtin_amdgcn_mfma_f32_32x32x16_bf16(PAF(1),VFR(5),o[1],0,0,0), C0,12); \
    KRD(GL,2); GAPB(o[0]=__builtin_amdgcn_mfma_f32_32x32x16_bf16(PAF(2),VFR(2),o[0],0,0,0), C1,0); \
    KRD(GL,3); GAPB(o[1]=__builtin_amdgcn_mfma_f32_32x32x16_bf16(PAF(2),VFR(6),o[1],0,0,0), C1,4); \
    GAPB(o[0]=__builtin_amdgcn_mfma_f32_32x32x16_bf16(PAF(3),VFR(3),o[0],0,0,0), C1,8); \
    GAPB(o[1]=__builtin_amdgcn_mfma_f32_32x32x16_bf16(PAF(3),VFR(7),o[1],0,0,0), C1,12); \
    }while(0)
  int t=1;
  #undef CMASK
  #define CMASK(P0,P1,t) do{}while(0)
  for(;t+5<NT;t+=2){
    STEP(pB0,pB1,pA0,pA1,t,true,true,true);     WAIT_BAR(2); RESC(); ROT();
    STEP(pA0,pA1,pB0,pB1,t+1,true,true,true);   WAIT_BAR(2); RESC(); ROT();
  }
  #undef CMASK
  #define CMASK(P0,P1,t) do{int jb_=(t)-(NT-4); if(jb_>=0)cmask(P0,P1,jb_,wid,mode);}while(0)
  #define ENDW(tt) do{ if((tt)+3<NT){WAIT_BAR(2);} else if((tt)+2<NT){WAIT_BAR(1);} else {WAIT_BAR(0);} }while(0)
  for(;t+1<NT;t+=2){
    STEP(pB0,pB1,pA0,pA1,t,(t+3<NT),(t+1<NT),(t+1<NT));       ENDW(t);   RESC(); ROT();
    STEP(pA0,pA1,pB0,pB1,t+1,(t+4<NT),(t+2<NT),(t+2<NT));     ENDW(t+1); RESC(); ROT();
  }
  STEP(pB0,pB1,pA0,pA1,NT-1,false,false,false); RESC();
  { float sacc=pB0[0]+pB0[1]; _Pragma("unroll") for(int r=2;r<16;++r)sacc+=pB0[r]; _Pragma("unroll") for(int r=0;r<16;++r)sacc+=pB1[r]; l_reg+=sacc;
    pw0=(u32x4){PKW(pB0,0),PKW(pB0,2),PKW(pB0,4),PKW(pB0,6)};pw1=(u32x4){PKW(pB0,8),PKW(pB0,10),PKW(pB0,12),PKW(pB0,14)};pw2=(u32x4){PKW(pB1,0),PKW(pB1,2),PKW(pB1,4),PKW(pB1,6)};pw3=(u32x4){PKW(pB1,8),PKW(pB1,10),PKW(pB1,12),PKW(pB1,14)};
    SBAR(); pv(o,vb0+sl_cur,PAF(0),PAF(1),PAF(2),PAF(3)); }
  #undef PKW
  #undef PAF
  #undef VFR
  #undef PIN
  #undef MX3
  #undef GAPA
  #undef GAPB
  #undef EX
  #undef VRD
  #undef KRD
  #undef STEP
  #undef ENDW
  {auto rr=__builtin_amdgcn_permlane32_swap(__float_as_uint(l_reg),__float_as_uint(l_reg),false,false);l_reg=__uint_as_float(rr[0])+__uint_as_float(rr[1]);}
  if(hi==0)wsf[32+r32]=l_reg;asm volatile("s_waitcnt lgkmcnt(0)":::"memory");
  float rli[16];
  #pragma unroll
  for(int r=0;r<16;++r)rli[r]=__builtin_amdgcn_rcpf(wsf[32+crow(r,hi)]);
  bf16*Ow=Ou+(long)(wid*QBLK)*DM;
  { bf16*stg=(bf16*)(shm+LDS_OST)+wid*2048;
    #pragma unroll
    for(int r=0;r<16;++r){const int orow=crow(r,hi);
      #pragma unroll
      for(int d0=0;d0<2;++d0)stg[orow*64+d0*32+r32]=__float2bfloat16(o[d0][r]*rli[r]);}
    asm volatile("s_waitcnt lgkmcnt(0)":::"memory");
    #pragma unroll
    for(int i=0;i<4;++i){const int row=i*8+(lane>>3),ch=lane&7; const u32x4 v=*(const u32x4*)(stg+row*64+ch*8); ATTN_STORE16(Ow+(long)row*DM+ch*8,v);} }
  asm volatile("s_waitcnt lgkmcnt(0)\n\ts_barrier":::"memory");
  #undef DMA_K
  #undef DMA_V
  #undef CMASK
  #undef START
  #undef RESC
  #undef ROT
}
constexpr int ATTN_LDS_BYTES=LDS_BYTES;

#undef SBAR
#undef WAIT_BAR
}
namespace attn2 {
using bf16 = __hip_bfloat16;
constexpr int NW = 8, QBLK = 32, KVBLK = 64, LD = 512;
constexpr size_t SHM_V = KVBLK * 128 * 2, SHM_K = KVBLK * 64 * 2, SHM_ATTN = 3 * SHM_V + 3 * SHM_K + NW * 64 * 4;
constexpr float THR = 8.f, NEGBIG = -1e30f;
using bf16x8 = __attribute__((ext_vector_type(8))) short;
using s16x4  = __attribute__((ext_vector_type(4))) short;
using f32x16 = __attribute__((ext_vector_type(16))) float;
using u32x4  = __attribute__((ext_vector_type(4))) unsigned;
#define A2_KSWZ(row, colB) ((row) * 128 + ((colB) ^ (((row) & 7) << 4)))
#define A2_SBAR() __builtin_amdgcn_sched_barrier(0)
__device__ __forceinline__ int crow(int r, int hi) { return (r & 3) + 8 * (r >> 2) + 4 * hi; }
__device__ __forceinline__ unsigned cvtpk(float lo, float hi) { typedef float f2 __attribute__((ext_vector_type(2))); typedef __bf16 b2 __attribute__((ext_vector_type(2))); f2 v = {lo, hi}; b2 b = __builtin_convertvector(v, b2); return __builtin_bit_cast(unsigned, b); }
__device__ __forceinline__ void amask(f32x16& p0, f32x16& p1, int j, int NT, int wid, int mode) {
  const int jb = j - (NT - 4); if (jb < 0) return;
  const bool all = (mode == 0) ? (jb > (wid >> 1)) : (jb == 3); const bool part = (mode == 1) && (jb == 2);
#pragma unroll
  for (int r = 0; r < 16; ++r) { if (all || (part && r >= 8)) p0[r] = NEGBIG; if (all || part) p1[r] = NEGBIG; }
}
__device__ __forceinline__ void partialSM(f32x16& p0, f32x16& p1, float& m_reg, float& mn, float& alpha) {
  float pmax = p0[0];
#pragma unroll
  for (int r = 1; r < 16; ++r) pmax = fmaxf(pmax, p0[r]);
#pragma unroll
  for (int r = 0; r < 16; ++r) pmax = fmaxf(pmax, p1[r]);
  { auto rr = __builtin_amdgcn_permlane32_swap(__float_as_uint(pmax), __float_as_uint(pmax), false, false); pmax = fmaxf(__uint_as_float(rr[0]), __uint_as_float(rr[1])); }
  if (__builtin_expect(__all(pmax - m_reg <= THR), 1)) { mn = m_reg; alpha = 1.f; }
  else { mn = fmaxf(m_reg, pmax); alpha = __builtin_amdgcn_exp2f(m_reg - mn); m_reg = mn; }
#pragma unroll
  for (int r = 0; r < 16; ++r) { p0[r] = p0[r] - mn; p1[r] = p1[r] - mn; }
#pragma unroll
  for (int r = 0; r < 16; ++r) p0[r] = __builtin_amdgcn_exp2f(p0[r]);
}
__device__ __forceinline__ void psm_head(const f32x16& p0, const f32x16& p1, float& m_reg, float& mn, float& alpha) {
  float pmax = p0[0];
#pragma unroll
  for (int r = 1; r < 16; ++r) pmax = fmaxf(pmax, p0[r]);
#pragma unroll
  for (int r = 0; r < 16; ++r) pmax = fmaxf(pmax, p1[r]);
  { auto rr = __builtin_amdgcn_permlane32_swap(__float_as_uint(pmax), __float_as_uint(pmax), false, false); pmax = fmaxf(__uint_as_float(rr[0]), __uint_as_float(rr[1])); }
  if (__builtin_expect(__all(pmax - m_reg <= THR), 1)) { mn = m_reg; alpha = 1.f; }
  else { mn = fmaxf(m_reg, pmax); alpha = __builtin_amdgcn_exp2f(m_reg - mn); m_reg = mn; }
}
typedef float f2_t __attribute__((ext_vector_type(2)));
template <int D> __device__ __forceinline__ void psm_slice(f32x16& p0, f32x16& p1, float mn) {
  const f2_t m2 = {mn, mn};
#pragma unroll
  for (int r = 4 * D; r < 4 * D + 4; r += 2) {
    f2_t a = {p0[r], p0[r + 1]}, c = {p1[r], p1[r + 1]}; a = a - m2; c = c - m2;
    p0[r] = __builtin_amdgcn_exp2f(a.x); p0[r + 1] = __builtin_amdgcn_exp2f(a.y); p1[r] = __builtin_amdgcn_exp2f(c.x); p1[r + 1] = __builtin_amdgcn_exp2f(c.y); }
}
template <bool DOEXP = true> __device__ __forceinline__ void finishSM(f32x16& p0, f32x16& p1, float alpha, float& l_reg, bf16x8& pa0, bf16x8& pa1, bf16x8& pa2, bf16x8& pa3) {
  if constexpr (DOEXP) {
#pragma unroll
  for (int r = 0; r < 16; ++r) p1[r] = __builtin_amdgcn_exp2f(p1[r]); }
  f2_t ps2 = {0.f, 0.f};
#pragma unroll
  for (int r = 0; r < 16; r += 2) { ps2 = ps2 + (f2_t){p0[r], p0[r + 1]}; ps2 = ps2 + (f2_t){p1[r], p1[r + 1]}; }
  float ps = ps2.x + ps2.y;
  { auto rr = __builtin_amdgcn_permlane32_swap(__float_as_uint(ps), __float_as_uint(ps), false, false); ps = __uint_as_float(rr[0]) + __uint_as_float(rr[1]); }
  l_reg = l_reg * alpha + ps;
#define A2_PK4(P, BASE, OUT) do { unsigned a0 = cvtpk(P[BASE + 0], P[BASE + 1]), a1 = cvtpk(P[BASE + 2], P[BASE + 3]);   \
    unsigned b0 = cvtpk(P[BASE + 4], P[BASE + 5]), b1 = cvtpk(P[BASE + 6], P[BASE + 7]);                              \
    auto r0 = __builtin_amdgcn_permlane32_swap(a0, b0, false, false); auto r1 = __builtin_amdgcn_permlane32_swap(a1, b1, false, false); \
    u32x4 w = {r0[0], r1[0], r0[1], r1[1]}; OUT = *reinterpret_cast<bf16x8*>(&w); } while (0)
  A2_PK4(p0, 0, pa0); A2_PK4(p0, 8, pa1); A2_PK4(p1, 0, pa2); A2_PK4(p1, 8, pa3);
#undef A2_PK4
}
__device__ __forceinline__ void qkt(f32x16& p0, f32x16& p1, const char* Ks, const bf16x8* qr, int r32, int hi) {
  p0 = f32x16{}; p1 = f32x16{};
#pragma unroll
  for (int d0 = 0; d0 < 4; ++d0) { const int cb = (d0 * 16 + hi * 8) * 2;
    const bf16x8 b0 = *reinterpret_cast<const bf16x8*>(Ks + A2_KSWZ(r32, cb));
    const bf16x8 b1 = *reinterpret_cast<const bf16x8*>(Ks + A2_KSWZ(32 + r32, cb));
    p0 = __builtin_amdgcn_mfma_f32_32x32x16_bf16(b0, qr[d0], p0, 0, 0, 0);
    p1 = __builtin_amdgcn_mfma_f32_32x32x16_bf16(b1, qr[d0], p1, 0, 0, 0); }
}
__device__ __forceinline__ int v_st(int k, int c) { const int kk = (k & ~0xC) | ((k & 4) << 1) | ((k & 8) >> 1); return ((kk >> 3) * 4 + (c >> 5)) * 512 + ((kk & 7) * 32 + (c & 31)) * 2; }
__device__ __forceinline__ int v_rd_base(int lane) { return ((lane & 3) << 3) | (((lane >> 2) & 3) << 6) | (((lane >> 4) & 1) << 5) | (((lane >> 5) & 1) << 8); }
constexpr int v_rd_off(int d0, int ks, int half) { return d0 * 512 + ks * 4096 + half * 2048; }
template <int OFF> __device__ __forceinline__ s16x4 tr_read(int vb) { s16x4 r; asm volatile("ds_read_b64_tr_b16 %0, %1 offset:%2" : "=&v"(r) : "v"(vb), "i"(OFF) : "memory"); return r; }
template <int D0> __device__ __forceinline__ void pv_one(f32x16& od, int vb, bf16x8 pa0, bf16x8 pa1, bf16x8 pa2, bf16x8 pa3) {
  const s16x4 l0 = tr_read<v_rd_off(D0, 0, 0)>(vb), h0 = tr_read<v_rd_off(D0, 0, 1)>(vb), l1 = tr_read<v_rd_off(D0, 1, 0)>(vb), h1 = tr_read<v_rd_off(D0, 1, 1)>(vb);
  const s16x4 l2 = tr_read<v_rd_off(D0, 2, 0)>(vb), h2 = tr_read<v_rd_off(D0, 2, 1)>(vb), l3 = tr_read<v_rd_off(D0, 3, 0)>(vb), h3 = tr_read<v_rd_off(D0, 3, 1)>(vb);
  asm volatile("s_waitcnt lgkmcnt(0)" ::: "memory"); A2_SBAR();
#define A2_PK(L, H) (bf16x8){L[0], L[1], L[2], L[3], H[0], H[1], H[2], H[3]}
  od = __builtin_amdgcn_mfma_f32_32x32x16_bf16(pa0, A2_PK(l0, h0), od, 0, 0, 0);
  od = __builtin_amdgcn_mfma_f32_32x32x16_bf16(pa1, A2_PK(l1, h1), od, 0, 0, 0);
  od = __builtin_amdgcn_mfma_f32_32x32x16_bf16(pa2, A2_PK(l2, h2), od, 0, 0, 0);
  od = __builtin_amdgcn_mfma_f32_32x32x16_bf16(pa3, A2_PK(l3, h3), od, 0, 0, 0);
#undef A2_PK
}
__device__ __forceinline__ void pv_d0(f32x16* o, int vb, bf16x8 pa0, bf16x8 pa1, bf16x8 pa2, bf16x8 pa3) {
  pv_one<0>(o[0], vb, pa0, pa1, pa2, pa3); pv_one<1>(o[1], vb, pa0, pa1, pa2, pa3); pv_one<2>(o[2], vb, pa0, pa1, pa2, pa3); pv_one<3>(o[3], vb, pa0, pa1, pa2, pa3);
}
__device__ __forceinline__ void pv_d0_sm(f32x16* o, int vb, bf16x8 pa0, bf16x8 pa1, bf16x8 pa2, bf16x8 pa3, f32x16& p0, f32x16& p1, float mn) {
  pv_one<0>(o[0], vb, pa0, pa1, pa2, pa3); psm_slice<0>(p0, p1, mn); pv_one<1>(o[1], vb, pa0, pa1, pa2, pa3); psm_slice<1>(p0, p1, mn);
  pv_one<2>(o[2], vb, pa0, pa1, pa2, pa3); psm_slice<2>(p0, p1, mn); pv_one<3>(o[3], vb, pa0, pa1, pa2, pa3); psm_slice<3>(p0, p1, mn);
}
__device__ __forceinline__ void unit(const bf16* __restrict__ Qb, const bf16* __restrict__ Kh, const bf16* __restrict__ Vh, bf16* __restrict__ Ob, const int NT, const int mode, char* lds) {
  const int tid = threadIdx.x, wid = __builtin_amdgcn_readfirstlane(tid >> 6), lane = tid & 63, r32 = lane & 31, hi = lane >> 5;
  char* V_lds = lds; char* K_lds = lds + 3 * SHM_V;
  float* ws = (float*)(lds + 3 * SHM_V + 3 * SHM_K) + wid * 64; float* li_l = ws; float* al_l = ws + 32;
  float m_reg = NEGBIG, l_reg = 0; f32x16 o[4] = {}; bf16x8 qr[4];
  const bf16* Qw = Qb + (long)(wid * QBLK + r32) * LD + hi * 8;
#pragma unroll
  for (int d0 = 0; d0 < 4; ++d0) qr[d0] = *reinterpret_cast<const bf16x8*>(Qw + d0 * 16);
  const int sr = tid >> 4, sc = (tid & 15) * 8, vst0 = v_st(sr, sc);
  const int kr = tid >> 3, kc = (tid & 7) * 8, kst = A2_KSWZ(kr, kc * 2);
  const unsigned voffV = (unsigned)(sr * LD + sc) * 2u, voffK = (unsigned)(kr * LD + kc) * 2u;
  const int vb0 = (int)(uintptr_t)V_lds + v_rd_base(lane);
  struct { bf16x8 vs0, vs1, ks0; } sr_[2];
#define A2_SLOAD(i, k0) do { const char* vb_ = (const char*)Vh + (long)(k0) * (LD * 2); const char* kb_ = (const char*)Kh + (long)(k0) * (LD * 2);     \
    sr_[i].vs0 = *reinterpret_cast<const bf16x8*>(vb_ + voffV); sr_[i].vs1 = *reinterpret_cast<const bf16x8*>(vb_ + 32 * LD * 2 + voffV); sr_[i].ks0 = *reinterpret_cast<const bf16x8*>(kb_ + voffK); } while (0)
#define A2_SWRITE(b, i) do { *(bf16x8*)(V_lds + (b) * SHM_V + vst0) = sr_[i].vs0; *(bf16x8*)(V_lds + (b) * SHM_V + 8192 + vst0) = sr_[i].vs1; *(bf16x8*)(K_lds + (b) * SHM_K + kst) = sr_[i].ks0; } while (0)
#define A2_SWAIT() asm volatile("s_waitcnt vmcnt(3)" ::: "memory")
#define A2_RESC(a) do { if (__any((a) < 1.f)) { if (hi == 0) al_l[r32] = (a); asm volatile("s_waitcnt lgkmcnt(0)" ::: "memory"); \
    _Pragma("unroll") for (int d = 0; d < 4; ++d) _Pragma("unroll") for (int r = 0; r < 16; ++r) o[d][r] *= al_l[crow(r, hi)]; } } while (0)
  f32x16 pA0, pA1, pB0, pB1; float mnA, mnB, alA, alB; bf16x8 pa0, pa1, pa2, pa3;
  constexpr int SE = 0, SO = 1;
  A2_SLOAD(SE, 0); asm volatile("s_waitcnt vmcnt(0)" ::: "memory"); A2_SWRITE(0, SE); __syncthreads();
  qkt(pA0, pA1, K_lds, qr, r32, hi); amask(pA0, pA1, 0, NT, wid, mode); psm_head(pA0, pA1, m_reg, mnA, alA);
  psm_slice<0>(pA0, pA1, mnA); psm_slice<1>(pA0, pA1, mnA); psm_slice<2>(pA0, pA1, mnA); psm_slice<3>(pA0, pA1, mnA);
  A2_SLOAD(SO, KVBLK); if (2 < NT) A2_SLOAD(SE, 2 * KVBLK);
  A2_SWAIT(); A2_SWRITE(1, SO); __syncthreads();
  int sp = 0, sc_ = 1, sn = 2;
#define A2_ROT() do { const int t_ = sp; sp = sc_; sc_ = sn; sn = t_; } while (0)
  for (int j = 1; j + 1 < NT; j += 2) {
    A2_SBAR(); qkt(pB0, pB1, K_lds + sc_ * SHM_K, qr, r32, hi);
    finishSM<false>(pA0, pA1, alA, l_reg, pa0, pa1, pa2, pa3); A2_SBAR();
    if (j >= NT - 4) { asm volatile("" ::: "memory"); amask(pB0, pB1, j, NT, wid, mode); }
    psm_head(pB0, pB1, m_reg, mnB, alB);
    A2_SLOAD(SO, (j + 2) * KVBLK); A2_SBAR();
    pv_d0_sm(o, vb0 + sp * (int)SHM_V, pa0, pa1, pa2, pa3, pB0, pB1, mnB);
    A2_SWAIT(); A2_SWRITE(sn, SE);
    A2_RESC(alB); __syncthreads(); A2_ROT();
    A2_SBAR(); qkt(pA0, pA1, K_lds + sc_ * SHM_K, qr, r32, hi);
    finishSM<false>(pB0, pB1, alB, l_reg, pa0, pa1, pa2, pa3); A2_SBAR();
    if (j + 1 >= NT - 4) { asm volatile("" ::: "memory"); amask(pA0, pA1, j + 1, NT, wid, mode); }
    psm_head(pA0, pA1, m_reg, mnA, alA);
    if (j + 3 < NT) A2_SLOAD(SE, (j + 3) * KVBLK); A2_SBAR();
    pv_d0_sm(o, vb0 + sp * (int)SHM_V, pa0, pa1, pa2, pa3, pA0, pA1, mnA);
    A2_SWAIT(); A2_SWRITE(sn, SO);
    A2_RESC(alA); __syncthreads(); A2_ROT();
  }
  A2_SBAR(); qkt(pB0, pB1, K_lds + sc_ * SHM_K, qr, r32, hi); amask(pB0, pB1, NT - 1, NT, wid, mode);
  finishSM<false>(pA0, pA1, alA, l_reg, pa0, pa1, pa2, pa3); A2_SBAR();
  pv_d0(o, vb0 + sp * (int)SHM_V, pa0, pa1, pa2, pa3); partialSM(pB0, pB1, m_reg, mnB, alB);
  A2_RESC(alB);
  finishSM(pB0, pB1, alB, l_reg, pa0, pa1, pa2, pa3); A2_SBAR();
  pv_d0(o, vb0 + sc_ * (int)SHM_V, pa0, pa1, pa2, pa3);
#undef A2_ROT
  if (hi == 0) li_l[r32] = l_reg; asm volatile("s_waitcnt lgkmcnt(0)" ::: "memory");
  float rli[16];
#pragma unroll
  for (int r = 0; r < 16; ++r) rli[r] = __builtin_amdgcn_rcpf(li_l[crow(r, hi)]);
  unsigned short* Ow = (unsigned short*)Ob + (long)(wid * QBLK) * LD;
#pragma unroll
  for (int r = 0; r < 16; ++r) { const int orow = crow(r, hi);
#pragma unroll
    for (int d0 = 0; d0 < 4; ++d0) Ow[(long)orow * LD + d0 * 32 + r32] = (unsigned short)(cvtpk(o[d0][r] * rli[r], 0.f) & 0xffffu); }
  __syncthreads();
#undef A2_SLOAD
#undef A2_SWRITE
#undef A2_SWAIT
#undef A2_RESC
}
#undef A2_KSWZ
#undef A2_SBAR
}
#define GAS __attribute__((address_space(1)))
#define LAS __attribute__((address_space(3)))
typedef unsigned short bf16;
typedef unsigned v4u __attribute__((ext_vector_type(4)));
typedef float f32x4 __attribute__((ext_vector_type(4)));
typedef short bf16x8 __attribute__((ext_vector_type(8)));
typedef GAS unsigned gu32;
typedef GAS unsigned long long gu64;
#define RLX_AGENT __ATOMIC_RELAXED, __HIP_MEMORY_SCOPE_AGENT
#define LDS_WAIT() asm volatile("s_waitcnt lgkmcnt(0)" ::: "memory")
#define VM_WAIT() asm volatile("s_waitcnt vmcnt(0)" ::: "memory")
__device__ __forceinline__ unsigned long long rt() { return __builtin_amdgcn_s_memrealtime(); }
__device__ __forceinline__ unsigned f2bf(float f) { unsigned u = __builtin_bit_cast(unsigned, f); return (u + 0x7fffu + ((u >> 16) & 1u)) >> 16; }
__device__ __forceinline__ unsigned pk2(float lo, float hi) { return f2bf(lo) | (f2bf(hi) << 16); }

#define XB_TMO      128
#define XB_XCNT(j)  (256  + 64 * (j))
#define XB_XSUB(j)  (1280 + 64 * (j))
#define XB_XGEN(j)  (2304 + 64 * (j))
#define XB_TOP      3328
#define XB_TOPGEN   3392
#define XCD_BAR_WORDS 3456
#define XB_SPIN_CAP (1u << 18)

__device__ __forceinline__ unsigned xb_ld(unsigned* p)              { return __hip_atomic_load(p, __ATOMIC_RELAXED, __HIP_MEMORY_SCOPE_AGENT); }
__device__ __forceinline__ unsigned xb_add(unsigned* p, unsigned v) { return __hip_atomic_fetch_add(p, v, __ATOMIC_RELAXED, __HIP_MEMORY_SCOPE_AGENT); }
__device__ __forceinline__ unsigned xb_xcc_id() { return (unsigned)__builtin_amdgcn_s_getreg((3 << 11) | 20) & 0xFu; }
#define XB_SPIN(cond, bar) do { unsigned _sp = 0; while (cond) { __builtin_amdgcn_s_sleep(1); \
    if ((++_sp & 255u) == 0u) { if (xb_ld(&(bar)[XB_TMO])) break; if (_sp > XB_SPIN_CAP) { atomicAdd(&(bar)[XB_TMO], 1u); break; } } } } while (0)

struct XcdBarrier {
    unsigned* bar; unsigned x;
    volatile LAS unsigned* st;
};

__device__ __forceinline__ XcdBarrier xcd_barrier_post(unsigned* bar, volatile LAS unsigned* st) {
    XcdBarrier b; b.bar = bar; b.x = xb_xcc_id(); b.st = st;
    if (threadIdx.x == 0) (void)xb_add(&bar[XB_XCNT(b.x)], 1u);
    return b;
}
__device__ __forceinline__ void xcd_barrier_complete(unsigned* bar, unsigned x, unsigned& nloc, unsigned& nx) {
    const unsigned G = gridDim.x * gridDim.y * gridDim.z;
    unsigned sum, cnt, mine, sp = 0u;
    for (;;) {
        sum = 0u; cnt = 0u; mine = 0u;
#pragma unroll
        for (unsigned j = 0; j < 16; ++j) { const unsigned c = xb_ld(&bar[XB_XCNT(j)]); sum += c; cnt += (c > 0u) ? 1u : 0u; mine = (j == x) ? c : mine; }
        if (sum == G) break;
        __builtin_amdgcn_s_sleep(1);
        if ((++sp & 255u) == 0u) { if (xb_ld(&bar[XB_TMO])) break; if (sp > XB_SPIN_CAP) { atomicAdd(&bar[XB_TMO], 1u); break; } }
    }
    nloc = mine > 0u ? mine : 1u; nx = cnt > 0u ? cnt : 1u;
}

__device__ __forceinline__ void xcd_barrier(const XcdBarrier& b) {
    asm volatile("s_waitcnt vmcnt(0)" ::: "memory");
    __syncthreads();
    if (threadIdx.x == 0) {
        unsigned* bar = b.bar;
        __builtin_amdgcn_s_waitcnt(0);
        unsigned nloc = b.st[0], nx = b.st[1];
        if (nloc == 0u) { xcd_barrier_complete(bar, b.x, nloc, nx); b.st[0] = nloc; b.st[1] = nx; }
        const unsigned old = xb_add(&bar[XB_XSUB(b.x)], 1u);
        const unsigned gen = old / nloc;
        if (old + 1u == (gen + 1u) * nloc) {
            __builtin_amdgcn_fence(__ATOMIC_RELEASE, "agent");
            asm volatile("s_waitcnt vmcnt(0)" ::: "memory");
            const unsigned og = xb_add(&bar[XB_TOP], 1u);
            const unsigned tg = og / nx;
            if (og + 1u == (tg + 1u) * nx) xb_add(&bar[XB_TOPGEN], 1u);
            else XB_SPIN(xb_ld(&bar[XB_TOPGEN]) == tg, bar);
            __builtin_amdgcn_fence(__ATOMIC_ACQUIRE, "agent");
            xb_add(&bar[XB_XGEN(b.x)], 1u);
            asm volatile("s_waitcnt vmcnt(0)" ::: "memory");
        } else {
            XB_SPIN(xb_ld(&bar[XB_XGEN(b.x)]) == gen, bar);
            __builtin_amdgcn_fence(__ATOMIC_ACQUIRE, "agent");
            asm volatile("s_waitcnt vmcnt(0)" ::: "memory");
        }
    }
    __syncthreads();
}

constexpr int NWAVES = 8;
using pg8::MP; using pg8::MS; using pg8::MV; using pg8::MPAD; using pg8::RWIN; using pg8::DFW; using pg8::FF; using pg8::FF2; using pg8::DM; using pg8::INDIM;
using pg8::O_YP; using pg8::O_YS; using pg8::O_KP; using pg8::O_VP; using pg8::O_SHP; using pg8::O_WKVP; using pg8::O_FCP; using pg8::O_KS; using pg8::O_VS; using pg8::O_SHS; using pg8::O_WKVS; using pg8::O_FCS;
typedef unsigned u32x2 __attribute__((ext_vector_type(2)));
typedef float f32x2 __attribute__((ext_vector_type(2)));

constexpr size_t MiB = 1u << 20;
constexpr size_t WS_CTL = 0, CTL_ZERO_BYTES = 32768;
constexpr size_t WS_WIN = 2 * MiB, WS_WOUT = 9 * MiB, WS_WUP = 11 * MiB, WS_WDN = 22 * MiB;
constexpr size_t WS_WWT = 28 * MiB, WS_WAT = WS_WWT + 65536, WS_WGT = WS_WAT + 65536;
constexpr size_t WS_ROPE = 28 * MiB + 512 * 1024;
constexpr size_t WS_XN = 30 * MiB;
constexpr size_t WS_PRW = 95 * MiB;
constexpr size_t WS_QB = 208 * MiB, WS_KB = 240 * MiB, WS_VB = 272 * MiB;
constexpr size_t WS_QS = 304 * MiB, WS_KS = 306 * MiB, WS_VS = 339 * MiB;
constexpr size_t WS_MT2 = 372 * MiB;
constexpr size_t WS_END = 512 * MiB;
constexpr int CW_TMO = 0, CW_CODE = 1, CW_BAR = 4096;

constexpr int RING_OFF = 0, RING_BYTES = 131072;
constexpr int LDSCTL_OFF = 159744, MISC_OFF = LDSCTL_OFF + 320;
constexpr int LDS_BYTES = 163840;

struct Frame {
    LAS unsigned char* lds;
    volatile LAS unsigned* MISC;
    gu32* ctl;
    int tid, lane, wave;
    int vcu, G;
    __device__ __forceinline__ const float* inp(int i) const { return ((const float* const __attribute__((address_space(4)))*)__builtin_amdgcn_kernarg_segment_ptr())[i]; }
    float* out;
    unsigned char* ws;
};
enum { I_XP = 0, I_XS, I_CK, I_CV, I_SSH, I_SWKV, I_SFC, I_N1G, I_WIN, I_MU, I_W0, I_WW2, I_A0, I_AW2, I_GW2, I_KK, I_KA, I_RK, I_GNG, I_GNB,
       I_QG, I_KG, I_LQ1, I_LK1, I_LQ2, I_LK2, I_SUBG, I_WOUT, I_N2G, I_WUP, I_CW, I_CB, I_WDN };

__device__ __forceinline__ float wave_sum(float v) {
#pragma unroll
    for (int o = 1; o < 64; o <<= 1) v += __shfl_xor(v, o);
    return v;
}

__device__ __forceinline__ void p0_transpose_item(const float* W, int K, int N, bf16* WT, int k0, int n0_src, int n0_dst, const float* gain, LAS float* scr, int lane) {
#pragma unroll 8
    for (int i = 0; i < 32; ++i) { const int kk = 2 * i + (lane >> 5); float w = W[(size_t)(k0 + kk) * N + n0_src + (lane & 31)]; if (gain) w *= gain[k0 + kk]; scr[kk * 33 + (lane & 31)] = w; }
    LDS_WAIT(); asm volatile("" ::: "memory");
    const int c = lane & 7;
#pragma unroll
    for (int j = 0; j < 4; ++j) { const int n = (lane >> 3) + 8 * j; const LAS float* s = scr + (8 * c) * 33 + n;
        v4u o; o.x = pk2(s[0 * 33], s[1 * 33]); o.y = pk2(s[2 * 33], s[3 * 33]); o.z = pk2(s[4 * 33], s[5 * 33]); o.w = pk2(s[6 * 33], s[7 * 33]);
        *(GAS v4u*)(WT + (size_t)(n0_dst + n) * K + k0 + 8 * c) = o; }
    LDS_WAIT(); asm volatile("" ::: "memory");
}
__device__ __forceinline__ void rms_row_to_bf16(int lane, const float* xrow, bf16* orow) {
    const GAS f32x4* xr = (const GAS f32x4*)xrow + lane;
    f32x4 v[4]; float s = 0.f;
#pragma unroll
    for (int j = 0; j < 4; ++j) { v[j] = xr[64 * j]; s += (v[j].x * v[j].x + v[j].y * v[j].y) + (v[j].z * v[j].z + v[j].w * v[j].w); }
    const float rstd = 1.f / sqrtf(wave_sum(s) * (1.f / 1024.f) + 1e-6f);
    GAS unsigned long long* o8 = (GAS unsigned long long*)orow + lane;
#pragma unroll
    for (int j = 0; j < 4; ++j) o8[64 * j] = (unsigned long long)pk2(v[j].x * rstd, v[j].y * rstd) | ((unsigned long long)pk2(v[j].z * rstd, v[j].w * rstd) << 32);
}
__device__ __forceinline__ void rms_row2_to_bf16(int lane, const float* x0, bf16* o0, const float* x1, bf16* o1) {
    const GAS f32x4* xa = (const GAS f32x4*)x0 + lane; const GAS f32x4* xb = (const GAS f32x4*)x1 + lane;
    f32x4 va[4], vb[4]; float sa = 0.f, sb = 0.f;
#pragma unroll
    for (int j = 0; j < 4; ++j) { va[j] = xa[64 * j]; vb[j] = xb[64 * j]; }
#pragma unroll
    for (int j = 0; j < 4; ++j) { sa += (va[j].x * va[j].x + va[j].y * va[j].y) + (va[j].z * va[j].z + va[j].w * va[j].w); sb += (vb[j].x * vb[j].x + vb[j].y * vb[j].y) + (vb[j].z * vb[j].z + vb[j].w * vb[j].w); }
    const float ra = 1.f / sqrtf(wave_sum(sa) * (1.f / 1024.f) + 1e-6f), rb = 1.f / sqrtf(wave_sum(sb) * (1.f / 1024.f) + 1e-6f);
    GAS unsigned long long* pa = (GAS unsigned long long*)o0 + lane; GAS unsigned long long* pb = (GAS unsigned long long*)o1 + lane;
#pragma unroll
    for (int j = 0; j < 4; ++j) { pa[64 * j] = (unsigned long long)pk2(va[j].x * ra, va[j].y * ra) | ((unsigned long long)pk2(va[j].z * ra, va[j].w * ra) << 32);
        pb[64 * j] = (unsigned long long)pk2(vb[j].x * rb, vb[j].y * rb) | ((unsigned long long)pk2(vb[j].z * rb, vb[j].w * rb) << 32); }
}
__device__ __forceinline__ void sincos_d(double a, float& sn, float& cs) {
    const double k = __builtin_rint(a * 0.3183098861837907);
    const double r = __builtin_fma(-k, 3.141592653589793, a) - k * 1.2246467991473532e-16;
    const double r2 = r * r;
    double s = -1.0 / 121645100408832000.0;
    s = s * r2 + 1.0 / 355687428096000.0;
    s = s * r2 - 1.0 / 1307674368000.0;
    s = s * r2 + 1.0 / 6227020800.0;
    s = s * r2 - 1.0 / 39916800.0;
    s = s * r2 + 1.0 / 362880.0;
    s = s * r2 - 1.0 / 5040.0;
    s = s * r2 + 1.0 / 120.0;
    s = s * r2 - 1.0 / 6.0;
    s = s * r2 + 1.0; s = s * r;
    double c = -1.0 / 6402373705728000.0;
    c = c * r2 + 1.0 / 20922789888000.0;
    c = c * r2 - 1.0 / 87178291200.0;
    c = c * r2 + 1.0 / 479001600.0;
    c = c * r2 - 1.0 / 3628800.0;
    c = c * r2 + 1.0 / 40320.0;
    c = c * r2 - 1.0 / 720.0;
    c = c * r2 + 1.0 / 24.0;
    c = c * r2 - 0.5;
    c = c * r2 + 1.0;
    const bool odd = (((long long)k) & 1) != 0;
    sn = (float)(odd ? -s : s); cs = (float)(odd ? -c : c);
}
__device__ __forceinline__ void p0_urgent(Frame& F) {
    LAS float* scr = (LAS float*)(F.lds + RING_OFF + F.wave * 16384);
    const int gw = F.vcu * NWAVES + F.wave, NGW = F.G * NWAVES;
    bf16* Win_t = (bf16*)(F.ws + WS_WIN);
    constexpr int I_IN = 16 * 104;
    for (int r = gw; r < I_IN; r += NGW) { const int kb = r / 104, nb = r % 104, pn = nb >> 3, pb = nb & 7; const int sb = (pn < 7) ? nb : 8 * pn + 2 * (pb & 3) + (pb >> 2);
        p0_transpose_item(F.inp(I_WIN), 1024, INDIM, Win_t, 64 * kb, 32 * sb, 32 * nb, F.inp(I_N1G), scr, F.lane); }
    bf16* XN = (bf16*)(F.ws + WS_XN);
    {   const float* xp = F.inp(I_XP); const float* xs = F.inp(I_XS);
        int m = gw;
        for (; m + NGW < MP; m += 2 * NGW) rms_row2_to_bf16(F.lane, xp + (size_t)m * DM, XN + (size_t)m * DM, xp + (size_t)(m + NGW) * DM, XN + (size_t)(m + NGW) * DM);
        for (; m < MPAD; m += NGW) {
            if (m < MP) rms_row_to_bf16(F.lane, xp + (size_t)m * DM, XN + (size_t)m * DM);
            else if (m < MV) rms_row_to_bf16(F.lane, xs + (size_t)(m - MP) * DM, XN + (size_t)m * DM);
            else { GAS v4u* o = (GAS v4u*)(XN + (size_t)m * DM) + F.lane; o[0] = (v4u){0u, 0u, 0u, 0u}; o[64] = (v4u){0u, 0u, 0u, 0u}; }
        }
    }
    const int gt = (F.vcu * NWAVES + F.wave) * 64 + F.lane, NGT = NGW * 64;
    {
        bf16* Ks = (bf16*)(F.ws + WS_KS); bf16* Vs = (bf16*)(F.ws + WS_VS);
        constexpr int NZ = 8 * 112 * 64;
        for (int it = gt; it < 2 * NZ; it += NGT) { const int w = it >= NZ, i = w ? it - NZ : it; const int rowi = i >> 6, ch = i & 63, b = rowi / 112, p = 4112 + rowi % 112;
            *(GAS v4u*)((w ? Vs : Ks) + ((size_t)b * 4224 + p) * 512 + ch * 8) = (v4u){0u, 0u, 0u, 0u}; }
        bf16* Qs = (bf16*)(F.ws + WS_QS);
        constexpr int NQ = 8 * 240 * 64;
        for (int it = gt; it < NQ; it += NGT) { const int rowi = it >> 6, ch = it & 63, b = rowi / 240, p = 16 + rowi % 240;
            *(GAS v4u*)(Qs + ((size_t)b * 256 + p) * 512 + ch * 8) = (v4u){0u, 0u, 0u, 0u}; }
    }
    {   bf16* WwT = (bf16*)(F.ws + WS_WWT); bf16* WaT = (bf16*)(F.ws + WS_WAT); bf16* WgT = (bf16*)(F.ws + WS_WGT);
        for (int it = gt; it < 512 * 64; it += NGT) { const int ch = it >> 6, m = it & 63; WwT[it] = (bf16)f2bf(F.inp(I_WW2)[(size_t)m * 512 + ch]); WaT[it] = (bf16)f2bf(F.inp(I_AW2)[(size_t)m * 512 + ch]); }
        for (int it = gt; it < 512 * 128; it += NGT) { const int ch = it >> 7, m = it & 127; WgT[it] = (bf16)f2bf(F.inp(I_GW2)[(size_t)m * 512 + ch]); }
    }
    {   float* cs = (float*)(F.ws + WS_ROPE);
        for (int it = gt; it < 8192 * 8; it += NGT) { const int pos = it >> 3, i = it & 7;
            const double inv = i == 0 ? 1.0 : i == 1 ? 0.19392274474868576 : i == 2 ? 0.03760603093086393 : i == 3 ? 0.007292664737217109 : i == 4 ? 0.001414213562373095 : i == 5 ? 0.0002742481756762073 : i == 6 ? 5.318295896944988e-05 : 1.031338537721246e-05;
            float sn, c; sincos_d((double)pos * inv, sn, c); cs[pos * 16 + i] = c; cs[pos * 16 + 8 + i] = sn; }
    }
}
constexpr int CACHE_ITEMS = 2 * 8 * 4096 * 64, CACHE_SPLIT = (CACHE_ITEMS / 100) * 55;
__device__ __forceinline__ void cache_convert(Frame& F, int part, int nparts, int lo, int hi) {
    const int gt = (part * NWAVES + F.wave) * 64 + F.lane, NGT = nparts * NWAVES * 64;
    bf16* Ks = (bf16*)(F.ws + WS_KS); bf16* Vs = (bf16*)(F.ws + WS_VS);
    constexpr int NIT = 8 * 4096 * 64;
    const float* ck = F.inp(I_CK); const float* cv = F.inp(I_CV);
    for (int it0 = lo + gt; it0 < hi; it0 += 4 * NGT) {
        f32x4 a[4], c[4];
#pragma unroll
        for (int q = 0; q < 4; ++q) { const int it = it0 + q * NGT; if (it < hi) { const int w = it >= NIT, i = w ? it - NIT : it; const GAS f32x4* src = (const GAS f32x4*)((w ? cv : ck) + (size_t)i * 8); a[q] = src[0]; c[q] = src[1]; } }
#pragma unroll
        for (int q = 0; q < 4; ++q) { const int it = it0 + q * NGT; if (it < hi) { const int w = it >= NIT, i = w ? it - NIT : it; const int rowi = i >> 6, ch = i & 63, b = rowi >> 12, p = rowi & 4095;
            v4u o; o.x = pk2(a[q].x, a[q].y); o.y = pk2(a[q].z, a[q].w); o.z = pk2(c[q].x, c[q].y); o.w = pk2(c[q].z, c[q].w);
            *(GAS v4u*)((w ? Vs : Ks) + ((size_t)b * 4224 + p) * 512 + ch * 8) = o; } }
    }
}
__device__ __forceinline__ void p0_deferred(Frame& F, int part, int nparts) {
    LAS float* scr = (LAS float*)(F.lds + RING_OFF + F.wave * 16384);
    const int gw = part * NWAVES + F.wave, NGW = nparts * NWAVES;
    bf16* Wout_t = (bf16*)(F.ws + WS_WOUT); bf16* Wup_t = (bf16*)(F.ws + WS_WUP); bf16* Wdn_t = (bf16*)(F.ws + WS_WDN);
    constexpr int I_OUT = 16 * 32, I_UP = 16 * 176, I_DN = 44 * 32, NITEMS = I_OUT + I_UP + I_DN;
    for (int it = gw; it < NITEMS; it += NGW) {
        int r = it;
        if (r < I_OUT) { const int kb = r / 32, nb = r % 32; p0_transpose_item(F.inp(I_WOUT), 1024, 1024, Wout_t, 64 * kb, 32 * nb, 32 * nb, nullptr, scr, F.lane); continue; } r -= I_OUT;
        if (r < I_UP) { const int kb = r / 176, nb = r % 176, pn = nb >> 3, pb = nb & 7; const int sb = (pb >> 2) * 88 + 4 * pn + (pb & 3);
            p0_transpose_item(F.inp(I_WUP), 1024, FF2, Wup_t, 64 * kb, 32 * sb, 32 * nb, F.inp(I_N2G), scr, F.lane); continue; } r -= I_UP;
        { const int kb = r / 32, nb = r % 32; p0_transpose_item(F.inp(I_WDN), FF, 1024, Wdn_t, 64 * kb, 32 * nb, 32 * nb, nullptr, scr, F.lane); }
    }
}

namespace rw {
constexpr int NUNIT = 4096 + 64;
constexpr int TP = 80, TB = 64 * TP * 2;
constexpr int GP = 144;
constexpr int MT_BYTES = TB, MD_BYTES = MT_BYTES + 17408;
constexpr size_t WS_QT = 372 * MiB, WS_YL = 413 * MiB, WS_S0 = 446 * MiB;
constexpr size_t WS_G = WS_XN, WS_E1 = WS_XN + (size_t)MPAD * 512 * 2;
constexpr int MISC = 14 * TB;
static_assert(MISC + 2304 <= LDSCTL_OFF, "rwkv LDS map");
constexpr int PT_OFF = MISC + 2304, PT_W0 = 1536, PT_A0 = 2048, PT_KK = 2560, PTK_OFF = LDS_BYTES - 2048;
static_assert(PT_OFF + 3072 * 4 <= LDSCTL_OFF && PTK_OFF >= MISC_OFF + 256, "rwkv parameter table");
static_assert(WS_S0 + (size_t)NUNIT * TB <= WS_END && WS_QT + (size_t)NUNIT * TB <= WS_YL && WS_YL + (size_t)NUNIT * 8192 <= WS_S0, "rwkv ws map");
static_assert((size_t)NUNIT * MD_BYTES <= (size_t)33554432 * 4, "MD records fit the y_prompt region of d_out");

constexpr size_t WS_A2 = 488 * MiB;
static_assert(WS_A2 + (size_t)MPAD * 256 * 2 <= WS_END, "A2 fits");
typedef unsigned short ub16;
#define RW_TILE(i) ((LAS ub16*)(lds + (i) * rw::TB))
__device__ __forceinline__ float sigmoidf_(float x) { return __builtin_amdgcn_rcpf(1.0f + __expf(-x)); }
typedef float f32x2_t __attribute__((ext_vector_type(2))); typedef __bf16 bf16x2_t __attribute__((ext_vector_type(2)));
__device__ __forceinline__ unsigned cvtpk(float lo, float hi) { f32x2_t v = {lo, hi}; bf16x2_t b = __builtin_convertvector(v, bf16x2_t); return __builtin_bit_cast(unsigned, b); }
__device__ __forceinline__ float bflo(unsigned w) { return __uint_as_float(w << 16); }
__device__ __forceinline__ float bfhi(unsigned w) { return __uint_as_float(w & 0xffff0000u); }
__device__ __forceinline__ f32x4 unpack4(u32x2 w) { return (f32x4){bflo(w.x), bfhi(w.x), bflo(w.y), bfhi(w.y)}; }
__device__ __forceinline__ u32x2 pack4(f32x4 v) { u32x2 w; w.x = cvtpk(v[0], v[1]); w.y = cvtpk(v[2], v[3]); return w; }

template <int KS>
__device__ __forceinline__ void mm(f32x4 (&acc)[2], const LAS ub16* A, int lda, const LAS ub16* Bt, int ldb, int mt, int nh, int fr, int fq) {
#pragma unroll
    for (int ks = 0; ks < KS; ++ks) {
        const bf16x8 af = *(const LAS bf16x8*)(A + (16 * mt + fr) * lda + 32 * ks + 8 * fq);
#pragma unroll
        for (int nt = 0; nt < 2; ++nt) {
            const bf16x8 bfr = *(const LAS bf16x8*)(Bt + (32 * nh + 16 * nt + fr) * ldb + 32 * ks + 8 * fq);
            acc[nt] = __builtin_amdgcn_mfma_f32_16x16x32_bf16(bfr, af, acc[nt], 0, 0, 0);
        }
    }
}
struct FrA { bf16x8 k[2]; };
struct FrB { bf16x8 k[2][2]; };
__device__ __forceinline__ void ldA(FrA& f, const LAS ub16* A, int mt, int fr, int fq) {
#pragma unroll
    for (int ks = 0; ks < 2; ++ks) f.k[ks] = *(const LAS bf16x8*)(A + (16 * mt + fr) * TP + 32 * ks + 8 * fq);
}
__device__ __forceinline__ void ldB(FrB& f, const LAS ub16* Bt, int nh, int fr, int fq) {
#pragma unroll
    for (int ks = 0; ks < 2; ++ks)
#pragma unroll
        for (int nt = 0; nt < 2; ++nt) f.k[ks][nt] = *(const LAS bf16x8*)(Bt + (32 * nh + 16 * nt + fr) * TP + 32 * ks + 8 * fq);
}
__device__ __forceinline__ void mmf(f32x4 (&acc)[2], const FrA& a, const FrB& b) {
#pragma unroll
    for (int ks = 0; ks < 2; ++ks)
#pragma unroll
        for (int nt = 0; nt < 2; ++nt) acc[nt] = __builtin_amdgcn_mfma_f32_16x16x32_bf16(b.k[ks][nt], a.k[ks], acc[nt], 0, 0, 0);
}
#define RW_FENCE() __builtin_amdgcn_sched_barrier(0)
#define RW_ZERO(acc) do { acc[0] = (f32x4){0.f, 0.f, 0.f, 0.f}; acc[1] = (f32x4){0.f, 0.f, 0.f, 0.f}; } while (0)
#define RW_BAR() do { asm volatile("s_waitcnt lgkmcnt(0)" ::: "memory"); __builtin_amdgcn_s_barrier(); asm volatile("" ::: "memory"); } while (0)
#ifdef DBG_R1CHK
#define RW_CHK(acc, bit) do { bool ok_ = true; _Pragma("unroll") for (int q_ = 0; q_ < 2; ++q_) _Pragma("unroll") for (int e_ = 0; e_ < 4; ++e_) ok_ = ok_ && (fabsf(acc[q_][e_]) < 1e30f); if (!ok_) atomicOr((unsigned*)(F.ctl + 9), (unsigned)(bit)); } while (0)
#else
#define RW_CHK(acc, bit) do {} while (0)
#endif
template <int CTRL> __device__ __forceinline__ float dpp_shr0(float x) { return __builtin_bit_cast(float, __builtin_amdgcn_update_dpp(0, __builtin_bit_cast(int, x), CTRL, 0xf, 0xf, true)); }
__device__ __forceinline__ u32x2 quad_tr(u32x2 w, int fr) {
    const unsigned sel = (fr & 1) ? 0x03020706u : 0x05040100u;
    const unsigned a = (unsigned)__builtin_amdgcn_update_dpp(0, (int)w.x, 0xB1, 0xf, 0xf, false);
    const unsigned b = (unsigned)__builtin_amdgcn_update_dpp(0, (int)w.y, 0xB1, 0xf, 0xf, false);
    const unsigned u0 = __builtin_amdgcn_perm(a, w.x, sel), u1 = __builtin_amdgcn_perm(b, w.y, sel);
    const unsigned t0 = (unsigned)__builtin_amdgcn_update_dpp(0, (int)u0, 0x4E, 0xf, 0xf, false);
    const unsigned t1 = (unsigned)__builtin_amdgcn_update_dpp(0, (int)u1, 0x4E, 0xf, 0xf, false);
    u32x2 y; y.x = (fr & 2) ? t1 : u0; y.y = (fr & 2) ? u1 : t0; return y;
}
__device__ __forceinline__ void st_tile(LAS ub16* T, const f32x4 (&acc)[2], int m, int n0) {
#pragma unroll
    for (int nt = 0; nt < 2; ++nt) *(LAS u32x2*)(T + m * TP + n0 + 16 * nt) = pack4(acc[nt]);
}

__device__ __forceinline__ void st_tile_T(LAS ub16* T, const f32x4 (&acc)[2], int m, int n0, int fr) {
#pragma unroll
    for (int nt = 0; nt < 2; ++nt) { const u32x2 w = quad_tr(pack4(acc[nt]), fr); *(LAS u32x2*)(T + (n0 + 16 * nt + (fr & 3)) * TP + (m & ~3)) = w; }
}

__device__ __forceinline__ void a2_pass(Frame& F) {
    const int gt = (F.vcu * NWAVES + F.wave) * 64 + F.lane, NGT = F.G * NWAVES * 64;
    const ub16* Prw = (const ub16*)(F.ws + WS_PRW); ub16* A2 = (ub16*)(F.ws + WS_A2);
    const float* mu = F.inp(I_MU) + 1536; const float* ssh = F.inp(I_SSH);
    for (int it = gt; it < MV * 32; it += NGT) {
        const int r = it >> 5, cgp = it & 31, col = 8 * cgp;
        const bool samp = r >= MP; const int t = samp ? ((r - MP) & 15) : (r & 8191);
        const v4u cw = *(const GAS v4u*)(Prw + (size_t)r * RWIN + 1536 + col);
        float cur[8] = {bflo(cw.x), bfhi(cw.x), bflo(cw.y), bfhi(cw.y), bflo(cw.z), bfhi(cw.z), bflo(cw.w), bfhi(cw.w)};
        float prv[8];
        if (t > 0) { const v4u pw = *(const GAS v4u*)(Prw + (size_t)(r - 1) * RWIN + 1536 + col); prv[0] = bflo(pw.x); prv[1] = bfhi(pw.x); prv[2] = bflo(pw.y); prv[3] = bfhi(pw.y); prv[4] = bflo(pw.z); prv[5] = bfhi(pw.z); prv[6] = bflo(pw.w); prv[7] = bfhi(pw.w); }
        else if (samp) { const float* sp = ssh + (size_t)((r - MP) >> 4) * RWIN + 1536 + col;
#pragma unroll
            for (int e = 0; e < 8; ++e) prv[e] = sp[e]; }
        else {
#pragma unroll
            for (int e = 0; e < 8; ++e) prv[e] = 0.f; }
        const f32x4 m0 = *(const GAS f32x4*)(mu + col), m1 = *(const GAS f32x4*)(mu + col + 4);
        float z[8];
#pragma unroll
        for (int e = 0; e < 8; ++e) { const float m_ = e < 4 ? m0[e] : m1[e - 4]; z[e] = cur[e] + (prv[e] - cur[e]) * m_;
            if (col < 64) { const float ex = __expf(2.0f * z[e]); z[e] = 1.0f - 2.0f / (ex + 1.0f); }
            else if (col >= 128) z[e] = sigmoidf_(z[e]); }
        v4u o; o.x = cvtpk(z[0], z[1]); o.y = cvtpk(z[2], z[3]); o.z = cvtpk(z[4], z[5]); o.w = cvtpk(z[6], z[7]);
        *(GAS v4u*)(A2 + (size_t)r * 256 + col) = o;
    }
}

__device__ __forceinline__ void r1_param_table(Frame& F) {
    LAS float* pt = (LAS float*)(F.lds + PT_OFF); LAS float* pk = (LAS float*)(F.lds + PTK_OFF);
    const int tid = F.tid;
    const float* mu = F.inp(I_MU);
    pt[tid] = mu[tid]; pt[512 + tid] = mu[512 + tid]; pt[1024 + tid] = mu[1024 + tid];
    pt[PT_W0 + tid] = F.inp(I_W0)[tid]; pt[PT_A0 + tid] = F.inp(I_A0)[tid]; pt[PT_KK + tid] = F.inp(I_KK)[tid]; pk[tid] = F.inp(I_KA)[tid];
    __syncthreads();
}
__device__ __forceinline__ void lora_inputs(Frame& F, bool samp, int sb, int c, int row0, v4u (&xq)[4]) {
    const int tid = F.tid, tl = tid >> 3, cg = tid & 7; const bool hp = samp ? (tl > 0) : (c > 0 || tl > 0);
    const ub16* pr = (const ub16*)(F.ws + WS_PRW) + (size_t)(row0 + tl) * RWIN + 1536 + 32 * cg;
    const float* mu = F.inp(I_MU) + 1536 + 32 * cg;
#pragma unroll
    for (int q = 0; q < 4; ++q) {
        const v4u cw = *(const GAS v4u*)(pr + 8 * q);
        float cur[8] = {bflo(cw.x), bfhi(cw.x), bflo(cw.y), bfhi(cw.y), bflo(cw.z), bfhi(cw.z), bflo(cw.w), bfhi(cw.w)};
        float prv[8];
        if (hp) { const v4u pw = *(const GAS v4u*)(pr - RWIN + 8 * q); prv[0] = bflo(pw.x); prv[1] = bfhi(pw.x); prv[2] = bflo(pw.y); prv[3] = bfhi(pw.y); prv[4] = bflo(pw.z); prv[5] = bfhi(pw.z); prv[6] = bflo(pw.w); prv[7] = bfhi(pw.w); }
        else if (samp) { const float* sp = F.inp(I_SSH) + (size_t)sb * RWIN + 1536 + 32 * cg + 8 * q;
#pragma unroll
            for (int e = 0; e < 8; ++e) prv[e] = sp[e]; }
        else {
#pragma unroll
            for (int e = 0; e < 8; ++e) prv[e] = 0.f; }
        const f32x4 m0 = *(const GAS f32x4*)(mu + 8 * q), m1 = *(const GAS f32x4*)(mu + 8 * q + 4);
        float z[8];
#pragma unroll
        for (int e = 0; e < 8; ++e) { const float m_ = e < 4 ? m0[e] : m1[e - 4]; z[e] = cur[e] + (prv[e] - cur[e]) * m_;
            const float sg = __builtin_amdgcn_rcpf(1.0f + __expf(cg < 2 ? -2.0f * z[e] : -z[e]));
            z[e] = (cg < 2) ? 2.0f * sg - 1.0f : ((cg >= 4) ? sg : z[e]); }
        v4u o; o.x = cvtpk(z[0], z[1]); o.y = cvtpk(z[2], z[3]); o.z = cvtpk(z[4], z[5]); o.w = cvtpk(z[6], z[7]);
        xq[q] = o;
    }
}

struct R1Raw { u32x2 cur[2][3], prv[2][3]; v4u wts[4]; };
__device__ __forceinline__ void r1_decode(int u, bool& samp, int& sb, int& h, int& c, int& row0) {
    samp = u >= 4096; const int us = u - 4096;
    sb = samp ? (us >> 3) : (u >> 10); h = samp ? (us & 7) : ((u >> 7) & 7); c = samp ? 0 : (u & 127);
    row0 = samp ? (MP + 16 * sb) : (sb * 8192 + 64 * c);
}
__device__ __forceinline__ void r1_load(Frame& F, int u, R1Raw& R) {
    const int tid = F.tid, w = F.wave, lane = F.lane, mt = w >> 1, nh = w & 1, fr = lane & 15, fq = lane >> 4;
    bool samp; int sb, h, c, row0; r1_decode(u, samp, sb, h, c, row0);
    const ub16* Prw = (const ub16*)(F.ws + WS_PRW);
    const int t = 16 * mt + fr, n0 = 32 * nh + 4 * fq;
    const bool hasprev = samp ? (t > 0) : (c > 0 || t > 0);
    const ub16* pr = Prw + (size_t)(row0 + t) * RWIN + h * 64 + n0;
    const ub16* pp = hasprev ? pr - RWIN : pr;
#pragma unroll
    for (int nt = 0; nt < 2; ++nt)
#pragma unroll
        for (int x = 0; x < 3; ++x) { R.cur[nt][x] = *(const GAS u32x2*)(pr + x * 512 + 16 * nt); R.prv[nt][x] = *(const GAS u32x2*)(pp + x * 512 + 16 * nt); }
    const int wrow = tid >> 3, wch = tid & 7;
    R.wts[0] = *(const GAS v4u*)((const ub16*)(F.ws + WS_WWT) + (size_t)(h * 64 + wrow) * 64 + 8 * wch);
    R.wts[1] = *(const GAS v4u*)((const ub16*)(F.ws + WS_WAT) + (size_t)(h * 64 + wrow) * 64 + 8 * wch);
    R.wts[2] = *(const GAS v4u*)((const ub16*)(F.ws + WS_WGT) + (size_t)(h * 64 + wrow) * 128 + 8 * wch);
    R.wts[3] = *(const GAS v4u*)((const ub16*)(F.ws + WS_WGT) + (size_t)(h * 64 + wrow) * 128 + 64 + 8 * wch);
}
__device__ __forceinline__ void r1_unit(Frame& F, int u, R1Raw& R, int unext, const v4u (&xq)[4], const int cut = 99, const int cit = 0) {
    LAS unsigned char* lds = F.lds;
    int lane = F.lane; asm volatile("" : "+v"(lane));
    const int w = F.wave, tid = w * 64 + lane, mt = w >> 1, nh = w & 1, fr = lane & 15, fq = lane >> 4;
    bool samp; int sb, h, c, row0; r1_decode(u, samp, sb, h, c, row0);
    const int t = 16 * mt + fr, n0 = 32 * nh + 4 * fq;
    const bool valid = !samp || t < 16;
    const bool hasprev = samp ? (t > 0) : (c > 0 || t > 0);
    f32x4 r_[2], k_[2], v_[2];
#pragma unroll
    for (int nt = 0; nt < 2; ++nt)
#pragma unroll
        for (int x = 0; x < 3; ++x) {
            const int col = x * 512 + h * 64 + n0 + 16 * nt;
            const f32x4 cur = unpack4(R.cur[nt][x]);
            f32x4 prv = unpack4(R.prv[nt][x]);
            if (samp || c == 0) { if (!hasprev) prv = (f32x4){0.f, 0.f, 0.f, 0.f}; }
            if (samp && t == 0) prv = *(const GAS f32x4*)(F.inp(I_SSH) + (size_t)sb * RWIN + col);
            const f32x4 mu = *(const LAS f32x4*)((LAS float*)(lds + PT_OFF) + col);
            const f32x4 z = cur + (prv - cur) * mu;
            if (x == 0) r_[nt] = z; else if (x == 1) k_[nt] = z; else v_[nt] = z;
        }
    {   const int tl = tid >> 3, cg = tid & 7;
        LAS ub16* dst = (cg < 2) ? RW_TILE(0) + tl * TP + 32 * cg : (cg < 4) ? RW_TILE(1) + tl * TP + 32 * (cg - 2) : RW_TILE(2) + tl * GP + 32 * (cg - 4);
#pragma unroll
        for (int q = 0; q < 4; ++q) *(LAS v4u*)(dst + 8 * q) = xq[q];
        const int wrow = tid >> 3, wch = tid & 7;
        *(LAS v4u*)(RW_TILE(4) + wrow * TP + 8 * wch) = R.wts[0]; *(LAS v4u*)(RW_TILE(5) + wrow * TP + 8 * wch) = R.wts[1];
        *(LAS v4u*)(RW_TILE(6) + wrow * GP + 8 * wch) = R.wts[2]; *(LAS v4u*)(RW_TILE(6) + wrow * GP + 64 + 8 * wch) = R.wts[3];
    }
    f32x4 prk[2], pgg[2], pgb[2];
#pragma unroll
    for (int nt = 0; nt < 2; ++nt) { const int hc = h * 64 + n0 + 16 * nt;
        prk[nt] = *(const GAS f32x4*)(F.inp(I_RK) + hc); pgg[nt] = *(const GAS f32x4*)(F.inp(I_GNG) + hc); pgb[nt] = *(const GAS f32x4*)(F.inp(I_GNB) + hc); }
    __builtin_amdgcn_sched_barrier(0);
    r1_load(F, unext >= 0 ? unext : u, R);
    RW_BAR();
    if (cut <= 1) { RW_BAR(); return; }
    f32x4 lwa[2], laa[2], ga[2];
    RW_ZERO(lwa); RW_ZERO(laa); RW_ZERO(ga);
    mm<2>(lwa, RW_TILE(0), TP, RW_TILE(4), TP, mt, nh, fr, fq);
    mm<2>(laa, RW_TILE(1), TP, RW_TILE(5), TP, mt, nh, fr, fq);
    mm<4>(ga, RW_TILE(2), GP, RW_TILE(6), GP, mt, nh, fr, fq);
    if (cut <= 2) { if (lwa[0][0] + laa[1][1] + ga[0][2] == 1.2345f) F.MISC[1] = 1; RW_BAR(); return; }
    LAS float* red = (LAS float*)(lds + MISC); LAS float* tot = red + 256; LAS float* gC = tot + 256;
    f32x4 pw0[2], pa0[2], pkk[2], pka[2];
#pragma unroll
    for (int nt = 0; nt < 2; ++nt) { const int hc = h * 64 + n0 + 16 * nt; LAS float* pt = (LAS float*)(lds + PT_OFF);
        pw0[nt] = *(const LAS f32x4*)(pt + PT_W0 + hc); pa0[nt] = *(const LAS f32x4*)(pt + PT_A0 + hc); pkk[nt] = *(const LAS f32x4*)(pt + PT_KK + hc); pka[nt] = *(const LAS f32x4*)((LAS float*)(lds + PTK_OFF) + hc); }
    f32x4 lw[2], a_[2], kk[2], kp[2], g_[2], L[2];
    float ssq = 0.f, bcs = 0.f;
#pragma unroll
    for (int nt = 0; nt < 2; ++nt) {
        const f32x4 zw = pw0[nt] + lwa[nt], za = pa0[nt] + laa[nt];
        f32x4 sw, sa;
#pragma unroll
        for (int e = 0; e < 4; ++e) { sw[e] = sigmoidf_(zw[e]); sa[e] = sigmoidf_(za[e]); }
        lw[nt] = sw * -0.6065306597126334f; a_[nt] = sa;
        kk[nt] = k_[nt] * pkk[nt];
        kp[nt] = k_[nt] * ((sa - 1.0f) * pka[nt] + 1.0f);
        g_[nt] = ga[nt];
    }
    if (samp) {
#pragma unroll
        for (int nt = 0; nt < 2; ++nt)
#pragma unroll
            for (int e = 0; e < 4; ++e) if (!valid) { lw[nt][e] = 0.f; kk[nt][e] = 0.f; kp[nt][e] = 0.f; g_[nt][e] = 0.f; a_[nt][e] = 0.f; r_[nt][e] = 0.f; v_[nt][e] = 0.f; }
    }
#pragma unroll
    for (int nt = 0; nt < 2; ++nt) {
        const f32x4 k2 = kk[nt] * kk[nt], rb = r_[nt] * kp[nt] * prk[nt];
        ssq += (k2[0] + k2[1]) + (k2[2] + k2[3]); bcs += (rb[0] + rb[1]) + (rb[2] + rb[3]);
#pragma unroll
        for (int e = 0; e < 4; ++e) {
            float x = lw[nt][e];
            x += dpp_shr0<0x111>(x); x += dpp_shr0<0x112>(x); x += dpp_shr0<0x114>(x); x += dpp_shr0<0x118>(x);
            L[nt][e] = x;
            if (fr == 15) tot[mt * 64 + n0 + 16 * nt + e] = x;
        }
    }
    ssq += __shfl_xor(ssq, 16); ssq += __shfl_xor(ssq, 32); bcs += __shfl_xor(bcs, 16); bcs += __shfl_xor(bcs, 32);
    if (fq == 0) { red[((mt * 2 + nh) * 16 + fr) * 2] = ssq; red[((mt * 2 + nh) * 16 + fr) * 2 + 1] = bcs; }
    RW_BAR();
    if (cut <= 3) { if (L[0][0] + L[1][3] == 1.2345f) F.MISC[1] = 1; RW_BAR(); return; }
    const float ss = red[((mt * 2 + 0) * 16 + fr) * 2] + red[((mt * 2 + 1) * 16 + fr) * 2], bc = red[((mt * 2 + 0) * 16 + fr) * 2 + 1] + red[((mt * 2 + 1) * 16 + fr) * 2 + 1];
    const float rn = __builtin_amdgcn_rcpf(fmaxf(__builtin_amdgcn_sqrtf(ss), 1e-12f));
    ub16* Gb = (ub16*)(F.ws + WS_G); ub16* E1b = (ub16*)(F.ws + WS_E1);
    f32x4 Rq[2];
#pragma unroll
    for (int nt = 0; nt < 2; ++nt) {
        const int ch = n0 + 16 * nt, hc = h * 64 + ch;
        const f32x4 t0 = *(const LAS f32x4*)(tot + ch), t1 = *(const LAS f32x4*)(tot + 64 + ch), t2 = *(const LAS f32x4*)(tot + 128 + ch), t3 = *(const LAS f32x4*)(tot + 192 + ch);
        f32x4 Gv, Ev, vAc, vRc, vBc, vKc, tA, tB, tK;
        {
#define RW_EX4(X) ({ const f32x4 x_ = (X) * 1.4426950408889634f; (f32x4){__builtin_amdgcn_exp2f(x_[0]), __builtin_amdgcn_exp2f(x_[1]), __builtin_amdgcn_exp2f(x_[2]), __builtin_amdgcn_exp2f(x_[3])}; })
            const f32x4 z4 = (f32x4){0.f, 0.f, 0.f, 0.f};
            const f32x4 off = (mt > 0 ? t0 : z4) + (mt > 1 ? t1 : z4) + (mt > 2 ? t2 : z4);
            const f32x4 Lt = L[nt] + off, Lp = Lt - lw[nt], Lmid = t0 + t1, LC = Lmid + t2 + t3;
            const f32x4 kkn = kk[nt] * rn, bv = kkn * a_[nt];
            Gv = g_[nt] * pgg[nt]; Ev = (pgb[nt] + v_[nt] * bc) * g_[nt];
            vAc = -kkn * RW_EX4(Lp - Lmid); vRc = r_[nt] * RW_EX4(Lt - Lmid);
            const f32x4 em = RW_EX4(Lmid - Lt); vBc = bv * em; vKc = kp[nt] * em;
            const f32x4 ec = RW_EX4(LC - Lt);
            tA = -kkn * RW_EX4(Lp); tB = bv * ec; tK = kp[nt] * ec;
            Rq[nt] = r_[nt] * RW_EX4(Lt);
            if (t == 0) *(LAS f32x4*)(gC + ch) = RW_EX4(LC);
#undef RW_EX4
        }
        {
            const int qi = fr & 3, tq = t & ~3;
            const u32x2 wA = quad_tr(pack4(tA), fr), wB = quad_tr(pack4(tB), fr), wK = quad_tr(pack4(tK), fr), wV = quad_tr(pack4(v_[nt]), fr);
            *(LAS u32x2*)(RW_TILE(4) + (ch + qi) * TP + tq) = wA; *(LAS u32x2*)(RW_TILE(5) + (ch + qi) * TP + tq) = wB;
            *(LAS u32x2*)(RW_TILE(6) + (ch + qi) * TP + tq) = wK; *(LAS u32x2*)(RW_TILE(7) + (ch + qi) * TP + tq) = wV; }
        *(LAS u32x2*)(RW_TILE(0) + t * TP + ch) = pack4(vAc); *(LAS u32x2*)(RW_TILE(1) + t * TP + ch) = pack4(vRc);
        *(LAS u32x2*)(RW_TILE(2) + t * TP + ch) = pack4(vBc); *(LAS u32x2*)(RW_TILE(3) + t * TP + ch) = pack4(vKc);
        if (valid) { *(GAS u32x2*)(Gb + (size_t)(row0 + t) * 512 + hc) = pack4(Gv); *(GAS u32x2*)(E1b + (size_t)(row0 + t) * 512 + hc) = pack4(Ev); }
    }
    RW_BAR();
    if (cut <= 4) { if (Rq[0][0] + Rq[1][3] == 1.2345f) F.MISC[1] = 1; RW_BAR(); return; }
    const int citem = cit + tid;
    const f32x4 cka = *(const GAS f32x4*)(F.inp(I_CK) + (size_t)citem * 8), ckb = *(const GAS f32x4*)(F.inp(I_CK) + (size_t)citem * 8 + 4);
    const int m = 16 * mt + fr;
    f32x4 acc[2];
#define RW_MASK2(A, COND) do { _Pragma("unroll") for (int nt = 0; nt < 2; ++nt) _Pragma("unroll") for (int e = 0; e < 4; ++e) { const int n = n0 + 16 * nt + e; A[nt][e] = (COND) ? A[nt][e] : 0.f; } } while (0)
#define RW_TINIT(A, Ti) do { A[0] = unpack4(*(const LAS u32x2*)(RW_TILE(Ti) + m * TP + n0)); A[1] = unpack4(*(const LAS u32x2*)(RW_TILE(Ti) + m * TP + n0 + 16)); } while (0)
    f32x4 Tacc[2];
    {   FrA a0, a1; FrB b2, b3;
        ldA(a0, RW_TILE(0), mt, fr, fq); ldB(b2, RW_TILE(2), nh, fr, fq); ldB(b3, RW_TILE(3), nh, fr, fq); ldA(a1, RW_TILE(1), mt, fr, fq);
        RW_FENCE();
        f32x4 aN[2], aAK[2], aRB[2], aRK[2], tv[2];
        RW_ZERO(aN); RW_ZERO(aAK); RW_ZERO(aRB); RW_ZERO(aRK);
        mmf(aN, a0, b2); mmf(aAK, a0, b3); mmf(aRB, a1, b2); mmf(aRK, a1, b3);
        RW_MASK2(aN, n < m);
#pragma unroll
        for (int nt = 0; nt < 2; ++nt)
#pragma unroll
            for (int e = 0; e < 4; ++e) tv[nt][e] = aN[nt][e] + ((n0 + 16 * nt + e == m) ? 1.0f : 0.f);
        st_tile(RW_TILE(8), aN, m, n0); st_tile_T(RW_TILE(9), aN, m, n0, fr); st_tile(RW_TILE(13), tv, m, n0); Tacc[0] = tv[0]; Tacc[1] = tv[1];
        RW_MASK2(aAK, n < m); st_tile(RW_TILE(10), aAK, m, n0);
        RW_MASK2(aRB, n <= m); st_tile(RW_TILE(11), aRB, m, n0);
        RW_MASK2(aRK, n <= m); st_tile(RW_TILE(12), aRK, m, n0);
    }
#undef RW_MASK2
    RW_BAR();
    if (cut <= 5) { RW_BAR(); return; }
#define RW_SQTUP(Pi, PTi, Po, PTo, Ti, To) do { FrA aP_, aT_; FrB bPT_; f32x4 rP_[2]; \
        ldA(aP_, RW_TILE(Pi), mt, fr, fq); ldB(bPT_, RW_TILE(PTi), nh, fr, fq); ldA(aT_, RW_TILE(Ti), mt, fr, fq); acc[0] = Tacc[0]; acc[1] = Tacc[1]; \
        RW_FENCE(); RW_ZERO(rP_); \
        mmf(rP_, aP_, bPT_); mmf(acc, aT_, bPT_); \
        Tacc[0] = acc[0]; Tacc[1] = acc[1]; st_tile(RW_TILE(Po), rP_, m, n0); st_tile_T(RW_TILE(PTo), rP_, m, n0, fr); st_tile(RW_TILE(To), acc, m, n0); } while (0)
    {
        FrA a8, a7; FrB b9, b10; f32x4 r2[2];
        ldA(a8, RW_TILE(8), mt, fr, fq); ldB(b9, RW_TILE(9), nh, fr, fq); ldA(a7, RW_TILE(7), mt, fr, fq); ldB(b10, RW_TILE(10), nh, fr, fq);
        RW_FENCE(); RW_ZERO(acc); RW_ZERO(r2);
        mmf(acc, a8, b9); mmf(r2, a7, b10);
        st_tile(RW_TILE(0), acc, m, n0); st_tile_T(RW_TILE(1), acc, m, n0, fr); st_tile(RW_TILE(3), r2, m, n0); }
    RW_BAR();
    RW_SQTUP(0, 1, 8, 9, 13, 2);  RW_BAR();
    RW_SQTUP(8, 9, 0, 1, 2, 13);  RW_BAR();
    RW_SQTUP(0, 1, 8, 9, 13, 2);  RW_BAR();
    {
        FrA a8, a2; FrB b9; f32x4 r1[2];
        ldA(a2, RW_TILE(2), mt, fr, fq); ldB(b9, RW_TILE(9), nh, fr, fq); acc[0] = Tacc[0]; acc[1] = Tacc[1]; ldA(a8, RW_TILE(8), mt, fr, fq);
        RW_FENCE(); RW_ZERO(r1);
        mmf(acc, a2, b9); mmf(r1, a8, b9); Tacc[0] = acc[0]; Tacc[1] = acc[1];
        st_tile(RW_TILE(13), acc, m, n0); st_tile_T(RW_TILE(1), r1, m, n0, fr); }
    RW_BAR();
    {
        FrA a13; FrB b1;
        ldA(a13, RW_TILE(13), mt, fr, fq); ldB(b1, RW_TILE(1), nh, fr, fq); acc[0] = Tacc[0]; acc[1] = Tacc[1];
        RW_FENCE();
        mmf(acc, a13, b1); st_tile(RW_TILE(2), acc, m, n0); }
    RW_BAR();
#undef RW_SQTUP
    {
        FrA a4, a3; FrB b2; f32x4 r1[2];
        ldA(a4, RW_TILE(4), mt, fr, fq); ldB(b2, RW_TILE(2), nh, fr, fq); ldA(a3, RW_TILE(3), mt, fr, fq);
        RW_FENCE(); RW_ZERO(acc); RW_ZERO(r1);
        mmf(acc, a4, b2); mmf(r1, a3, b2);
        st_tile(RW_TILE(0), acc, m, n0); st_tile(RW_TILE(8), r1, m, n0); }
    RW_BAR();
    unsigned char* md = (unsigned char*)F.out + (size_t)u * MD_BYTES;
    {   FrA a5, a11; FrB b0;
        ldA(a5, RW_TILE(5), mt, fr, fq); ldB(b0, RW_TILE(0), nh, fr, fq); ldA(a11, RW_TILE(11), mt, fr, fq);
        FrA a8, a7; FrB b5, b6;
        ldA(a8, RW_TILE(8), mt, fr, fq); ldB(b5, RW_TILE(5), nh, fr, fq); ldA(a7, RW_TILE(7), mt, fr, fq); ldB(b6, RW_TILE(6), nh, fr, fq);
        RW_FENCE();
        f32x4 rM[2], rQ[2];
        RW_ZERO(rM); rQ[0] = Rq[0]; rQ[1] = Rq[1];
        mmf(rM, a5, b0); mmf(rQ, a11, b0);
        RW_ZERO(acc); mmf(acc, a8, b5); mmf(acc, a7, b6);
        RW_FENCE();
        FrA a12; FrB b8, b7;
        ldB(b8, RW_TILE(8), nh, fr, fq); ldA(a12, RW_TILE(12), mt, fr, fq); ldB(b7, RW_TILE(7), nh, fr, fq);
        RW_FENCE();
        ub16* qt = (ub16*)(F.ws + WS_QT) + (size_t)u * (64 * TP);
#pragma unroll
        for (int nt = 0; nt < 2; ++nt) {
#pragma unroll
            for (int e = 0; e < 4; ++e) { const int n = n0 + 16 * nt + e; if (n == m) rM[nt][e] += gC[n]; }
            *(GAS u32x2*)((ub16*)md + m * TP + n0 + 16 * nt) = pack4(rM[nt]);
            *(GAS u32x2*)(qt + m * TP + n0 + 16 * nt) = pack4(rQ[nt]);
            *(GAS f32x4*)((float*)(md + MT_BYTES) + m * 68 + n0 + 16 * nt) = acc[nt]; }
        f32x4 rY[2]; RW_ZERO(rY); mmf(rY, a11, b8); mmf(rY, a12, b7);
        ub16* yl = (ub16*)(F.ws + WS_YL) + (size_t)u * 4096;
#pragma unroll
        for (int nt = 0; nt < 2; ++nt) *(GAS u32x2*)(yl + m * 64 + n0 + 16 * nt) = pack4(rY[nt]); }
#undef RW_TINIT
    {   const int rowi = citem >> 6, ch = citem & 63, cb_ = rowi >> 12, cp_ = rowi & 4095;
        v4u o; o.x = cvtpk(cka[0], cka[1]); o.y = cvtpk(cka[2], cka[3]); o.z = cvtpk(ckb[0], ckb[1]); o.w = cvtpk(ckb[2], ckb[3]);
        *(GAS v4u*)((ub16*)(F.ws + WS_KS) + ((size_t)cb_ * 4224 + cp_) * 512 + ch * 8) = o; }
    RW_BAR();
}

__device__ __forceinline__ void r2_chain(Frame& F, int chain) {
    LAS unsigned char* lds = F.lds;
    const int tid = F.tid, w = F.wave, lane = F.lane, fr = lane & 15, fq = lane >> 4;
    const bool samp = chain >= 32; const int nsteps = samp ? 1 : 128; const int u0 = samp ? 4096 + (chain - 32) : chain * 128;
    const unsigned char* rec0 = (const unsigned char*)F.out + (size_t)u0 * MD_BYTES;
    constexpr int NPIECE = MD_BYTES / 16;
    v4u q[6][4];
#define R2_LOAD(k, step) do { _Pragma("unroll") for (int i_ = 0; i_ < 4; ++i_) { const int p_ = tid + 512 * i_; if (p_ < NPIECE) q[k][i_] = *(const GAS v4u*)(rec0 + (size_t)(step) * MD_BYTES + 16 * p_); } } while (0)
#pragma unroll
    for (int k = 0; k < 6; ++k) if (k < nsteps) R2_LOAD(k, k);
    f32x4 S[4];
    {   const int cs = chain - 32;
#pragma unroll
        for (int nt = 0; nt < 4; ++nt) S[nt] = (samp && w < 4) ? *(const GAS f32x4*)(F.inp(I_SWKV) + (size_t)cs * 4096 + (16 * w + fr) * 64 + 16 * nt + 4 * fq) : (f32x4){0.f, 0.f, 0.f, 0.f};
    }
    LAS ub16* stg = (LAS ub16*)(lds + 2 * MD_BYTES) + w * (16 * TP);
    ub16* S0b = (ub16*)(F.ws + WS_S0);
#define R2_STEP(k) do { const int c_ = c0 + (k); if (c_ < nsteps) { \
        LAS unsigned char* slot = lds + (c_ & 1) * MD_BYTES; \
        _Pragma("unroll") for (int i_ = 0; i_ < 4; ++i_) { const int p_ = tid + 512 * i_; if (p_ < NPIECE) *(LAS v4u*)(slot + 16 * p_) = q[k][i_]; } \
        if (c_ + 6 < nsteps) R2_LOAD(k, c_ + 6); \
        RW_BAR(); \
        if (w < 4) { \
            ub16* s0 = S0b + (size_t)(u0 + c_) * (64 * TP) + (16 * w + fr) * TP + 4 * fq; \
            _Pragma("unroll") for (int nt = 0; nt < 4; ++nt) { const u32x2 pk = pack4(S[nt]); *(GAS u32x2*)(s0 + 16 * nt) = pk; *(LAS u32x2*)(stg + fr * TP + 16 * nt + 4 * fq) = pk; } \
            asm volatile("s_waitcnt lgkmcnt(0)" ::: "memory"); \
            const bf16x8 sa0 = *(const LAS bf16x8*)(stg + fr * TP + 8 * fq), sa1 = *(const LAS bf16x8*)(stg + fr * TP + 32 + 8 * fq); \
            _Pragma("unroll") for (int nt = 0; nt < 4; ++nt) { \
                f32x4 acc_ = *(const LAS f32x4*)(slot + MT_BYTES + ((16 * w + fr) * 68 + 16 * nt + 4 * fq) * 4); \
                const bf16x8 mb0 = *(const LAS bf16x8*)((LAS ub16*)slot + (16 * nt + fr) * TP + 8 * fq), mb1 = *(const LAS bf16x8*)((LAS ub16*)slot + (16 * nt + fr) * TP + 32 + 8 * fq); \
                acc_ = __builtin_amdgcn_mfma_f32_16x16x32_bf16(mb0, sa0, acc_, 0, 0, 0); acc_ = __builtin_amdgcn_mfma_f32_16x16x32_bf16(mb1, sa1, acc_, 0, 0, 0); S[nt] = acc_; } \
        } } } while (0)
    for (int c0 = 0; c0 < nsteps; c0 += 6) { R2_STEP(0); R2_STEP(1); R2_STEP(2); R2_STEP(3); R2_STEP(4); R2_STEP(5); }
#undef R2_STEP
#undef R2_LOAD
    if (w < 4) {
        float* dst = samp ? F.out + O_WKVS + (size_t)(chain - 32) * 4096 : F.out + O_WKVP + (size_t)chain * 4096;
#pragma unroll
        for (int nt = 0; nt < 4; ++nt) *(GAS f32x4*)(dst + (16 * w + fr) * 64 + 16 * nt + 4 * fq) = S[nt];
    }
    RW_BAR();
}

struct R3Raw { v4u qs[5]; u32x2 yl[4], g[4], e[4]; };
__device__ __forceinline__ void r3_load(Frame& F, int uA, int uB, R3Raw& R) {
    const int tid = F.tid, w = F.wave, lane = F.lane, fr = lane & 15, fq = lane >> 4;
#pragma unroll
    for (int i = 0; i < 5; ++i) { const int p = tid + 512 * i, tix = p / (TB / 16), off = (p % (TB / 16)) * 16; const int u = (tix < 2) ? uA : uB;
        const unsigned char* src = F.ws + ((tix & 1) ? WS_S0 : WS_QT) + (size_t)(u < 0 ? uA : u) * TB + off; R.qs[i] = *(const GAS v4u*)src; }
    const int u = (w < 4) ? uA : (uB < 0 ? uA : uB);
    bool samp; int sb, h, c, row0; r1_decode(u, samp, sb, h, c, row0);
    const int t = 16 * (w & 3) + fr;
    const ub16* yl = (const ub16*)(F.ws + WS_YL) + (size_t)u * 4096 + t * 64 + 4 * fq;
    const int rr = (!samp || t < 16) ? row0 + t : row0;
    const ub16* Gb = (const ub16*)(F.ws + WS_G) + (size_t)rr * 512 + h * 64 + 4 * fq; const ub16* Eb = (const ub16*)(F.ws + WS_E1) + (size_t)rr * 512 + h * 64 + 4 * fq;
#pragma unroll
    for (int nt = 0; nt < 4; ++nt) { R.yl[nt] = *(const GAS u32x2*)(yl + 16 * nt); R.g[nt] = *(const GAS u32x2*)(Gb + 16 * nt); R.e[nt] = *(const GAS u32x2*)(Eb + 16 * nt); }
}
__device__ __forceinline__ void r3_pair(Frame& F, int uA, int uB, ub16* YMIX, R3Raw& R, int nA, int nB, bool has_next, int par) {
    LAS unsigned char* lds = F.lds + par * 4 * TB;
    int lane = F.lane; asm volatile("" : "+v"(lane));
    const int w = F.wave, tid = w * 64 + lane, fr = lane & 15, fq = lane >> 4;
#pragma unroll
    for (int i = 0; i < 5; ++i) *(LAS v4u*)(lds + 16 * (tid + 512 * i)) = R.qs[i];
    const int u = (w < 4) ? uA : uB;
    bool samp; int sb, h, c, row0; r1_decode(u < 0 ? uA : u, samp, sb, h, c, row0);
    const int t = 16 * (w & 3) + fr;
    const bool valid = (u >= 0) && (!samp || t < 16);
    f32x4 acc[4], G[4], E[4];
#pragma unroll
    for (int nt = 0; nt < 4; ++nt) { acc[nt] = unpack4(R.yl[nt]); G[nt] = unpack4(R.g[nt]); E[nt] = unpack4(R.e[nt]); }
    if (has_next) r3_load(F, nA, nB, R);
    RW_BAR();
    {   const LAS ub16* Qt = (const LAS ub16*)(lds + (w < 4 ? 0 : 2 * TB)); const LAS ub16* S0 = (const LAS ub16*)(lds + (w < 4 ? TB : 3 * TB));
#pragma unroll
        for (int ks = 0; ks < 2; ++ks) {
            const bf16x8 af = *(const LAS bf16x8*)(Qt + (16 * (w & 3) + fr) * TP + 32 * ks + 8 * fq);
#pragma unroll
            for (int nt = 0; nt < 4; ++nt) { const bf16x8 bfr = *(const LAS bf16x8*)(S0 + (16 * nt + fr) * TP + 32 * ks + 8 * fq);
                acc[nt] = __builtin_amdgcn_mfma_f32_16x16x32_bf16(bfr, af, acc[nt], 0, 0, 0); }
        }
    }
    float s1 = 0.f, s2 = 0.f;
#pragma unroll
    for (int nt = 0; nt < 4; ++nt)
#pragma unroll
        for (int e = 0; e < 4; ++e) { s1 += acc[nt][e]; s2 += acc[nt][e] * acc[nt][e]; }
    s1 += __shfl_xor(s1, 16); s1 += __shfl_xor(s1, 32); s2 += __shfl_xor(s2, 16); s2 += __shfl_xor(s2, 32);
    const float mean = s1 * (1.0f / 64.0f), var = fmaxf(s2 * (1.0f / 64.0f) - mean * mean, 0.f), rstd = 1.0f / sqrtf(var + 64e-5f);
    if (valid) {
#pragma unroll
        for (int nt = 0; nt < 4; ++nt) { const f32x4 y = (acc[nt] - mean) * rstd * G[nt] + E[nt];
            *(GAS u32x2*)(YMIX + (size_t)(row0 + t) * DM + h * 64 + 4 * fq + 16 * nt) = pack4(y); }
    }
}
#undef RW_TILE
}

constexpr size_t WS_O0 = WS_PRW, WS_O1 = WS_PRW + 32 * MiB, WS_OS0 = WS_PRW + 64 * MiB, WS_OS1 = WS_PRW + 66 * MiB;
constexpr size_t WS_YMIX = WS_QB;
static_assert(WS_OS1 + 2 * MiB <= WS_QB && WS_YMIX + (size_t)MPAD * 1024 * 2 <= WS_QS, "ws overlays");
constexpr int Q_ITEMS = 12 + 128 + 16 + 128;
constexpr int CW_QHEAD = 1024;
__device__ __forceinline__ void attn_item(Frame& F, char* ldsg, int g, int a) {
    using attn_body::bf16;
    if (a >= 128 && a < 144) {
        const int idx = a - 128, vh = idx & 1, c = (idx >> 1) & 1, h = (idx >> 2) & 3, b = g;
        const bf16* Qs = (const bf16*)(F.ws + WS_QS); const bf16* Ks = (const bf16*)(F.ws + WS_KS); const bf16* Vs = (const bf16*)(F.ws + WS_VS);
        bf16* Os = (bf16*)(F.ws + (c ? WS_OS1 : WS_OS0));
        attn_body::attn_unit<8>(Qs + (size_t)b * 256 * 512 + h * 128 + c * 64, Ks + (size_t)b * 4224 * 512 + h * 128 + c * 64, Vs + (size_t)b * 4224 * 512 + h * 128 + vh * 64,
                                Os + (size_t)b * 256 * 512 + h * 128 + vh * 64, 66, 1, ldsg);
        return;
    }
    const int a2 = a < 128 ? a : a - 16, qb = 31 - (a2 >> 3), pr = 8 * g + (a2 & 7);
    const int vh = pr & 1, c = (pr >> 1) & 1, bh = pr >> 2, b = bh >> 2, h = bh & 3;
    const bf16* Qb = (const bf16*)(F.ws + WS_QB); const bf16* Kb = (const bf16*)(F.ws + WS_KB); const bf16* Vb = (const bf16*)(F.ws + WS_VB);
    bf16* Ob = (bf16*)(F.ws + (c ? WS_O1 : WS_O0));
    const size_t rq = (size_t)b * 8192 + (size_t)qb * 256, rk = (size_t)b * 8192;
    attn_body::attn_unit<8>(Qb + rq * 512 + h * 128 + c * 64, Kb + rk * 512 + h * 128 + c * 64, Vb + rk * 512 + h * 128 + vh * 64, Ob + rq * 512 + h * 128 + vh * 64, 4 * qb + 4, 0, ldsg);
}
constexpr int Q_ITEMS2 = 12 + 64 + 8 + 64;
__device__ __forceinline__ void attn_item2(Frame& F, char* ldsg, int g, int a, int ocsel = -1, int kmask = -1) {
    using attn2::bf16;
    if (a >= 64 && a < 72) {
        const int idx = a - 64, c = idx & 1, h = idx >> 1, b = g, oc = ocsel >= 0 ? ocsel : c;
        const bf16* Qs = (const bf16*)(F.ws + WS_QS); const bf16* Ks = (const bf16*)(F.ws + WS_KS); const bf16* Vs = (const bf16*)(F.ws + WS_VS);
        bf16* Os = (bf16*)(F.ws + (oc ? WS_OS1 : WS_OS0));
        attn2::unit(Qs + (size_t)b * 256 * 512 + h * 128 + c * 64, Ks + (size_t)b * 4224 * 512 + h * 128 + c * 64, Vs + (size_t)b * 4224 * 512 + h * 128, Os + (size_t)b * 256 * 512 + h * 128, 66, 1, ldsg);
        return;
    }
    const int a2 = a < 64 ? a : a - 8, qb = 31 - (a2 >> 2), combo = a2 & 3, bh = 2 * g + (combo >> 1), c = combo & 1, b = bh >> 2, h = bh & 3, oc = ocsel >= 0 ? ocsel : c;
    const bf16* Qb = (const bf16*)(F.ws + WS_QB); const bf16* Kb = (const bf16*)(F.ws + WS_KB); const bf16* Vb = (const bf16*)(F.ws + WS_VB);
    bf16* Ob = (bf16*)(F.ws + (oc ? WS_O1 : WS_O0));
    const size_t rq = (size_t)b * 8192 + (size_t)qb * 256, rk = (size_t)b * 8192;
    attn2::unit(Qb + rq * 512 + h * 128 + c * 64, Kb + rk * 512 + h * 128 + c * 64, Vb + rk * 512 + h * 128, Ob + rq * 512 + h * 128, 4 * qb + 4, 0, ldsg);
}
__device__ __forceinline__ void phase3_queue(Frame& F, char* ldsg, int li) {
    const int g = F.vcu >> 5;
    gu32* head = F.ctl + CW_QHEAD + 64 * g;
    if (F.tid == 0) F.MISC[0] = __hip_atomic_fetch_add(head, 1u, __ATOMIC_RELAXED, __HIP_MEMORY_SCOPE_AGENT);
    __syncthreads();
    int it = (int)F.MISC[0];
    __syncthreads();
    while (it < Q_ITEMS2) {
        unsigned nxt = 0u;
        if (F.tid == 0) nxt = __hip_atomic_fetch_add(head, 1u, __ATOMIC_RELAXED, __HIP_MEMORY_SCOPE_AGENT);
        if (it < 4) rw::r2_chain(F, 4 * g + it);
        else if (it < 12) rw::r2_chain(F, 32 + 8 * g + (it - 4));
#ifdef DBG_R2_ONLY_IN_DUP
        else if (li == 0) attn_item2(F, ldsg, g, it - 12);
#else
        else attn_item2(F, ldsg, g, it - 12);
#endif
        if (F.tid == 0) F.MISC[0] = nxt;
        __syncthreads();
        it = (int)F.MISC[0];
        __syncthreads();
    }
}

__device__ __forceinline__ void combine_rows(Frame& F) {
    const int gw = F.vcu * NWAVES + F.wave, NGW = F.G * NWAVES, lane = F.lane;
    float d1 = F.inp(I_LQ1)[lane] * F.inp(I_LK1)[lane], d2 = F.inp(I_LQ2)[lane] * F.inp(I_LK2)[lane];
    d1 = wave_sum(d1); d2 = wave_sum(d2);
    const float lam = __expf(d1) - __expf(d2) + 0.2f;
    const f32x4 g0 = *(const GAS f32x4*)(F.inp(I_SUBG) + (lane & 15) * 8), g1 = *(const GAS f32x4*)(F.inp(I_SUBG) + (lane & 15) * 8 + 4);
    bf16* YMIX = (bf16*)(F.ws + WS_YMIX);
    for (int r0 = gw; r0 < MV; r0 += 2 * NGW) {
        v4u a[2], b[2];
#pragma unroll
        for (int q = 0; q < 2; ++q) { const int r = r0 + q * NGW; if (r < MV) {
            const bf16 *o0, *o1;
            if (r < MP) { o0 = (const bf16*)(F.ws + WS_O0) + (size_t)r * 512; o1 = (const bf16*)(F.ws + WS_O1) + (size_t)r * 512; }
            else { const int rs = r - MP; const size_t ro = ((size_t)(rs >> 4) * 256 + (rs & 15)) * 512; o0 = (const bf16*)(F.ws + WS_OS0) + ro; o1 = (const bf16*)(F.ws + WS_OS1) + ro; }
            a[q] = *(const GAS v4u*)(o0 + lane * 8); b[q] = *(const GAS v4u*)(o1 + lane * 8); } }
#pragma unroll
        for (int q = 0; q < 2; ++q) { const int r = r0 + q * NGW; if (r < MV) {
            float d[8];
            d[0] = rw::bflo(a[q].x) - lam * rw::bflo(b[q].x); d[1] = rw::bfhi(a[q].x) - lam * rw::bfhi(b[q].x); d[2] = rw::bflo(a[q].y) - lam * rw::bflo(b[q].y); d[3] = rw::bfhi(a[q].y) - lam * rw::bfhi(b[q].y);
            d[4] = rw::bflo(a[q].z) - lam * rw::bflo(b[q].z); d[5] = rw::bfhi(a[q].z) - lam * rw::bfhi(b[q].z); d[6] = rw::bflo(a[q].w) - lam * rw::bflo(b[q].w); d[7] = rw::bfhi(a[q].w) - lam * rw::bfhi(b[q].w);
            float ss = 0.f;
#pragma unroll
            for (int e = 0; e < 8; ++e) ss += d[e] * d[e];
            ss += __shfl_xor(ss, 1); ss += __shfl_xor(ss, 2); ss += __shfl_xor(ss, 4); ss += __shfl_xor(ss, 8);
            const float sc = 0.8f / sqrtf(ss * (1.0f / 128.0f) + 1e-6f);
            v4u o; o.x = rw::cvtpk(d[0] * sc * g0[0], d[1] * sc * g0[1]); o.y = rw::cvtpk(d[2] * sc * g0[2], d[3] * sc * g0[3]); o.z = rw::cvtpk(d[4] * sc * g1[0], d[5] * sc * g1[1]); o.w = rw::cvtpk(d[6] * sc * g1[2], d[7] * sc * g1[3]);
            *(GAS v4u*)(YMIX + (size_t)r * DM + 512 + lane * 8) = o; } }
    }
    { const float* xs = F.inp(I_XS); for (int i = gw * 64 + lane; i < MS * DM / 4; i += NGW * 64) *(GAS f32x4*)(F.out + (size_t)MP * DM + 4 * (size_t)i) = *(const GAS f32x4*)(xs + 4 * (size_t)i); }
    for (int r = MV + gw; r < MPAD; r += NGW) { GAS v4u* o = (GAS v4u*)(YMIX + (size_t)r * DM) + lane; o[0] = (v4u){0u, 0u, 0u, 0u}; o[64] = (v4u){0u, 0u, 0u, 0u}; }
}

constexpr size_t WS_HRAW = 95 * MiB, WS_HS = 108 * MiB, WS_ACT = 274 * MiB;
static_assert(WS_HRAW + (size_t)129 * 4 * FF2 * 4 <= WS_HS && WS_ACT + (size_t)MPAD * FF * 2 <= WS_END, "ffn ws map");
__device__ __forceinline__ void h2_rows(Frame& F) {
    const int gw = F.vcu * NWAVES + F.wave, NGW = F.G * NWAVES;
    bf16* H2 = (bf16*)(F.ws + WS_XN);
    int m = gw;
    for (; m + NGW < MV; m += 2 * NGW) rms_row2_to_bf16(F.lane, F.out + (size_t)m * DM, H2 + (size_t)m * DM, F.out + (size_t)(m + NGW) * DM, H2 + (size_t)(m + NGW) * DM);
    for (; m < MPAD; m += NGW) {
        if (m < MV) rms_row_to_bf16(F.lane, F.out + (size_t)m * DM, H2 + (size_t)m * DM);
        else { GAS v4u* o = (GAS v4u*)(H2 + (size_t)m * DM) + F.lane; o[0] = (v4u){0u, 0u, 0u, 0u}; o[64] = (v4u){0u, 0u, 0u, 0u}; }
    }
}
__device__ __forceinline__ void conv_fixup(Frame& F) {
    const int gt = (F.vcu * NWAVES + F.wave) * 64 + F.lane, NGT = F.G * NWAVES * 64;
    const float* Hraw = (const float*)(F.ws + WS_HRAW); const float* Hs = (const float*)(F.ws + WS_HS); bf16* ACT = (bf16*)(F.ws + WS_ACT);
    const float* cw = F.inp(I_CW); const float* cb = F.inp(I_CB);
    for (int it = gt; it < 136 * 352; it += NGT) {
        const int pr = it / 352, jc = it % 352, j = jc * 8, pc = 256 * (j >> 7) + (j & 127);
        const float *r0g, *r1g, *r2g, *r3g; int o0, o1, orow0; bool phys0, phys1;
        if (pr < 128) { const int pm = pr; if (pm == 0 || (pm & 31) == 0) continue;
            r0g = Hraw + ((size_t)(pm - 1) * 4 + 2) * FF2; r1g = Hraw + ((size_t)(pm - 1) * 4 + 3) * FF2; r2g = Hraw + ((size_t)pm * 4 + 0) * FF2; r3g = Hraw + ((size_t)pm * 4 + 1) * FF2; phys0 = true; phys1 = true; orow0 = pm * 256; }
        else { const int b = pr - 128; r0g = F.inp(I_SFC) + ((size_t)b * 2 + 0) * FF2; r1g = F.inp(I_SFC) + ((size_t)b * 2 + 1) * FF2; r2g = Hs + ((size_t)b * 2 + 0) * FF2; r3g = Hs + ((size_t)b * 2 + 1) * FF2; phys0 = false; phys1 = false; orow0 = MP + 16 * b; }
        o0 = phys0 ? pc : j; o1 = phys1 ? pc : j;
        const int up0 = phys0 ? 128 : FF, up1 = phys1 ? 128 : FF;
        float a0[8], a1[8];
#pragma unroll
        for (int e = 0; e < 8; ++e) {
            const float g0 = r0g[o0 + e], g1 = r1g[o1 + e], g2 = r2g[pc + e], g3 = r3g[pc + e];
            const float u0 = r0g[o0 + up0 + e], u1 = r1g[o1 + up1 + e], u2 = r2g[pc + 128 + e], u3 = r3g[pc + 128 + e];
            const float wg0 = cw[j + e], wg1 = cw[FF2 + j + e], wg2 = cw[2 * FF2 + j + e], bg = cb[j + e];
            const float wu0 = cw[FF + j + e], wu1 = cw[FF2 + FF + j + e], wu2 = cw[2 * FF2 + FF + j + e], bu = cb[FF + j + e];
            const float xg0 = bg + wg0 * g0 + wg1 * g1 + wg2 * g2, xu0 = bu + wu0 * u0 + wu1 * u1 + wu2 * u2;
            const float xg1 = bg + wg0 * g1 + wg1 * g2 + wg2 * g3, xu1 = bu + wu0 * u1 + wu1 * u2 + wu2 * u3;
            a0[e] = xg0 / (1.0f + __expf(-xg0)) * xu0; a1[e] = xg1 / (1.0f + __expf(-xg1)) * xu1;
        }
        v4u w0, w1; w0.x = rw::cvtpk(a0[0], a0[1]); w0.y = rw::cvtpk(a0[2], a0[3]); w0.z = rw::cvtpk(a0[4], a0[5]); w0.w = rw::cvtpk(a0[6], a0[7]);
        w1.x = rw::cvtpk(a1[0], a1[1]); w1.y = rw::cvtpk(a1[2], a1[3]); w1.z = rw::cvtpk(a1[4], a1[5]); w1.w = rw::cvtpk(a1[6], a1[7]);
        *(GAS v4u*)(ACT + (size_t)orow0 * FF + j) = w0; *(GAS v4u*)(ACT + (size_t)(orow0 + 1) * FF + j) = w1;
    }
    for (int it = gt; it < (MPAD - MV) * 352; it += NGT) { const int r = MV + it / 352, jc = it % 352; *(GAS v4u*)(ACT + (size_t)r * FF + jc * 8) = (v4u){0u, 0u, 0u, 0u}; }
}

template <int NB, int KB>
__device__ __forceinline__ void skinny_gemm(Frame& F, const bf16* A, int lda, const bf16* Wt, int K) {
    const int n0 = 16 * (F.vcu >> 2), kq = (F.vcu & 3) * (K >> 2), w = F.wave, fr = F.lane & 15, fq = F.lane >> 4;
    const bf16* ap = A + (size_t)(MP + 16 * w + fr) * lda + kq + 8 * fq; const bf16* bp = Wt + (size_t)(n0 + fr) * K + kq + 8 * fq;
    f32x4 acc0 = (f32x4){0.f, 0.f, 0.f, 0.f}, acc1 = (f32x4){0.f, 0.f, 0.f, 0.f};
#pragma unroll
    for (int b = 0; b < NB; ++b) {
        bf16x8 af[KB], bfr[KB];
#pragma unroll
        for (int i = 0; i < KB; ++i) { af[i] = *(const GAS bf16x8*)(ap + (b * KB + i) * 32); bfr[i] = *(const GAS bf16x8*)(bp + (b * KB + i) * 32); }
#pragma unroll
        for (int i = 0; i < KB; ++i) { if (i & 1) acc1 = __builtin_amdgcn_mfma_f32_16x16x32_bf16(bfr[i], af[i], acc1, 0, 0, 0); else acc0 = __builtin_amdgcn_mfma_f32_16x16x32_bf16(bfr[i], af[i], acc0, 0, 0, 0); }
    }
    const f32x4 acc = acc0 + acc1;
    float* o = F.out + (size_t)(MP + 16 * w + fr) * DM + n0 + 4 * fq;
#pragma unroll
    for (int e = 0; e < 4; ++e) atomicAdd(o + e, acc[e]);
}
#ifdef DBG_ATTN_CMP
__device__ __forceinline__ void dbg_attn_cmp(Frame& F, char* ldsg) {
    const int g = F.vcu >> 5, s = F.vcu & 31;
    for (int a = s; a < 272; a += 32) {
        const bool samp = a >= 128 && a < 144; int c;
        if (samp) c = ((a - 128) >> 1) & 1; else { const int a2 = a < 128 ? a : a - 16; c = ((8 * g + (a2 & 7)) >> 1) & 1; }
        if (c == 0) attn_item(F, ldsg, g, a);
    }
    for (int a = s; a < 136; a += 32) {
        const bool samp = a >= 64 && a < 72; int c;
        if (samp) c = (a - 64) & 1; else { const int a2 = a < 64 ? a : a - 8; c = a2 & 1; }
        if (c == 0) attn_item2(F, ldsg, g, a, 1);
    }
}
__device__ __forceinline__ void dbg_attn_report(Frame& F) {
    const int gt = (F.vcu * NWAVES + F.wave) * 64 + F.lane, NGT = F.G * NWAVES * 64;
    const bf16* o0 = (const bf16*)(F.ws + WS_O0); const bf16* o1 = (const bf16*)(F.ws + WS_O1); float e = 0.f;
    for (int i = gt; i < MP * 512; i += NGT) e = fmaxf(e, fabsf(__uint_as_float((unsigned)o0[i] << 16) - __uint_as_float((unsigned)o1[i] << 16)));
    const bf16* s0 = (const bf16*)(F.ws + WS_OS0); const bf16* s1 = (const bf16*)(F.ws + WS_OS1);
    for (int i = gt; i < 8 * 16 * 512; i += NGT) { const int b = i / (16 * 512), r = (i / 512) & 15, cc = i & 511; const size_t o = ((size_t)b * 256 + r) * 512 + cc;
        e = fmaxf(e, fabsf(__uint_as_float((unsigned)s0[o] << 16) - __uint_as_float((unsigned)s1[o] << 16))); }
    if (!(e == e)) e = 9.0f;
    atomicMax((unsigned*)(F.ctl + 10), __float_as_uint(e));
}
#endif

#ifndef MK_SP2
#define MK_SP2 true
#endif
#ifndef MK_PH_HI
#define MK_PH_HI 99
#endif
struct Args { const float* in[33]; float* out; unsigned char* ws; int ph_lo, ph_hi, li, pad; };
__global__ void __launch_bounds__(NWAVES * 64, 2) hymba_fwd(Args args) {
    extern __shared__ __attribute__((aligned(16))) unsigned char lds[];
    Frame F;
    F.lds = (LAS unsigned char*)lds;
    F.MISC = (volatile LAS unsigned*)(F.lds + MISC_OFF);
    F.tid = threadIdx.x; F.lane = F.tid & 63; F.wave = __builtin_amdgcn_readfirstlane(F.tid >> 6);
    F.G = gridDim.x; { const int bx = blockIdx.x; F.vcu = (F.G % 8 == 0) ? (bx % 8) * (F.G / 8) + bx / 8 : bx; }
    F.ws = args.ws; F.out = args.out; F.ctl = (gu32*)(args.ws + WS_CTL);
    for (int u = F.tid; u < (LDS_BYTES - LDSCTL_OFF) / 4; u += NWAVES * 64) ((LAS unsigned*)(F.lds + LDSCTL_OFF))[u] = 0u;
    __syncthreads();
    XcdBarrier bar = xcd_barrier_post((unsigned*)(F.ctl + CW_BAR), F.MISC + 8);
    const int lo = args.ph_lo, hi = args.ph_hi;
#define IN(k) (lo <= (k) && (k) < hi)
#define GRID_BAR() xcd_barrier(bar)

    if (IN(0)) { p0_urgent(F); cache_convert(F, F.vcu, F.G, F.G == 256 ? CACHE_ITEMS / 2 : 0, CACHE_SPLIT); GRID_BAR(); }

    if (IN(1)) {
        pg8::Gemm g{(const bf16*)(F.ws + WS_XN), (const bf16*)(F.ws + WS_WIN), MPAD, INDIM, 1024}; pg8::StaticOrder S; S.init(MPAD, INDIM, F.G, (int)blockIdx.x);
        pg8::EpiInProj E{(bf16*)(F.ws + WS_PRW), (bf16*)(F.ws + WS_QB), (bf16*)(F.ws + WS_KB), (bf16*)(F.ws + WS_VB), (bf16*)(F.ws + WS_QS), (bf16*)(F.ws + WS_KS), (bf16*)(F.ws + WS_VS),
                         F.out, F.inp(I_QG), F.inp(I_KG), (const float*)(F.ws + WS_ROPE)};
        pg8::gemm_phase<pg8::EpiInProj, pg8::StaticOrder, true, MK_SP2>(F.lds + RING_OFF, g, S, E);
        {
            const int rem = ((MPAD / 256) * (INDIM / 256)) % F.G;
            if (rem == 0) cache_convert(F, (int)blockIdx.x, F.G, CACHE_SPLIT, CACHE_ITEMS); else if ((int)blockIdx.x >= rem) cache_convert(F, (int)blockIdx.x - rem, F.G - rem, CACHE_SPLIT, CACHE_ITEMS);
        }
        GRID_BAR();
    }
    if (IN(2)) {
        constexpr int R1_FULL = rw::NUNIT % 256;
        {   rw::R1Raw R; v4u xq[4];
            const int nq = (512 - F.vcu + F.G - 1) / F.G, nsamp = (F.vcu < 64 && F.G == 256) ? 1 : 0;
            const int ntot = 8 * nq + nsamp;
            auto unit_of = [&](int k) -> int { if (k < 8 * nq) { const int q = F.vcu + (k >> 3) * F.G, h = k & 7; return ((q >> 7) * 8 + h) * 128 + (q & 127); } return 4096 + F.vcu; };
            if (ntot > 0) rw::r1_load(F, unit_of(0), R);
            rw::r1_param_table(F);
            for (int k = 0; k < ntot; ++k) {
                const int u = unit_of(k);
                if ((k & 7) == 0) { bool samp; int sb, h, c, row0; rw::r1_decode(u, samp, sb, h, c, row0); rw::lora_inputs(F, samp, sb, c, row0, xq); }
                rw::r1_unit(F, u, R, k + 1 < ntot ? unit_of(k + 1) : -1, xq, (args.li == 0) ? DBG_R1_CUT : 99, (F.vcu * 16 + (k < 16 ? k : 15)) * 512);
            }
            if (F.G != 256) for (int us = F.vcu; us < 64; us += F.G) { const int u = 4096 + us; bool samp; int sb, h, c, row0; rw::r1_decode(u, samp, sb, h, c, row0); rw::lora_inputs(F, samp, sb, c, row0, xq); rw::r1_load(F, u, R); rw::r1_unit(F, u, R, -1, xq); }
        }
        if (F.G == 256 && F.vcu >= R1_FULL) p0_deferred(F, F.vcu - R1_FULL, 256 - R1_FULL); else if (F.G != 256) p0_deferred(F, F.vcu, F.G);
        GRID_BAR();
    }
    if (IN(3)) {
#ifdef DBG_ATTN_CMP
        dbg_attn_cmp(F, (char*)lds + RING_OFF); GRID_BAR(); dbg_attn_report(F); GRID_BAR();
        { const float v_ = 1e4f * __uint_as_float(__hip_atomic_load((unsigned*)(F.ctl + 10), __ATOMIC_RELAXED, __HIP_MEMORY_SCOPE_AGENT)); const size_t gt_ = (size_t)(F.vcu * NWAVES + F.wave) * 64 + F.lane; if (gt_ < 7168) F.out[O_SHP + gt_] = v_; }
#else
        phase3_queue(F, (char*)lds + RING_OFF, args.li);
#endif
        GRID_BAR();
    }
    if (IN(4)) {
        {
            rw::R3Raw R; const int n = (rw::NUNIT - F.vcu + F.G - 1) / F.G; int par = 0;
            auto uof = [&](int k) -> int { return k < n ? F.vcu + k * F.G : -1; };
            if (n > 0) rw::r3_load(F, uof(0), uof(1), R);
            for (int k = 0; k < n; k += 2, par ^= 1) rw::r3_pair(F, uof(k), uof(k + 1), (rw::ub16*)(F.ws + WS_YMIX), R, uof(k + 2), uof(k + 3), k + 2 < n, par);
            __syncthreads();
        }
        combine_rows(F);
        GRID_BAR();
    }
    if (IN(5)) {
        skinny_gemm<1, 8>(F, (const bf16*)(F.ws + WS_YMIX), DM, (const bf16*)(F.ws + WS_WOUT), 1024);
        pg8::Gemm g{(const bf16*)(F.ws + WS_YMIX), (const bf16*)(F.ws + WS_WOUT), MP, 1024, 1024}; pg8::StaticOrder S; S.init(MP, 1024, F.G, (int)blockIdx.x);
        pg8::EpiResid E{F.inp(I_XP), F.inp(I_XS), F.out};
        pg8::gemm_phase<pg8::EpiResid, pg8::StaticOrder, true, MK_SP2>(F.lds + RING_OFF, g, S, E);
        GRID_BAR();
    }
    if (IN(6)) { h2_rows(F); GRID_BAR(); }
    if (IN(7)) {
        pg8::Gemm g{(const bf16*)(F.ws + WS_XN), (const bf16*)(F.ws + WS_WUP), MPAD, FF2, 1024};
        pg8::EpiUpConv E{(bf16*)(F.ws + WS_ACT), F.out, (float*)(F.ws + WS_HRAW), (float*)(F.ws + WS_HS), F.inp(I_CW), F.inp(I_CB), (LAS float*)(F.lds + RING_BYTES)};
        { pg8::RowTileOrder S1{MP / 256, FF2 / 256, (int)blockIdx.x}; pg8::gemm_phase<pg8::EpiUpConv, pg8::RowTileOrder, true, MK_SP2, true>(F.lds + RING_OFF, g, S1, E); }
        pg8::StaticOrder S; S.init(MP, FF2, F.G, (int)blockIdx.x);
        pg8::gemm_phase<pg8::EpiUpConv, pg8::StaticOrder, true, MK_SP2>(F.lds + RING_OFF, g, S, E);
        GRID_BAR();
    }
    if (IN(8)) { conv_fixup(F); GRID_BAR(); }
#ifdef DBG_CHECK_ACT
    dbg_check_act(F);
#endif
    if (IN(11)) {
        skinny_gemm<2, 11>(F, (const bf16*)(F.ws + WS_ACT), FF, (const bf16*)(F.ws + WS_WDN), FF);
        pg8::Gemm g{(const bf16*)(F.ws + WS_ACT), (const bf16*)(F.ws + WS_WDN), MP, 1024, FF}; pg8::StaticOrder S; S.init(MP, 1024, F.G, (int)blockIdx.x);
        pg8::EpiAccum E{F.out};
        pg8::gemm_phase<pg8::EpiAccum, pg8::StaticOrder, true, MK_SP2>(F.lds + RING_OFF, g, S, E);
    }
#ifdef PHASES_REST_DEFINED
    PHASES_REST
#endif
#undef IN
}

extern "C" void kernel_launch(void* const* d_in, const int* in_sizes, int n_in, void* d_out, int out_size, void* d_ws, size_t ws_size, hipStream_t stream) {
    static int grid = 0;
    if (grid == 0) {
        if (n_in != 33 || in_sizes[0] != MP * DM || (size_t)out_size != pg8::O_END || ws_size < WS_END) {
            fprintf(stderr, "kernel_launch: unexpected problem: n_in %d in0 %d out %d ws %zu (need %zu)\n", n_in, n_in > 0 ? in_sizes[0] : -1, out_size, ws_size, (size_t)WS_END); grid = -1; return; }
        int dev = 0, cus = 0, per_cu = 0;
        if (hipGetDevice(&dev) != hipSuccess || hipDeviceGetAttribute(&cus, hipDeviceAttributeMultiprocessorCount, dev) != hipSuccess) { fprintf(stderr, "kernel_launch: device query failed\n"); grid = -1; return; }
        if (hipFuncSetAttribute((const void*)hymba_fwd, hipFuncAttributeMaxDynamicSharedMemorySize, LDS_BYTES) != hipSuccess) { fprintf(stderr, "kernel_launch: hipFuncSetAttribute failed\n"); grid = -1; return; }
        if (hipOccupancyMaxActiveBlocksPerMultiprocessor(&per_cu, (const void*)hymba_fwd, NWAVES * 64, LDS_BYTES) != hipSuccess || per_cu < 1) { fprintf(stderr, "kernel_launch: occupancy query says %d blocks per CU\n", per_cu); per_cu = 1; }
        (void)hipGetLastError();
        grid = cus;
        fprintf(stderr, "kernel_launch: grid %d (per_cu %d)\n", grid, per_cu);
    }
    if (grid < 0) return;
    Args a{};
    for (int i = 0; i < 33; ++i) a.in[i] = (const float*)d_in[i];
    a.out = (float*)d_out; a.ws = (unsigned char*)d_ws; a.li = 0; a.pad = 0;
#ifdef TIME_PH
    const int nl = 2; const int los[2] = {0, TIME_PH}, his[2] = {TIME_PH + 1, MK_PH_HI};
#else
    const int nl = 1; const int los[1] = {0}, his[1] = {MK_PH_HI};
#endif
    for (int li = 0; li < nl; ++li) {
        if (hipMemsetAsync((char*)d_ws + WS_CTL, 0, CTL_ZERO_BYTES, stream) != hipSuccess) { fprintf(stderr, "kernel_launch: memset failed\n"); return; }
        a.ph_lo = los[li]; a.ph_hi = his[li]; a.li = li;
        void* kargs[] = {&a};
        hipError_t e = hipLaunchCooperativeKernel((const void*)hymba_fwd, dim3(grid), dim3(NWAVES * 64), kargs, LDS_BYTES, stream);
        if (e != hipSuccess) fprintf(stderr, "kernel_launch: cooperative launch failed: %s (grid %d)\n", hipGetErrorString(e), grid);
    }
}
```

```cpp
#include <hip/hip_runtime.h>
#ifndef DBG_R1_CUT
#define DBG_R1_CUT 99
#endif
#ifndef DBG_KMASK
#define DBG_KMASK (-1)
#endif
#include <cstdio>
#include <cstdint>
namespace pg8 {
#define PG8_LAS __attribute__((address_space(3)))
typedef unsigned short bf16_t;
typedef short bf16x8 __attribute__((ext_vector_type(8)));
typedef float f32x4 __attribute__((ext_vector_type(4)));
typedef unsigned u32x4 __attribute__((ext_vector_type(4)));
constexpr int BM = 256, BK = 64, HALF = 128, HTB = HALF * BK * 2  , STAGE_BYTES = 8 * HTB, NXCD = 8, WGM = 8;

__host__ __device__ __forceinline__ int lds_byte(int r, int c) { const int st = (r >> 4) * 2 + (c >> 5), rr = r & 15, cc = c & 31, ob = rr * 64 + cc * 2; return st * 1024 + (ob ^ (((ob >> 9) & 1) << 5)); }
__host__ __device__ __forceinline__ void stage_rc(int b, int& R, int& C) { const int st = b / 1024, sb = b % 1024, swz = sb ^ (((sb >> 9) & 1) << 5); R = (st >> 1) * 16 + swz / 64; C = (st & 1) * 32 + (swz % 64) / 2; }
__host__ __device__ __forceinline__ int perm32(int rho) { const int n = rho >> 4, i = rho & 15; return 8 * (i >> 2) + 4 * n + (i & 3); }

struct Unit { int pm, pn; };
struct Gemm { const bf16_t* A; const bf16_t* Bt; int M, N, K; };

struct StaticOrder {
    int nM, nN, nwg, G, c;
    __host__ __device__ void init(int M, int N, int G_, int c_) { nM = M / BM; nN = N / BM; nwg = nM * nN; G = G_; c = c_; }
    __host__ __device__ bool next(int i, Unit& u) const {
        const long L = (long)i * G + c; if (L >= nwg) return false;
        int wgid = (int)L; { const int q = nwg / NXCD, r = nwg % NXCD, xcd = wgid % NXCD, off = wgid / NXCD; wgid = (xcd < r ? xcd * (q + 1) : r * (q + 1) + (xcd - r) * q) + off; }
        const int nig = WGM * nN, gid = wgid / nig, fm = gid * WGM, gsz = (nM - fm) < WGM ? (nM - fm) : WGM;
        u.pm = fm + ((wgid % nig) % gsz); u.pn = (wgid % nig) / gsz; return true;
    }
    __device__ __forceinline__ void a_ready(const Unit&) const {}
    __device__ __forceinline__ void done(const Unit&) const {}
};
struct RowTileOrder {
    int pm, nN, c;
    __host__ __device__ bool next(int i, Unit& u) const { if (i > 0 || c >= nN) return false; u.pm = pm; u.pn = c; return true; }
    __device__ __forceinline__ void a_ready(const Unit&) const {}
    __device__ __forceinline__ void done(const Unit&) const {}
};


constexpr int MP = 32768, MS = 128, MV = 32896, MPAD = 33024;
constexpr int RWIN = 1792, DFW = 512, FF = 2816, FF2 = 5632, DM = 1024, INDIM = 3328;
constexpr size_t O_YP = 0, O_YS = 33554432, O_KP = 33685504, O_VP = 50462720, O_SHP = 67239936, O_WKVP = 67247104, O_FCP = 67378176,
                 O_KS = 67423232, O_VS = 67488768, O_SHS = 67554304, O_WKVS = 67568640, O_FCS = 67830784, O_END = 67920896;
constexpr float QK_C2 = 0.125f * 1.4426950408889634f;

typedef float f32x2_c __attribute__((ext_vector_type(2))); typedef __bf16 bf16x2_c __attribute__((ext_vector_type(2)));
__device__ __forceinline__ unsigned cvt_pk_bf16(float lo, float hi) { f32x2_c v = {lo, hi}; bf16x2_c b = __builtin_convertvector(v, bf16x2_c); return __builtin_bit_cast(unsigned, b); }
__device__ __forceinline__ u32x4 pack8(const f32x4& v0, const f32x4& v1) { u32x4 w; w.x = cvt_pk_bf16(v0[0], v0[1]); w.y = cvt_pk_bf16(v0[2], v0[3]); w.z = cvt_pk_bf16(v1[0], v1[1]); w.w = cvt_pk_bf16(v1[2], v1[3]); return w; }

struct EpiInProj {
    static constexpr bool PERM = true, AFTER_DRAIN = false;
    bf16_t* Prw; bf16_t* Qb; bf16_t* Kb; bf16_t* Vb; bf16_t* Qs; bf16_t* Ks; bf16_t* Vs; float* out; const float* qg; const float* kg; const float* ropecs;
    __device__ __forceinline__ void operator()(const f32x4 (&acc)[2][2][4][2], const Unit& u, int wr, int wc, int fr, int fq) const {
        const int pn = u.pn, pm = u.pm; const bool samp = (pm == 128);
        if (pn < 7) {
#pragma unroll
            for (int ai = 0; ai < 2; ++ai) {
                if (samp && ai == 1) continue;
#pragma unroll
                for (int m = 0; m < 4; ++m) {
                    const int r = pm * BM + ai * HALF + wr * 64 + m * 16 + fr;
                    const bool last = samp ? (fr == 15) : ((r & 8191) == 8191);
#pragma unroll
                    for (int bj = 0; bj < 2; ++bj) {
                        const int col = pn * BM + bj * HALF + wc * 32 + 8 * fq;
                        const f32x4 v0 = acc[ai][bj][m][0], v1 = acc[ai][bj][m][1];
                        *(u32x4*)(Prw + (size_t)r * RWIN + col) = pack8(v0, v1);
                        if (last) { float* dst = samp ? out + O_SHS + (size_t)((r - MP) >> 4) * RWIN + col : out + O_SHP + (size_t)(r >> 13) * RWIN + col;
                            *(f32x4*)dst = v0; *(f32x4*)(dst + 4) = v1; }
                    }
                }
            }
            return;
        }
        const int tix = pn - 7, which = tix >> 1, G8 = (tix & 1) * 4 + wc;
        f32x4 gv[2][2];
#pragma unroll
        for (int bj = 0; bj < 2; ++bj)
#pragma unroll
            for (int n = 0; n < 2; ++n) gv[bj][n] = (which < 2) ? *(const f32x4*)((which == 0 ? qg : kg) + 32 * bj + 8 * fq + 4 * n) : (f32x4){1.f, 1.f, 1.f, 1.f};
#pragma unroll
        for (int ai = 0; ai < 2; ++ai) {
            if (samp && ai == 1) continue;
#pragma unroll
            for (int m = 0; m < 4; ++m) {
                const int r = pm * BM + ai * HALF + wr * 64 + m * 16 + fr;
                const int rs = r - MP;
                const int pos = samp ? (4096 + (rs & 15)) : (r & 8191);
                f32x4 v[2][2];
#pragma unroll
                for (int bj = 0; bj < 2; ++bj)
#pragma unroll
                    for (int n = 0; n < 2; ++n) v[bj][n] = acc[ai][bj][m][n];
                if (which < 2) {
                    float ss = 0.f;
#pragma unroll
                    for (int bj = 0; bj < 2; ++bj)
#pragma unroll
                        for (int n = 0; n < 2; ++n) ss += (v[bj][n][0] * v[bj][n][0] + v[bj][n][1] * v[bj][n][1]) + (v[bj][n][2] * v[bj][n][2] + v[bj][n][3] * v[bj][n][3]);
                    ss += __shfl_xor(ss, 16); ss += __shfl_xor(ss, 32);
                    const float rstd = __builtin_amdgcn_rsqf(ss * (1.0f / 64.0f) + 1e-6f);
#pragma unroll
                    for (int bj = 0; bj < 2; ++bj)
#pragma unroll
                        for (int n = 0; n < 2; ++n) v[bj][n] = v[bj][n] * rstd * gv[bj][n];
                    const float* cs = ropecs + (size_t)pos * 16;
#pragma unroll
                    for (int n = 0; n < 2; ++n) {
                        const f32x4 c4 = *(const f32x4*)(cs + 4 * n), s4 = *(const f32x4*)(cs + 8 + 4 * n);
                        f32x4 o = v[0][n];
#pragma unroll
                        for (int e = 0; e < 4; ++e) {
                            const float own = v[0][n][e], oth = __shfl_xor(own, 16);
                            const float r1 = own * c4[e] - oth * s4[e], r2 = own * c4[e] + oth * s4[e];
                            o[e] = (fq == 0) ? r1 : ((fq == 1) ? r2 : own);
                        }
                        v[0][n] = o;
                    }
                }
                if (which == 0) {
                    bf16_t* qrow = samp ? Qs + ((size_t)(rs >> 4) * 256 + (rs & 15)) * DFW : Qb + (size_t)r * DFW;
#pragma unroll
                    for (int bj = 0; bj < 2; ++bj) *(u32x4*)(qrow + 64 * G8 + 32 * bj + 8 * fq) = pack8(v[bj][0] * QK_C2, v[bj][1] * QK_C2);
                } else {
                    bf16_t* brow; float* frow;
                    if (which == 1) { brow = samp ? Ks + ((size_t)(rs >> 4) * 4224 + 4096 + (rs & 15)) * DFW : Kb + (size_t)r * DFW; frow = samp ? out + O_KS + (size_t)rs * DFW : out + O_KP + (size_t)r * DFW; }
                    else            { brow = samp ? Vs + ((size_t)(rs >> 4) * 4224 + 4096 + (rs & 15)) * DFW : Vb + (size_t)r * DFW; frow = samp ? out + O_VS + (size_t)rs * DFW : out + O_VP + (size_t)r * DFW; }
#pragma unroll
                    for (int bj = 0; bj < 2; ++bj) { const int c0 = 64 * G8 + 32 * bj + 8 * fq;
                        *(u32x4*)(brow + c0) = pack8(v[bj][0], v[bj][1]);
                        *(f32x4*)(frow + c0) = v[bj][0]; *(f32x4*)(frow + c0 + 4) = v[bj][1]; }
                }
            }
        }
    }
};

struct EpiResid {
    static constexpr bool PERM = false, AFTER_DRAIN = false;
    const float* xp; const float* xs; float* out;
    __device__ __forceinline__ void operator()(const f32x4 (&acc)[2][2][4][2], const Unit& u, int wr, int wc, int fr, int fq) const {
        const int col0 = u.pn * BM + wc * 32 + 4 * fq;
#pragma unroll
        for (int ai = 0; ai < 2; ++ai)
#pragma unroll
            for (int m = 0; m < 4; ++m) { const int r = u.pm * BM + ai * HALF + wr * 64 + m * 16 + fr;
                if (r < MV) { const float* xr = (r < MP) ? xp + (size_t)r * DM : xs + (size_t)(r - MP) * DM; float* orow = out + (size_t)r * DM;
#pragma unroll
                    for (int bj = 0; bj < 2; ++bj)
#pragma unroll
                        for (int n = 0; n < 2; ++n) { const int c = col0 + bj * HALF + n * 16; *(f32x4*)(orow + c) = *(const f32x4*)(xr + c) + acc[ai][bj][m][n]; } } }
    }
};
struct EpiAccum {
    static constexpr bool PERM = false, AFTER_DRAIN = false;
    float* out;
    __device__ __forceinline__ void operator()(const f32x4 (&acc)[2][2][4][2], const Unit& u, int wr, int wc, int fr, int fq) const {
        const int col0 = u.pn * BM + wc * 32 + 4 * fq;
#pragma unroll
        for (int ai = 0; ai < 2; ++ai)
#pragma unroll
            for (int m = 0; m < 4; ++m) { const int r = u.pm * BM + ai * HALF + wr * 64 + m * 16 + fr;
                if (r < MV) { float* orow = out + (size_t)r * DM;
#pragma unroll
                    for (int bj = 0; bj < 2; ++bj)
#pragma unroll
                        for (int n = 0; n < 2; ++n) { const int c = col0 + bj * HALF + n * 16; *(f32x4*)(orow + c) = *(const f32x4*)(orow + c) + acc[ai][bj][m][n]; } } }
    }
};
__device__ __forceinline__ float dpp_ror1(float x) { return __builtin_bit_cast(float, __builtin_amdgcn_update_dpp(0, __builtin_bit_cast(int, x), 0x121, 0xf, 0xf, false)); }
__device__ __forceinline__ float dpp_ror2(float x) { return __builtin_bit_cast(float, __builtin_amdgcn_update_dpp(0, __builtin_bit_cast(int, x), 0x122, 0xf, 0xf, false)); }
__device__ __forceinline__ float dpp_shr1(float old, float x) { return __builtin_bit_cast(float, __builtin_amdgcn_update_dpp(__builtin_bit_cast(int, old), __builtin_bit_cast(int, x), 0x111, 0xf, 0xf, false)); }
__device__ __forceinline__ float dpp_shr2(float old, float x) { return __builtin_bit_cast(float, __builtin_amdgcn_update_dpp(__builtin_bit_cast(int, old), __builtin_bit_cast(int, x), 0x112, 0xf, 0xf, false)); }
template <int CTRL> __device__ __forceinline__ float dppz(float x) { return __builtin_bit_cast(float, __builtin_amdgcn_update_dpp(0, __builtin_bit_cast(int, x), CTRL, 0xf, 0xf, true)); }
struct EpiUpConv {
    static constexpr bool PERM = true, AFTER_DRAIN = false;
    bf16_t* ACT; float* out; float* Hraw; float* Hs; const float* cw; const float* cb; PG8_LAS float* halo;
    __device__ __forceinline__ void save_row(float* d, int c, const f32x4 (&a)[2][2][4][2], int ai, int m) const {
#pragma unroll
        for (int bj = 0; bj < 2; ++bj) { *(f32x4*)(d + c + bj * HALF) = a[ai][bj][m][0]; *(f32x4*)(d + c + bj * HALF + 4) = a[ai][bj][m][1]; }
    }
    __device__ __forceinline__ void operator()(const f32x4 (&acc)[2][2][4][2], const Unit& u, int wr, int wc, int fr, int fq) const {
        const int pm = u.pm, pn = u.pn; const bool samp = (pm == 128);
        const int cphys = pn * BM + wc * 32 + 8 * fq;
        if (fr >= 14) {
#pragma unroll
            for (int ai = 0; ai < 2; ++ai)
#pragma unroll
                for (int bj = 0; bj < 2; ++bj)
#pragma unroll
                    for (int n = 0; n < 2; ++n) *(PG8_LAS f32x4*)(halo + ((2 * ai + wr) * 2 + (fr - 14)) * 256 + bj * HALF + wc * 32 + 8 * fq + 4 * n) = acc[ai][bj][3][n];
        }
        if (wr == 0 && fr < 2) save_row(Hraw + ((size_t)pm * 4 + fr) * FF2, cphys, acc, 0, 0);
        if (wr == 1 && fr >= 14) { save_row(Hraw + ((size_t)pm * 4 + (fr - 12)) * FF2, cphys, acc, 1, 3);
            if (!samp && (pm & 31) == 31) { float* d = out + O_FCP + ((size_t)(pm >> 5) * 2 + (fr - 14)) * FF2; const int cl = pn * HALF + wc * 32 + 8 * fq;
#pragma unroll
                for (int bj = 0; bj < 2; ++bj) { *(f32x4*)(d + cl + bj * FF) = acc[1][bj][3][0]; *(f32x4*)(d + cl + bj * FF + 4) = acc[1][bj][3][1]; } } }
        if (samp) {
#pragma unroll
            for (int m = 0; m < 4; ++m) {
                if (fr < 2) save_row(Hs + ((size_t)(wr * 4 + m) * 2 + fr) * FF2, cphys, acc, 0, m);
                if (fr >= 14) { float* d = out + O_FCS + ((size_t)(wr * 4 + m) * 2 + (fr - 14)) * FF2; const int cl = pn * HALF + wc * 32 + 8 * fq;
#pragma unroll
                    for (int bj = 0; bj < 2; ++bj) { *(f32x4*)(d + cl + bj * FF) = acc[0][bj][m][0]; *(f32x4*)(d + cl + bj * FF + 4) = acc[0][bj][m][1]; } }
            }
        }
        asm volatile("s_waitcnt lgkmcnt(0)" ::: "memory"); __builtin_amdgcn_s_barrier(); asm volatile("" ::: "memory");
#pragma unroll
        for (int n = 0; n < 2; ++n) {
            const int j0 = pn * HALF + wc * 32 + 8 * fq + 4 * n;
            const f32x4 wg0 = *(const f32x4*)(cw + j0), wg1 = *(const f32x4*)(cw + FF2 + j0), wg2 = *(const f32x4*)(cw + 2 * FF2 + j0), bg = *(const f32x4*)(cb + j0);
            const f32x4 wu0 = *(const f32x4*)(cw + FF + j0), wu1 = *(const f32x4*)(cw + FF2 + FF + j0), wu2 = *(const f32x4*)(cw + 2 * FF2 + FF + j0), bu = *(const f32x4*)(cb + FF + j0);
#pragma unroll
            for (int ai = 0; ai < 2; ++ai) {
                const int idx = 2 * ai + wr;
                f32x4 pg = (f32x4){0.f, 0.f, 0.f, 0.f}, pu = (f32x4){0.f, 0.f, 0.f, 0.f};
                if (idx > 0 && fr >= 14) { const PG8_LAS float* hp = halo + ((idx - 1) * 2 + (fr - 14)) * 256 + wc * 32 + 8 * fq + 4 * n; pg = *(const PG8_LAS f32x4*)hp; pu = *(const PG8_LAS f32x4*)(hp + HALF); }
#pragma unroll
                for (int m = 0; m < 4; ++m) {
                    const f32x4 cg = acc[ai][0][m][n], cu = acc[ai][1][m][n];
                    f32x4 a;
#pragma unroll
                    for (int e = 0; e < 4; ++e) {
                        float xg = fmaf(wg2[e], cg[e], bg[e]), xu = fmaf(wu2[e], cu[e], bu[e]);
                        xg = fmaf(dppz<0x111>(cg[e]), wg1[e], xg); xu = fmaf(dppz<0x111>(cu[e]), wu1[e], xu);
                        xg = fmaf(dppz<0x10F>(pg[e]), wg1[e], xg); xu = fmaf(dppz<0x10F>(pu[e]), wu1[e], xu);
                        xg = fmaf(dppz<0x112>(cg[e]), wg0[e], xg); xu = fmaf(dppz<0x112>(cu[e]), wu0[e], xu);
                        xg = fmaf(dppz<0x10E>(pg[e]), wg0[e], xg); xu = fmaf(dppz<0x10E>(pu[e]), wu0[e], xu);
                        a[e] = xg * __builtin_amdgcn_rcpf(1.0f + __expf(-xg)) * xu;
                    }
                    pg = cg; pu = cu;
                    const int r = pm * BM + ai * HALF + wr * 64 + m * 16 + fr;
                    if (r < MV) { typedef unsigned u32x2_ __attribute__((ext_vector_type(2))); u32x2_ w; w.x = cvt_pk_bf16(a[0], a[1]); w.y = cvt_pk_bf16(a[2], a[3]); *(u32x2_*)(ACT + (size_t)r * FF + j0) = w; }
                    __builtin_amdgcn_sched_barrier(0);
                }
            }
        }
    }
};
template <class Epi, class Sched, bool ALIGN_EPI = false, bool SP2 = false, bool HALF_ROWS = false>
__device__ __forceinline__ void gemm_phase(PG8_LAS unsigned char* lds, const Gemm g, const Sched& S, const Epi& E) {
    const int tid = threadIdx.x, wid = __builtin_amdgcn_readfirstlane(tid >> 6), lane = tid & 63, wr = wid >> 2, wc = wid & 3, fr = lane & 15, fq = lane >> 4;
    const int K = g.K, nt = K / BK;
    unsigned voffA[2], voffB[2];
#pragma unroll
    for (int i = 0; i < 2; ++i) { int R, C; stage_rc(tid * 16 + i * 8192, R, C); const int Rb = Epi::PERM ? ((R & ~31) + perm32(R & 31)) : R;
        voffA[i] = (unsigned)(R * K + C) * 2u; voffB[i] = (unsigned)(Rb * K + C) * 2u; }
    const size_t kstep = (size_t)(BK * 2);
    const size_t hstep = (size_t)HALF * K * 2;
    const size_t tstep = 2 * hstep;
    const unsigned ldsw = (unsigned)wid * 1024u;
    const int aoff = lds_byte(wr * 64 + fr, fq * 8), boff = lds_byte(wc * 32 + fr, fq * 8);
#define PG8_SA(b, h) (((b) * 2 + (h)) * HTB)
#define PG8_SB(b, h) ((4 + (b) * 2 + (h)) * HTB)
#define PG8_STAGE(bufoff, gbase, voff) do { _Pragma("unroll") for (int _i = 0; _i < 2; ++_i) \
        __builtin_amdgcn_global_load_lds((const unsigned*)((const char*)(gbase) + (voff)[_i]), (PG8_LAS unsigned*)(lds + (bufoff) + ldsw + _i * 8192), 16, 0, 0); } while (0)
#define PG8_LDA(dst, b, h) do { _Pragma("unroll") for (int m = 0; m < 4; ++m) _Pragma("unroll") for (int k = 0; k < 2; ++k) dst[m][k] = *(const PG8_LAS bf16x8*)(lds + PG8_SA(b, h) + aoff + m * 2048 + k * 1024); } while (0)
#define PG8_LDB(dst, b, h) do { _Pragma("unroll") for (int n = 0; n < 2; ++n) _Pragma("unroll") for (int k = 0; k < 2; ++k) dst[n][k] = *(const PG8_LAS bf16x8*)(lds + PG8_SB(b, h) + boff + n * 2048 + k * 1024); } while (0)
#define PG8_MMA(ai, bj, At, Bt) do { __builtin_amdgcn_s_setprio(1); _Pragma("unroll") for (int m = 0; m < 4; ++m) _Pragma("unroll") for (int n = 0; n < 2; ++n) _Pragma("unroll") for (int k = 0; k < 2; ++k) \
        acc[ai][bj][m][n] = __builtin_amdgcn_mfma_f32_16x16x32_bf16(Bt[n][k], At[m][k], acc[ai][bj][m][n], 0, 0, 0); __builtin_amdgcn_s_setprio(0); } while (0)
#define PG8_WAIT_V(n) asm volatile("s_waitcnt vmcnt(" #n ")" ::: "memory")
#define PG8_WAIT_L(n) asm volatile("s_waitcnt lgkmcnt(" #n ")" ::: "memory")
#define PG8_BAR __builtin_amdgcn_s_barrier()
#define PG8_SCHED __builtin_amdgcn_sched_barrier(0)
    Unit cur, nxt; int ui = 0;
    if (!S.next(0, cur)) return;
    f32x4 acc[2][2][4][2];
#pragma unroll
    for (int a = 0; a < 2; ++a)
#pragma unroll
        for (int b = 0; b < 2; ++b)
#pragma unroll
            for (int m = 0; m < 4; ++m)
#pragma unroll
                for (int n = 0; n < 2; ++n) acc[a][b][m][n] = (f32x4){0.f, 0.f, 0.f, 0.f};
    bf16x8 At[4][2], B0[2][2], B1[2][2];
    const char* cA = (const char*)g.A + (size_t)cur.pm * tstep; const char* cB = (const char*)g.Bt + (size_t)cur.pn * tstep;
    S.a_ready(cur);
    if constexpr (SP2) {
        PG8_STAGE(PG8_SB(0, 0), cB, voffB); PG8_STAGE(PG8_SB(0, 1), cB + hstep, voffB); PG8_STAGE(PG8_SA(0, 0), cA, voffA); PG8_STAGE(PG8_SA(0, 1), cA + hstep, voffA);
        if (wr == 1) PG8_BAR;
        PG8_WAIT_V(2); PG8_BAR;
        PG8_STAGE(PG8_SB(1, 0), cB + kstep, voffB); PG8_STAGE(PG8_SA(1, 0), cA + kstep, voffA); PG8_STAGE(PG8_SB(1, 1), cB + hstep + kstep, voffB);
        PG8_WAIT_V(6); PG8_BAR;
    } else {
        PG8_STAGE(PG8_SB(0, 0), cB, voffB); PG8_STAGE(PG8_SA(0, 0), cA, voffA); PG8_STAGE(PG8_SB(0, 1), cB + hstep, voffB); PG8_STAGE(PG8_SA(0, 1), cA + hstep, voffA);
        if (wr == 1) PG8_BAR;
        PG8_WAIT_V(4); PG8_BAR;
        PG8_STAGE(PG8_SB(1, 0), cB + kstep, voffB); PG8_STAGE(PG8_SA(1, 0), cA + kstep, voffA); PG8_STAGE(PG8_SB(1, 1), cB + hstep + kstep, voffB);
        PG8_WAIT_V(6); PG8_BAR;
    }
    for (;;) {
        const bool has_next = S.next(ui + 1, nxt);
        const char* nA = has_next ? (const char*)g.A + (size_t)nxt.pm * tstep : cA; const char* nB = has_next ? (const char*)g.Bt + (size_t)nxt.pn * tstep : cB;
        for (int t = 0; t < nt; t += 2) {
            const bool last = (t == nt - 2);
            const char* a1 = cA + (size_t)(t + 1) * kstep;
            const char* a2 = last ? nA : cA + (size_t)(t + 2) * kstep; const char* b2 = last ? nB : cB + (size_t)(t + 2) * kstep;
            const char* a3 = a2 + kstep; const char* b3 = b2 + kstep;
            if (last && has_next) S.a_ready(nxt);
            if constexpr (SP2) {
            PG8_LDB(B0, 0, 0); PG8_LDB(B1, 0, 1); PG8_SCHED; PG8_LDA(At, 0, 0); PG8_STAGE(PG8_SA(1, 1), a1 + hstep, voffA);
            PG8_WAIT_V(8); PG8_WAIT_L(0); PG8_BAR; PG8_MMA(0, 0, At, B0); PG8_MMA(0, 1, At, B1); PG8_BAR; PG8_SCHED;
            PG8_LDA(At, 0, 1); PG8_STAGE(PG8_SB(0, 0), b2, voffB); PG8_STAGE(PG8_SB(0, 1), b2 + hstep, voffB); PG8_STAGE(PG8_SA(0, 0), a2, voffA);
            PG8_WAIT_V(8); PG8_WAIT_L(0); PG8_BAR; if constexpr (!HALF_ROWS) { PG8_MMA(1, 0, At, B0); PG8_MMA(1, 1, At, B1); } PG8_BAR; PG8_SCHED;
            PG8_LDB(B0, 1, 0); PG8_LDB(B1, 1, 1); PG8_SCHED; PG8_LDA(At, 1, 0); PG8_STAGE(PG8_SA(0, 1), a2 + hstep, voffA);
            PG8_WAIT_V(8); PG8_WAIT_L(0); PG8_BAR; PG8_MMA(0, 0, At, B0); PG8_MMA(0, 1, At, B1); PG8_BAR; PG8_SCHED;
            PG8_LDA(At, 1, 1); PG8_STAGE(PG8_SB(1, 0), b3, voffB); PG8_STAGE(PG8_SB(1, 1), b3 + hstep, voffB); PG8_STAGE(PG8_SA(1, 0), a3, voffA);
            PG8_WAIT_V(8); PG8_WAIT_L(0); PG8_BAR; if constexpr (!HALF_ROWS) { PG8_MMA(1, 0, At, B0); PG8_MMA(1, 1, At, B1); } PG8_BAR; PG8_SCHED;
            } else {
            PG8_LDB(B0, 0, 0); PG8_SCHED; PG8_LDA(At, 0, 0); PG8_STAGE(PG8_SA(1, 1), a1 + hstep, voffA);
            PG8_WAIT_L(8); PG8_BAR; PG8_WAIT_L(0); PG8_MMA(0, 0, At, B0); PG8_BAR; PG8_SCHED;
            PG8_LDB(B1, 0, 1); PG8_STAGE(PG8_SB(0, 0), b2, voffB);
            PG8_BAR; PG8_WAIT_L(0); PG8_MMA(0, 1, At, B1); PG8_BAR;
            PG8_LDA(At, 0, 1); PG8_STAGE(PG8_SA(0, 0), a2, voffA);
            PG8_BAR; PG8_WAIT_L(0); PG8_MMA(1, 0, At, B0); PG8_BAR; PG8_SCHED;
            PG8_STAGE(PG8_SB(0, 1), b2 + hstep, voffB);
            PG8_WAIT_V(6); PG8_BAR; PG8_MMA(1, 1, At, B1); PG8_BAR;
            PG8_LDB(B0, 1, 0); PG8_SCHED; PG8_LDA(At, 1, 0); PG8_STAGE(PG8_SA(0, 1), a2 + hstep, voffA);
            PG8_WAIT_L(8); PG8_BAR; PG8_WAIT_L(0); PG8_MMA(0, 0, At, B0); PG8_BAR; PG8_SCHED;
            PG8_LDB(B1, 1, 1); PG8_STAGE(PG8_SB(1, 0), b3, voffB);
            PG8_BAR; PG8_WAIT_L(0); PG8_MMA(0, 1, At, B1); PG8_BAR;
            PG8_LDA(At, 1, 1); PG8_STAGE(PG8_SA(1, 0), a3, voffA);
            PG8_BAR; PG8_WAIT_L(0); PG8_MMA(1, 0, At, B0); PG8_BAR; PG8_SCHED;
            PG8_STAGE(PG8_SB(1, 1), b3 + hstep, voffB);
            PG8_WAIT_V(6); PG8_BAR; PG8_MMA(1, 1, At, B1); PG8_BAR;
            }
        }
        if constexpr (ALIGN_EPI) { if (wr == 0) PG8_BAR; }
        if constexpr (!Epi::AFTER_DRAIN) { E(acc, cur, wr, wc, fr, fq); S.done(cur); }
        if (!has_next) break;
#pragma unroll
        for (int a = 0; a < 2; ++a)
#pragma unroll
            for (int b = 0; b < 2; ++b)
#pragma unroll
                for (int m = 0; m < 4; ++m)
#pragma unroll
                    for (int n = 0; n < 2; ++n) acc[a][b][m][n] = (f32x4){0.f, 0.f, 0.f, 0.f};
        cur = nxt; cA = nA; cB = nB; ++ui;
        if constexpr (ALIGN_EPI) { if (wr == 1) PG8_BAR; }
    }
    PG8_WAIT_V(0);
    if constexpr (!ALIGN_EPI) { if (wr == 0) PG8_BAR; }
    PG8_BAR;
    if constexpr (Epi::AFTER_DRAIN) { E.fused(acc, cur, wr, wc, fr, fq, lds, wid, lane); S.done(cur); }
#undef PG8_SA
#undef PG8_SB
#undef PG8_STAGE
#undef PG8_LDA
#undef PG8_LDB
#undef PG8_MMA
#undef PG8_WAIT_V
#undef PG8_WAIT_L
#undef PG8_BAR
#undef PG8_SCHED
}
}
#include <hip/hip_bf16.h>
#include <cmath>
namespace attn_body {
using bf16=__hip_bfloat16;
using bf16x8=__attribute__((ext_vector_type(8)))short;
using s16x4=__attribute__((ext_vector_type(4)))short;
using f32x16=__attribute__((ext_vector_type(16)))float;
using u32x4=__attribute__((ext_vector_type(4)))unsigned;
constexpr int D=64,DM=512;
constexpr int NW=8,QBLK=32,QB=QBLK*NW,KVBLK=64;
__device__ __forceinline__ int crow(int r,int hi){return (r&3)+8*(r>>2)+4*hi;}
#define SBAR() __builtin_amdgcn_sched_barrier(0)
__device__ __forceinline__ void cmask(f32x16&p0,f32x16&p1,int jb,int wid,int mode){
  const float NEG=-INFINITY; const bool all=(mode==0)?(jb>(wid>>1)):(jb==3); const bool part=(mode==1)&&(jb==2);
  #pragma unroll
  for(int r=0;r<16;++r){ if(all||(part&&r>=8))p0[r]=NEG; if(all||part)p1[r]=NEG; }
}

constexpr int NSLOT=3, SLOTB=8192;
constexpr int LDS_K=0, LDS_V=NSLOT*SLOTB, LDS_WS=2*NSLOT*SLOTB, LDS_OST=LDS_WS+NW*64*4, LDS_BYTES=LDS_OST+NW*4096;
constexpr float C2=0.125f*1.4426950408889634f;
__device__ __forceinline__ void glds16(const void*gsrc,unsigned lds_dst){unsigned keep;
  asm volatile("s_mov_b32 %0, m0\n\ts_mov_b32 m0, %2\n\ts_nop 0\n\tglobal_load_lds_dwordx4 %1, off\n\ts_mov_b32 m0, %0":"=&s"(keep):"v"(gsrc),"s"(lds_dst):"memory");}
__device__ __forceinline__ float max3f(float a,float b,float c){float r;asm("v_max3_f32 %0, %1, %2, %3":"=v"(r):"v"(a),"v"(b),"v"(c));return r;}
__device__ __forceinline__ float max2f(float a,float b){float r;asm("v_max_f32_e32 %0, %1, %2":"=v"(r):"v"(a),"v"(b));return r;}
__device__ __forceinline__ float fadd_s(float a,float b){float r;asm("v_add_f32_e32 %0, %1, %2":"=v"(r):"v"(a),"v"(b));return r;}
__device__ __forceinline__ float fsub_s(float a,float b){float r;asm("v_sub_f32_e32 %0, %1, %2":"=v"(r):"v"(a),"v"(b));return r;}
typedef float f32x2_t __attribute__((ext_vector_type(2))); typedef __bf16 bf16x2_t __attribute__((ext_vector_type(2)));
__device__ __forceinline__ unsigned cvtpk_s(float lo,float hi){f32x2_t v={lo,hi};bf16x2_t b=__builtin_convertvector(v,bf16x2_t);return __builtin_bit_cast(unsigned,b);}
#define WAIT_BAR(N) asm volatile("s_waitcnt vmcnt(" #N ") lgkmcnt(0)\n\ts_barrier":::"memory")

__device__ __forceinline__ void qkt(f32x16&p0,f32x16&p1,const char*Kslot,const bf16x8*qr,const f32x16&negm,int r32,int hi){
  const char*kb=Kslot+hi*1024+r32*16;
  #pragma unroll
  for(int d0=0;d0<4;++d0){
    const bf16x8 b0=*reinterpret_cast<const bf16x8*>(kb+d0*2048);
    const bf16x8 b1=*reinterpret_cast<const bf16x8*>(kb+d0*2048+512);
    if(d0==0){p0=__builtin_amdgcn_mfma_f32_32x32x16_bf16(b0,qr[0],negm,0,0,0);p1=__builtin_amdgcn_mfma_f32_32x32x16_bf16(b1,qr[0],negm,0,0,0);}
    else{p0=__builtin_amdgcn_mfma_f32_32x32x16_bf16(b0,qr[d0],p0,0,0,0);p1=__builtin_amdgcn_mfma_f32_32x32x16_bf16(b1,qr[d0],p1,0,0,0);}}
}
typedef __attribute__((address_space(3))) const char* lds_cptr;
typedef short v4i16_t __attribute__((ext_vector_type(4)));
__device__ __forceinline__ void kload8(bf16x8*kf,lds_cptr kp){
  kf[0]=*(const __attribute__((address_space(3))) bf16x8*)(kp);      kf[1]=*(const __attribute__((address_space(3))) bf16x8*)(kp+512);
  kf[2]=*(const __attribute__((address_space(3))) bf16x8*)(kp+2048); kf[3]=*(const __attribute__((address_space(3))) bf16x8*)(kp+2560);
  kf[4]=*(const __attribute__((address_space(3))) bf16x8*)(kp+4096); kf[5]=*(const __attribute__((address_space(3))) bf16x8*)(kp+4608);
  kf[6]=*(const __attribute__((address_space(3))) bf16x8*)(kp+6144); kf[7]=*(const __attribute__((address_space(3))) bf16x8*)(kp+6656);
}
__device__ __forceinline__ void kload2(bf16x8*kf,lds_cptr kp,int j){ kf[2*j]=*(const __attribute__((address_space(3))) bf16x8*)(kp+j*2048); kf[2*j+1]=*(const __attribute__((address_space(3))) bf16x8*)(kp+j*2048+512); }
__device__ __forceinline__ s16x4 vtr(lds_cptr p){ return __builtin_bit_cast(s16x4,__builtin_amdgcn_ds_read_tr16_b64_v4i16((__attribute__((address_space(3))) v4i16_t*)p)); }
__device__ __forceinline__ float rowmax(const f32x16&p0,const f32x16&p1){
  float a=max3f(p0[0],p0[1],p1[0]),b=max3f(p0[2],p0[3],p1[1]);a=max3f(a,p1[2],p1[3]);
  #pragma unroll
  for(int r=4;r<16;r+=4){a=max3f(a,p0[r],p0[r+1]);b=max3f(b,p0[r+2],p0[r+3]);a=max3f(a,p1[r],p1[r+1]);b=max3f(b,p1[r+2],p1[r+3]);}
  const float m=max2f(a,b);
  auto rr=__builtin_amdgcn_permlane32_swap(__float_as_uint(m),__float_as_uint(m),false,false);
  return max2f(__uint_as_float(rr[0]),__uint_as_float(rr[1]));
}
__device__ __forceinline__ void pv(f32x16*o,int vb,bf16x8 pa0,bf16x8 pa1,bf16x8 pa2,bf16x8 pa3){
  #pragma unroll
  for(int d0=0;d0<2;++d0){s16x4 lo[4],hi[4];
    #pragma unroll
    for(int ks=0;ks<4;++ks){
      asm volatile("ds_read_b64_tr_b16 %0,%1 offset:%c2":"=&v"(lo[ks]):"v"(vb),"i"(d0*4096+ks*1024):"memory");
      asm volatile("ds_read_b64_tr_b16 %0,%1 offset:%c2":"=&v"(hi[ks]):"v"(vb),"i"(d0*4096+ks*1024+512):"memory");}
    asm volatile("s_waitcnt lgkmcnt(0)":::"memory");SBAR();
    #define PK(k) (bf16x8){lo[k][0],lo[k][1],lo[k][2],lo[k][3],hi[k][0],hi[k][1],hi[k][2],hi[k][3]}
    o[d0]=__builtin_amdgcn_mfma_f32_32x32x16_bf16(pa0,PK(0),o[d0],0,0,0);
    o[d0]=__builtin_amdgcn_mfma_f32_32x32x16_bf16(pa1,PK(1),o[d0],0,0,0);
    o[d0]=__builtin_amdgcn_mfma_f32_32x32x16_bf16(pa2,PK(2),o[d0],0,0,0);
    o[d0]=__builtin_amdgcn_mfma_f32_32x32x16_bf16(pa3,PK(3),o[d0],0,0,0);
    #undef PK
  }
}

#ifndef ATTN_STORE16
#define ATTN_STORE16(p,v) (*(u32x4*)(p)=(v))
#endif
template<int THRL> __device__ __forceinline__ void attn_unit(const bf16*Qu,const bf16*__restrict__ Ku,const bf16*__restrict__ Vu,bf16*Ou,const int NT,const int mode,char*shm){
  const int tid=threadIdx.x,lane=tid&63,r32=lane&31,hi=lane>>5; const int wid=__builtin_amdgcn_readfirstlane(tid>>6);
  const bf16*Qw=Qu+(long)(wid*QBLK)*DM;
  const bf16*Kh=Ku,*Vh=Vu;
  const unsigned lds0=(unsigned)(uintptr_t)shm;
  float*wsf=(float*)(shm+LDS_WS)+wid*64;
  const bf16*ksrc=Kh+(long)lane*DM+wid*8;
  const bf16*vsrc=Vh+(long)(16*(wid&3)+(lane>>2))*DM+(wid>>2)*32+(lane&3)*8;
  const unsigned kdst=lds0+LDS_K+wid*1024, vdst=lds0+LDS_V+wid*1024;
  #define DMA_K(t,slot) glds16(ksrc+(long)(t)*KVBLK*DM,(unsigned)__builtin_amdgcn_readfirstlane(kdst+(slot)))
  #define DMA_V(t,slot) glds16(vsrc+(long)(t)*KVBLK*DM,(unsigned)__builtin_amdgcn_readfirstlane(vdst+(slot)))
  const int vb0=(int)(lds0+LDS_V)+((lane>>4)&1)*32+(lane&3)*8+(4*hi+((lane&15)>>2))*64;
  const char*Kbase=shm+LDS_K; bf16x8 kf[8];
  const lds_cptr shm3=(lds_cptr)shm; const lds_cptr kp0=shm3+LDS_K+hi*1024+r32*16; const lds_cptr vp0=shm3+LDS_V+((lane>>4)&1)*32+(lane&3)*8+(4*hi+((lane&15)>>2))*64;
  DMA_K(0,0);DMA_V(0,0);DMA_K(1,SLOTB);
  bf16x8 qr[4];
  #pragma unroll
  for(int d0=0;d0<4;++d0)qr[d0]=*reinterpret_cast<const bf16x8*>(&Qw[(long)r32*DM+d0*16+hi*8]);
  float mhat=0.f,l_reg=0.f;f32x16 o[2];o[0]=f32x16{};o[1]=f32x16{};f32x16 negm=f32x16{};asm volatile("":"+v"(negm));
  const int qrel=wid*QBLK+r32;
  #define CMASK(P0,P1,t) do{int jb_=(t)-(NT-4); if(jb_>=0)cmask(P0,P1,jb_,wid,mode);}while(0)
  bool resc=false;
  #define START(P0,P1) do{ const float rm=rowmax(P0,P1); resc=false; \
    { const float dl=rm; mhat=fadd_s(mhat,dl); \
      _Pragma("unroll") for(int r=0;r<16;++r){P0[r]=fsub_s(P0[r],dl);P1[r]=fsub_s(P1[r],dl);} \
      _Pragma("unroll") for(int r=0;r<16;++r)negm[r]=-mhat; asm volatile("":"+v"(negm)); } \
    _Pragma("unroll") for(int r=0;r<16;++r)P0[r]=__builtin_amdgcn_exp2f(P0[r]); }while(0)
  #define RESC() do{ if(resc){ asm volatile("s_waitcnt lgkmcnt(0)":::"memory"); \
      _Pragma("unroll") for(int d_=0;d_<2;++d_) _Pragma("unroll") for(int r=0;r<16;++r)o[d_][r]*=wsf[crow(r,hi)]; } }while(0)
  f32x16 pA0,pA1,pB0,pB1;
  int sl_prev=0,sl_cur=0,sl_next=SLOTB;
  #define ROT() do{sl_prev=sl_cur;sl_cur=sl_next;sl_next=(sl_next==(NSLOT-1)*SLOTB)?0:sl_next+SLOTB;}while(0)
  DMA_K(2,2*SLOTB);
  WAIT_BAR(3);
  qkt(pA0,pA1,Kbase,qr,negm,r32,hi);asm volatile("s_nop 15\n\ts_nop 7":"+v"(pA0),"+v"(pA1));CMASK(pA0,pA1,0);
  START(pA0,pA1);
  _Pragma("unroll") for(int r=0;r<16;++r)pA1[r]=__builtin_amdgcn_exp2f(pA1[r]);
  WAIT_BAR(0);
  DMA_K(3,0);DMA_V(1,SLOTB);
  ROT();
  kload8(kf,kp0+sl_cur);
  WAIT_BAR(2);
  s16x4 vlo[8],vhi[8]; u32x4 pw0,pw1,pw2,pw3;
  #define PKW(P,B) cvtpk_s(P[B],P[B+1])
  #define PAF(k) __builtin_bit_cast(bf16x8,pw##k)
  #define VFR(i) (bf16x8){vlo[i][0],vlo[i][1],vlo[i][2],vlo[i][3],vhi[i][0],vhi[i][1],vhi[i][2],vhi[i][3]}
  #define PIN(x) asm volatile("":"+v"(x))
  #define MX3(a,b,c) __builtin_fmaxf(__builtin_fmaxf((a),(b)),(c))
  #define GAPA(MF,A0,A1,A2,A3,W0,W1,PW) do{ MF; sacc+=A0; sacc+=A1; sacc+=A2; sacc+=A3; PIN(sacc); W0; W1; PIN(PW); SBAR(); }while(0)
  #define EX(v) __builtin_amdgcn_exp2f(v)
  #define GAPB(MF,X,B) do{ MF; X[B]=EX(X[B]); X[B+1]=EX(X[B+1]); X[B+2]=EX(X[B+2]); X[B+3]=EX(X[B+3]); PIN(X); SBAR(); }while(0)
  #define VRD(i) do{ vlo[i]=vtr(vp_+(((i)>>2)*4096+((i)&3)*1024)); vhi[i]=vtr(vp_+(((i)>>2)*4096+((i)&3)*1024+512)); }while(0)
  #define KRD(G,j) do{ if(G){ kload2(kf,kp0+sl_next,j); SBAR(); } }while(0)
  #define STEP(C0,C1,P0,P1,t,GK,GV,GL) do{ SBAR(); \
    const lds_cptr vp_=vp0+sl_prev; \
    VRD(0); SBAR(); float sacc=(P0[0]+P0[1]); \
    GAPA(C0=__builtin_amdgcn_mfma_f32_32x32x16_bf16(kf[0],qr[0],negm,0,0,0), P0[2],P0[3],P0[4],P0[5],     pw0[0]=PKW(P0,0), pw0[1]=PKW(P0,2), pw0); \
    VRD(4); SBAR(); GAPA(C1=__builtin_amdgcn_mfma_f32_32x32x16_bf16(kf[1],qr[0],negm,0,0,0), P0[6],P0[7],P0[8],P0[9],     pw0[2]=PKW(P0,4), pw0[3]=PKW(P0,6), pw0); \
    VRD(1); SBAR(); GAPA(C0=__builtin_amdgcn_mfma_f32_32x32x16_bf16(kf[2],qr[1],C0,0,0,0),   P0[10],P0[11],P0[12],P0[13], pw1[0]=PKW(P0,8), pw1[1]=PKW(P0,10), pw1); \
    VRD(5); SBAR(); GAPA(C1=__builtin_amdgcn_mfma_f32_32x32x16_bf16(kf[3],qr[1],C1,0,0,0),   P0[14],P0[15],P1[0],P1[1],   pw1[2]=PKW(P0,12),pw1[3]=PKW(P0,14), pw1); \
    VRD(2); SBAR(); GAPA(C0=__builtin_amdgcn_mfma_f32_32x32x16_bf16(kf[4],qr[2],C0,0,0,0),   P1[2],P1[3],P1[4],P1[5],     pw2[0]=PKW(P1,0), pw2[1]=PKW(P1,2), pw2); \
    VRD(6); SBAR(); GAPA(C1=__builtin_amdgcn_mfma_f32_32x32x16_bf16(kf[5],qr[2],C1,0,0,0),   P1[6],P1[7],P1[8],P1[9],     pw2[2]=PKW(P1,4), pw2[3]=PKW(P1,6), pw2); \
    VRD(3); SBAR(); GAPA(C0=__builtin_amdgcn_mfma_f32_32x32x16_bf16(kf[6],qr[3],C0,0,0,0),   P1[10],P1[11],P1[12],P1[13], pw3[0]=PKW(P1,8), pw3[1]=PKW(P1,10), pw3); \
    VRD(7); SBAR(); GAPA(C1=__builtin_amdgcn_mfma_f32_32x32x16_bf16(kf[7],qr[3],C1,0,0,0),   P1[14],P1[15],0.f,0.f,       pw3[2]=PKW(P1,12),pw3[3]=PKW(P1,14), pw3); \
    l_reg+=sacc; \
    if(GK){DMA_K((t)+3,sl_cur);} if(GV){DMA_V((t)+1,sl_next);} \
    CMASK(C0,C1,t); \
    { float a=MX3(C0[0],C0[1],C1[0]),b=MX3(C0[2],C0[3],C1[1]); a=MX3(a,C1[2],C1[3]); \
      _Pragma("unroll") for(int r=4;r<16;r+=4){a=MX3(a,C0[r],C0[r+1]);b=MX3(b,C0[r+2],C0[r+3]);a=MX3(a,C1[r],C1[r+1]);b=MX3(b,C1[r+2],C1[r+3]);} \
      float rm=__builtin_fmaxf(a,b); { auto rr=__builtin_amdgcn_permlane32_swap(__float_as_uint(rm),__float_as_uint(rm),false,false); rm=__builtin_fmaxf(__uint_as_float(rr[0]),__uint_as_float(rr[1])); } \
      resc=false; \
      if(__builtin_expect(__any(rm>(float)THRL),0)){ const float dl=__builtin_fmaxf(rm,0.f); mhat+=dl; \
        _Pragma("unroll") for(int r=0;r<16;++r){C0[r]-=dl;C1[r]-=dl;} \
        _Pragma("unroll") for(int r=0;r<16;++r)negm[r]=-mhat; asm volatile("":"+v"(negm)); \
        const float f=__builtin_amdgcn_exp2f(-dl); l_reg*=f; if(hi==0)wsf[r32]=f; resc=true; } } \
    SBAR(); \
    GAPB(o[0]=__builtin_amdgcn_mfma_f32_32x32x16_bf16(PAF(0),VFR(0),o[0],0,0,0), C0,0); \
    GAPB(o[1]=__builtin_amdgcn_mfma_f32_32x32x16_bf16(PAF(0),VFR(4),o[1],0,0,0), C0,4); \
    KRD(GL,0); GAPB(o[0]=__builtin_amdgcn_mfma_f32_32x32x16_bf16(PAF(1),VFR(1),o[0],0,0,0), C0,8); \
    KRD(GL,1); GAPB(o[1]=__builtin_amdgcn_mfma_f32_32x32x16_bf16(PAF(1),VFR(5),o[1],0,0,0), C0,12); \
    KRD(GL,2); GAPB(o[0]=__builtin_amdgcn_mfma_f32_32x32x16_bf16(PAF(2),VFR(2),o[0],0,0,0), C1,0); \
    KRD(GL,3); GAPB(o[1]=__builtin_amdgcn_mfma_f32_32x32x16_bf16(PAF(2),VFR(6),o[1],0,0,0), C1,4); \
    GAPB(o[0]=__builtin_amdgcn_mfma_f32_32x32x16_bf16(PAF(3),VFR(3),o[0],0,0,0), C1,8); \
    GAPB(o[1]=__builtin_amdgcn_mfma_f32_32x32x16_bf16(PAF(3),VFR(7),o[1],0,0,0), C1,12); \
    }while(0)
  int t=1;
  #undef CMASK
  #define CMASK(P0,P1,t) do{}while(0)
  for(;t+5<NT;t+=2){
    STEP(pB0,pB1,pA0,pA1,t,true,true,true);     WAIT_BAR(2); RESC(); ROT();
    STEP(pA0,pA1,pB0,pB1,t+1,true,true,true);   WAIT_BAR(2); RESC(); ROT();
  }
  #undef CMASK
  #define CMASK(P0,P1,t) do{int jb_=(t)-(NT-4); if(jb_>=0)cmask(P0,P1,jb_,wid,mode);}while(0)
  #define ENDW(tt) do{ if((tt)+3<NT){WAIT_BAR(2);} else if((tt)+2<NT){WAIT_BAR(1);} else {WAIT_BAR(0);} }while(0)
  for(;t+1<NT;t+=2){
    STEP(pB0,pB1,pA0,pA1,t,(t+3<NT),(t+1<NT),(t+1<NT));       ENDW(t);   RESC(); ROT();
    STEP(pA0,pA1,pB0,pB1,t+1,(t+4<NT),(t+2<NT),(t+2<NT));     ENDW(t+1); RESC(); ROT();
  }
  STEP(pB0,pB1,pA0,pA1,NT-1,false,false,false); RESC();
  { float sacc=pB0[0]+pB0[1]; _Pragma("unroll") for(int r=2;r<16;++r)sacc+=pB0[r]; _Pragma("unroll") for(int r=0;r<16;++r)sacc+=pB1[r]; l_reg+=sacc;
    pw0=(u32x4){PKW(pB0,0),PKW(pB0,2),PKW(pB0,4),PKW(pB0,6)};pw1=(u32x4){PKW(pB0,8),PKW(pB0,10),PKW(pB0,12),PKW(pB0,14)};pw2=(u32x4){PKW(pB1,0),PKW(pB1,2),PKW(pB1,4),PKW(pB1,6)};pw3=(u32x4){PKW(pB1,8),PKW(pB1,10),PKW(pB1,12),PKW(pB1,14)};
    SBAR(); pv(o,vb0+sl_cur,PAF(0),PAF(1),PAF(2),PAF(3)); }
  #undef PKW
  #undef PAF
  #undef VFR
  #undef PIN
  #undef MX3
  #undef GAPA
  #undef GAPB
  #undef EX
  #undef VRD
  #undef KRD
  #undef STEP
  #undef ENDW
  {auto rr=__builtin_amdgcn_permlane32_swap(__float_as_uint(l_reg),__float_as_uint(l_reg),false,false);l_reg=__uint_as_float(rr[0])+__uint_as_float(rr[1]);}
  if(hi==0)wsf[32+r32]=l_reg;asm volatile("s_waitcnt lgkmcnt(0)":::"memory");
  float rli[16];
  #pragma unroll
  for(int r=0;r<16;++r)rli[r]=__builtin_amdgcn_rcpf(wsf[32+crow(r,hi)]);
  bf16*Ow=Ou+(long)(wid*QBLK)*DM;
  { bf16*stg=(bf16*)(shm+LDS_OST)+wid*2048;
    #pragma unroll
    for(int r=0;r<16;++r){const int orow=crow(r,hi);
      #pragma unroll
      for(int d0=0;d0<2;++d0)stg[orow*64+d0*32+r32]=__float2bfloat16(o[d0][r]*rli[r]);}
    asm volatile("s_waitcnt lgkmcnt(0)":::"memory");
    #pragma unroll
    for(int i=0;i<4;++i){const int row=i*8+(lane>>3),ch=lane&7; const u32x4 v=*(const u32x4*)(stg+row*64+ch*8); ATTN_STORE16(Ow+(long)row*DM+ch*8,v);} }
  asm volatile("s_waitcnt lgkmcnt(0)\n\ts_barrier":::"memory");
  #undef DMA_K
  #undef DMA_V
  #undef CMASK
  #undef START
  #undef RESC
  #undef ROT
}
constexpr int ATTN_LDS_BYTES=LDS_BYTES;

#undef SBAR
#undef WAIT_BAR
}
namespace attn2 {
using bf16 = __hip_bfloat16;
constexpr int NW = 8, QBLK = 32, KVBLK = 64, LD = 512;
constexpr size_t SHM_V = KVBLK * 128 * 2, SHM_K = KVBLK * 64 * 2, SHM_ATTN = 3 * SHM_V + 3 * SHM_K + NW * 64 * 4;
constexpr float THR = 8.f, NEGBIG = -1e30f;
using bf16x8 = __attribute__((ext_vector_type(8))) short;
using s16x4  = __attribute__((ext_vector_type(4))) short;
using f32x16 = __attribute__((ext_vector_type(16))) float;
using u32x4  = __attribute__((ext_vector_type(4))) unsigned;
#define A2_KSWZ(row, colB) ((row) * 128 + ((colB) ^ (((row) & 7) << 4)))
#define A2_SBAR() __builtin_amdgcn_sched_barrier(0)
__device__ __forceinline__ int crow(int r, int hi) { return (r & 3) + 8 * (r >> 2) + 4 * hi; }
__device__ __forceinline__ unsigned cvtpk(float lo, float hi) { typedef float f2 __attribute__((ext_vector_type(2))); typedef __bf16 b2 __attribute__((ext_vector_type(2))); f2 v = {lo, hi}; b2 b = __builtin_convertvector(v, b2); return __builtin_bit_cast(unsigned, b); }
__device__ __forceinline__ void amask(f32x16& p0, f32x16& p1, int j, int NT, int wid, int mode) {
  const int jb = j - (NT - 4); if (jb < 0) return;
  const bool all = (mode == 0) ? (jb > (wid >> 1)) : (jb == 3); const bool part = (mode == 1) && (jb == 2);
#pragma unroll
  for (int r = 0; r < 16; ++r) { if (all || (part && r >= 8)) p0[r] = NEGBIG; if (all || part) p1[r] = NEGBIG; }
}
__device__ __forceinline__ void partialSM(f32x16& p0, f32x16& p1, float& m_reg, float& mn, float& alpha) {
  float pmax = p0[0];
#pragma unroll
  for (int r = 1; r < 16; ++r) pmax = fmaxf(pmax, p0[r]);
#pragma unroll
  for (int r = 0; r < 16; ++r) pmax = fmaxf(pmax, p1[r]);
  { auto rr = __builtin_amdgcn_permlane32_swap(__float_as_uint(pmax), __float_as_uint(pmax), false, false); pmax = fmaxf(__uint_as_float(rr[0]), __uint_as_float(rr[1])); }
  if (__builtin_expect(__all(pmax - m_reg <= THR), 1)) { mn = m_reg; alpha = 1.f; }
  else { mn = fmaxf(m_reg, pmax); alpha = __builtin_amdgcn_exp2f(m_reg - mn); m_reg = mn; }
#pragma unroll
  for (int r = 0; r < 16; ++r) { p0[r] = p0[r] - mn; p1[r] = p1[r] - mn; }
#pragma unroll
  for (int r = 0; r < 16; ++r) p0[r] = __builtin_amdgcn_exp2f(p0[r]);
}
__device__ __forceinline__ void psm_head(const f32x16& p0, const f32x16& p1, float& m_reg, float& mn, float& alpha) {
  float pmax = p0[0];
#pragma unroll
  for (int r = 1; r < 16; ++r) pmax = fmaxf(pmax, p0[r]);
#pragma unroll
  for (int r = 0; r < 16; ++r) pmax = fmaxf(pmax, p1[r]);
  { auto rr = __builtin_amdgcn_permlane32_swap(__float_as_uint(pmax), __float_as_uint(pmax), false, false); pmax = fmaxf(__uint_as_float(rr[0]), __uint_as_float(rr[1])); }
  if (__builtin_expect(__all(pmax - m_reg <= THR), 1)) { mn = m_reg; alpha = 1.f; }
  else { mn = fmaxf(m_reg, pmax); alpha = __builtin_amdgcn_exp2f(m_reg - mn); m_reg = mn; }
}
typedef float f2_t __attribute__((ext_vector_type(2)));
template <int D> __device__ __forceinline__ void psm_slice(f32x16& p0, f32x16& p1, float mn) {
  const f2_t m2 = {mn, mn};
#pragma unroll
  for (int r = 4 * D; r < 4 * D + 4; r += 2) {
    f2_t a = {p0[r], p0[r + 1]}, c = {p1[r], p1[r + 1]}; a = a - m2; c = c - m2;
    p0[r] = __builtin_amdgcn_exp2f(a.x); p0[r + 1] = __builtin_amdgcn_exp2f(a.y); p1[r] = __builtin_amdgcn_exp2f(c.x); p1[r + 1] = __builtin_amdgcn_exp2f(c.y); }
}
template <bool DOEXP = true> __device__ __forceinline__ void finishSM(f32x16& p0, f32x16& p1, float alpha, float& l_reg, bf16x8& pa0, bf16x8& pa1, bf16x8& pa2, bf16x8& pa3) {
  if constexpr (DOEXP) {
#pragma unroll
  for (int r = 0; r < 16; ++r) p1[r] = __builtin_amdgcn_exp2f(p1[r]); }
  f2_t ps2 = {0.f, 0.f};
#pragma unroll
  for (int r = 0; r < 16; r += 2) { ps2 = ps2 + (f2_t){p0[r], p0[r + 1]}; ps2 = ps2 + (f2_t){p1[r], p1[r + 1]}; }
  float ps = ps2.x + ps2.y;
  { auto rr = __builtin_amdgcn_permlane32_swap(__float_as_uint(ps), __float_as_uint(ps), false, false); ps = __uint_as_float(rr[0]) + __uint_as_float(rr[1]); }
  l_reg = l_reg * alpha + ps;
#define A2_PK4(P, BASE, OUT) do { unsigned a0 = cvtpk(P[BASE + 0], P[BASE + 1]), a1 = cvtpk(P[BASE + 2], P[BASE + 3]);   \
    unsigned b0 = cvtpk(P[BASE + 4], P[BASE + 5]), b1 = cvtpk(P[BASE + 6], P[BASE + 7]);                              \
    auto r0 = __builtin_amdgcn_permlane32_swap(a0, b0, false, false); auto r1 = __builtin_amdgcn_permlane32_swap(a1, b1, false, false); \
    u32x4 w = {r0[0], r1[0], r0[1], r1[1]}; OUT = *reinterpret_cast<bf16x8*>(&w); } while (0)
  A2_PK4(p0, 0, pa0); A2_PK4(p0, 8, pa1); A2_PK4(p1, 0, pa2); A2_PK4(p1, 8, pa3);
#undef A2_PK4
}
__device__ __forceinline__ void qkt(f32x16& p0, f32x16& p1, const char* Ks, const bf16x8* qr, int r32, int hi) {
  p0 = f32x16{}; p1 = f32x16{};
#pragma unroll
  for (int d0 = 0; d0 < 4; ++d0) { const int cb = (d0 * 16 + hi * 8) * 2;
    const bf16x8 b0 = *reinterpret_cast<const bf16x8*>(Ks + A2_KSWZ(r32, cb));
    const bf16x8 b1 = *reinterpret_cast<const bf16x8*>(Ks + A2_KSWZ(32 + r32, cb));
    p0 = __builtin_amdgcn_mfma_f32_32x32x16_bf16(b0, qr[d0], p0, 0, 0, 0);
    p1 = __builtin_amdgcn_mfma_f32_32x32x16_bf16(b1, qr[d0], p1, 0, 0, 0); }
}
__device__ __forceinline__ int v_st(int k, int c) { const int kk = (k & ~0xC) | ((k & 4) << 1) | ((k & 8) >> 1); return ((kk >> 3) * 4 + (c >> 5)) * 512 + ((kk & 7) * 32 + (c & 31)) * 2; }
__device__ __forceinline__ int v_rd_base(int lane) { return ((lane & 3) << 3) | (((lane >> 2) & 3) << 6) | (((lane >> 4) & 1) << 5) | (((lane >> 5) & 1) << 8); }
constexpr int v_rd_off(int d0, int ks, int half) { return d0 * 512 + ks * 4096 + half * 2048; }
template <int OFF> __device__ __forceinline__ s16x4 tr_read(int vb) { s16x4 r; asm volatile("ds_read_b64_tr_b16 %0, %1 offset:%2" : "=&v"(r) : "v"(vb), "i"(OFF) : "memory"); return r; }
template <int D0> __device__ __forceinline__ void pv_one(f32x16& od, int vb, bf16x8 pa0, bf16x8 pa1, bf16x8 pa2, bf16x8 pa3) {
  const s16x4 l0 = tr_read<v_rd_off(D0, 0, 0)>(vb), h0 = tr_read<v_rd_off(D0, 0, 1)>(vb), l1 = tr_read<v_rd_off(D0, 1, 0)>(vb), h1 = tr_read<v_rd_off(D0, 1, 1)>(vb);
  const s16x4 l2 = tr_read<v_rd_off(D0, 2, 0)>(vb), h2 = tr_read<v_rd_off(D0, 2, 1)>(vb), l3 = tr_read<v_rd_off(D0, 3, 0)>(vb), h3 = tr_read<v_rd_off(D0, 3, 1)>(vb);
  asm volatile("s_waitcnt lgkmcnt(0)" ::: "memory"); A2_SBAR();
#define A2_PK(L, H) (bf16x8){L[0], L[1], L[2], L[3], H[0], H[1], H[2], H[3]}
  od = __builtin_amdgcn_mfma_f32_32x32x16_bf16(pa0, A2_PK(l0, h0), od, 0, 0, 0);
  od = __builtin_amdgcn_mfma_f32_32x32x16_bf16(pa1, A2_PK(l1, h1), od, 0, 0, 0);
  od = __builtin_amdgcn_mfma_f32_32x32x16_bf16(pa2, A2_PK(l2, h2), od, 0, 0, 0);
  od = __builtin_amdgcn_mfma_f32_32x32x16_bf16(pa3, A2_PK(l3, h3), od, 0, 0, 0);
#undef A2_PK
}
__device__ __forceinline__ void pv_d0(f32x16* o, int vb, bf16x8 pa0, bf16x8 pa1, bf16x8 pa2, bf16x8 pa3) {
  pv_one<0>(o[0], vb, pa0, pa1, pa2, pa3); pv_one<1>(o[1], vb, pa0, pa1, pa2, pa3); pv_one<2>(o[2], vb, pa0, pa1, pa2, pa3); pv_one<3>(o[3], vb, pa0, pa1, pa2, pa3);
}
__device__ __forceinline__ void pv_d0_sm(f32x16* o, int vb, bf16x8 pa0, bf16x8 pa1, bf16x8 pa2, bf16x8 pa3, f32x16& p0, f32x16& p1, float mn) {
  pv_one<0>(o[0], vb, pa0, pa1, pa2, pa3); psm_slice<0>(p0, p1, mn); pv_one<1>(o[1], vb, pa0, pa1, pa2, pa3); psm_slice<1>(p0, p1, mn);
  pv_one<2>(o[2], vb, pa0, pa1, pa2, pa3); psm_slice<2>(p0, p1, mn); pv_one<3>(o[3], vb, pa0, pa1, pa2, pa3); psm_slice<3>(p0, p1, mn);
}
__device__ __forceinline__ void unit(const bf16* __restrict__ Qb, const bf16* __restrict__ Kh, const bf16* __restrict__ Vh, bf16* __restrict__ Ob, const int NT, const int mode, char* lds) {
  const int tid = threadIdx.x, wid = __builtin_amdgcn_readfirstlane(tid >> 6), lane = tid & 63, r32 = lane & 31, hi = lane >> 5;
  char* V_lds = lds; char* K_lds = lds + 3 * SHM_V;
  float* ws = (float*)(lds + 3 * SHM_V + 3 * SHM_K) + wid * 64; float* li_l = ws; float* al_l = ws + 32;
  float m_reg = NEGBIG, l_reg = 0; f32x16 o[4] = {}; bf16x8 qr[4];
  const bf16* Qw = Qb + (long)(wid * QBLK + r32) * LD + hi * 8;
#pragma unroll
  for (int d0 = 0; d0 < 4; ++d0) qr[d0] = *reinterpret_cast<const bf16x8*>(Qw + d0 * 16);
  const int sr = tid >> 4, sc = (tid & 15) * 8, vst0 = v_st(sr, sc);
  const int kr = tid >> 3, kc = (tid & 7) * 8, kst = A2_KSWZ(kr, kc * 2);
  const unsigned voffV = (unsigned)(sr * LD + sc) * 2u, voffK = (unsigned)(kr * LD + kc) * 2u;
  const int vb0 = (int)(uintptr_t)V_lds + v_rd_base(lane);
  struct { bf16x8 vs0, vs1, ks0; } sr_[2];
#define A2_SLOAD(i, k0) do { const char* vb_ = (const char*)Vh + (long)(k0) * (LD * 2); const char* kb_ = (const char*)Kh + (long)(k0) * (LD * 2);     \
    sr_[i].vs0 = *reinterpret_cast<const bf16x8*>(vb_ + voffV); sr_[i].vs1 = *reinterpret_cast<const bf16x8*>(vb_ + 32 * LD * 2 + voffV); sr_[i].ks0 = *reinterpret_cast<const bf16x8*>(kb_ + voffK); } while (0)
#define A2_SWRITE(b, i) do { *(bf16x8*)(V_lds + (b) * SHM_V + vst0) = sr_[i].vs0; *(bf16x8*)(V_lds + (b) * SHM_V + 8192 + vst0) = sr_[i].vs1; *(bf16x8*)(K_lds + (b) * SHM_K + kst) = sr_[i].ks0; } while (0)
#define A2_SWAIT() asm volatile("s_waitcnt vmcnt(3)" ::: "memory")
#define A2_RESC(a) do { if (__any((a) < 1.f)) { if (hi == 0) al_l[r32] = (a); asm volatile("s_waitcnt lgkmcnt(0)" ::: "memory"); \
    _Pragma("unroll") for (int d = 0; d < 4; ++d) _Pragma("unroll") for (int r = 0; r < 16; ++r) o[d][r] *= al_l[crow(r, hi)]; } } while (0)
  f32x16 pA0, pA1, pB0, pB1; float mnA, mnB, alA, alB; bf16x8 pa0, pa1, pa2, pa3;
  constexpr int SE = 0, SO = 1;
  A2_SLOAD(SE, 0); asm volatile("s_waitcnt vmcnt(0)" ::: "memory"); A2_SWRITE(0, SE); __syncthreads();
  qkt(pA0, pA1, K_lds, qr, r32, hi); amask(pA0, pA1, 0, NT, wid, mode); psm_head(pA0, pA1, m_reg, mnA, alA);
  psm_slice<0>(pA0, pA1, mnA); psm_slice<1>(pA0, pA1, mnA); psm_slice<2>(pA0, pA1, mnA); psm_slice<3>(pA0, pA1, mnA);
  A2_SLOAD(SO, KVBLK); if (2 < NT) A2_SLOAD(SE, 2 * KVBLK);
  A2_SWAIT(); A2_SWRITE(1, SO); __syncthreads();
  int sp = 0, sc_ = 1, sn = 2;
#define A2_ROT() do { const int t_ = sp; sp = sc_; sc_ = sn; sn = t_; } while (0)
  for (int j = 1; j + 1 < NT; j += 2) {
    A2_SBAR(); qkt(pB0, pB1, K_lds + sc_ * SHM_K, qr, r32, hi);
    finishSM<false>(pA0, pA1, alA, l_reg, pa0, pa1, pa2, pa3); A2_SBAR();
    if (j >= NT - 4) { asm volatile("" ::: "memory"); amask(pB0, pB1, j, NT, wid, mode); }
    psm_head(pB0, pB1, m_reg, mnB, alB);
    A2_SLOAD(SO, (j + 2) * KVBLK); A2_SBAR();
    pv_d0_sm(o, vb0 + sp * (int)SHM_V, pa0, pa1, pa2, pa3, pB0, pB1, mnB);
    A2_SWAIT(); A2_SWRITE(sn, SE);
    A2_RESC(alB); __syncthreads(); A2_ROT();
    A2_SBAR(); qkt(pA0, pA1, K_lds + sc_ * SHM_K, qr, r32, hi);
    finishSM<false>(pB0, pB1, alB, l_reg, pa0, pa1, pa2, pa3); A2_SBAR();
    if (j + 1 >= NT - 4) { asm volatile("" ::: "memory"); amask(pA0, pA1, j + 1, NT, wid, mode); }
    psm_head(pA0, pA1, m_reg, mnA, alA);
    if (j + 3 < NT) A2_SLOAD(SE, (j + 3) * KVBLK); A2_SBAR();
    pv_d0_sm(o, vb0 + sp * (int)SHM_V, pa0, pa1, pa2, pa3, pA0, pA1, mnA);
    A2_SWAIT(); A2_SWRITE(sn, SO);
    A2_RESC(alA); __syncthreads(); A2_ROT();
  }
  A2_SBAR(); qkt(pB0, pB1, K_lds + sc_ * SHM_K, qr, r32, hi); amask(pB0, pB1, NT - 1, NT, wid, mode);
  finishSM<false>(pA0, pA1, alA, l_reg, pa0, pa1, pa2, pa3); A2_SBAR();
  pv_d0(o, vb0 + sp * (int)SHM_V, pa0, pa1, pa2, pa3); partialSM(pB0, pB1, m_reg, mnB, alB);
  A2_RESC(alB);
  finishSM(pB0, pB1, alB, l_reg, pa0, pa1, pa2, pa3); A2_SBAR();
  pv_d0(o, vb0 + sc_ * (int)SHM_V, pa0, pa1, pa2, pa3);
#undef A2_ROT
  if (hi == 0) li_l[r32] = l_reg; asm volatile("s_waitcnt lgkmcnt(0)" ::: "memory");
  float rli[16];
#pragma unroll
  for (int r = 0; r < 16; ++r) rli[r] = __builtin_amdgcn_rcpf(li_l[crow(r, hi)]);
  unsigned short* Ow = (unsigned short*)Ob + (long)(wid * QBLK) * LD;
#pragma unroll
  for (int r = 0; r < 16; ++r) { const int orow = crow(r, hi);
#pragma unroll
    for (int d0 = 0; d0 < 4; ++d0) Ow[(long)orow * LD + d0 * 32 + r32] = (unsigned short)(cvtpk(o[d0][r] * rli[r], 0.f) & 0xffffu); }
  __syncthreads();
#undef A2_SLOAD
#undef A2_SWRITE
#undef A2_SWAIT
#undef A2_RESC
}
#undef A2_KSWZ
#undef A2_SBAR
}
#define GAS __attribute__((address_space(1)))
#define LAS __attribute__((address_space(3)))
typedef unsigned short bf16;
typedef unsigned v4u __attribute__((ext_vector_type(4)));
typedef float f32x4 __attribute__((ext_vector_type(4)));
typedef short bf16x8 __attribute__((ext_vector_type(8)));
typedef GAS unsigned gu32;
typedef GAS unsigned long long gu64;
#define RLX_AGENT __ATOMIC_RELAXED, __HIP_MEMORY_SCOPE_AGENT
#define LDS_WAIT() asm volatile("s_waitcnt lgkmcnt(0)" ::: "memory")
#define VM_WAIT() asm volatile("s_waitcnt vmcnt(0)" ::: "memory")
__device__ __forceinline__ unsigned long long rt() { return __builtin_amdgcn_s_memrealtime(); }
__device__ __forceinline__ unsigned f2bf(float f) { unsigned u = __builtin_bit_cast(unsigned, f); return (u + 0x7fffu + ((u >> 16) & 1u)) >> 16; }
__device__ __forceinline__ unsigned pk2(float lo, float hi) { return f2bf(lo) | (f2bf(hi) << 16); }

#define XB_TMO      128
#define XB_XCNT(j)  (256  + 64 * (j))
#define XB_XSUB(j)  (1280 + 64 * (j))
#define XB_XGEN(j)  (2304 + 64 * (j))
#define XB_TOP      3328
#define XB_TOPGEN   3392
#define XCD_BAR_WORDS 3456
#define XB_SPIN_CAP (1u << 18)

__device__ __forceinline__ unsigned xb_ld(unsigned* p)              { return __hip_atomic_load(p, __ATOMIC_RELAXED, __HIP_MEMORY_SCOPE_AGENT); }
__device__ __forceinline__ unsigned xb_add(unsigned* p, unsigned v) { return __hip_atomic_fetch_add(p, v, __ATOMIC_RELAXED, __HIP_MEMORY_SCOPE_AGENT); }
__device__ __forceinline__ unsigned xb_xcc_id() { return (unsigned)__builtin_amdgcn_s_getreg((3 << 11) | 20) & 0xFu; }
#define XB_SPIN(cond, bar) do { unsigned _sp = 0; while (cond) { __builtin_amdgcn_s_sleep(1); \
    if ((++_sp & 255u) == 0u) { if (xb_ld(&(bar)[XB_TMO])) break; if (_sp > XB_SPIN_CAP) { atomicAdd(&(bar)[XB_TMO], 1u); break; } } } } while (0)

struct XcdBarrier {
    unsigned* bar; unsigned x;
    volatile LAS unsigned* st;
};

__device__ __forceinline__ XcdBarrier xcd_barrier_post(unsigned* bar, volatile LAS unsigned* st) {
    XcdBarrier b; b.bar = bar; b.x = xb_xcc_id(); b.st = st;
    if (threadIdx.x == 0) (void)xb_add(&bar[XB_XCNT(b.x)], 1u);
    return b;
}
__device__ __forceinline__ void xcd_barrier_complete(unsigned* bar, unsigned x, unsigned& nloc, unsigned& nx) {
    const unsigned G = gridDim.x * gridDim.y * gridDim.z;
    unsigned sum, cnt, mine, sp = 0u;
    for (;;) {
        sum = 0u; cnt = 0u; mine = 0u;
#pragma unroll
        for (unsigned j = 0; j < 16; ++j) { const unsigned c = xb_ld(&bar[XB_XCNT(j)]); sum += c; cnt += (c > 0u) ? 1u : 0u; mine = (j == x) ? c : mine; }
        if (sum == G) break;
        __builtin_amdgcn_s_sleep(1);
        if ((++sp & 255u) == 0u) { if (xb_ld(&bar[XB_TMO])) break; if (sp > XB_SPIN_CAP) { atomicAdd(&bar[XB_TMO], 1u); break; } }
    }
    nloc = mine > 0u ? mine : 1u; nx = cnt > 0u ? cnt : 1u;
}

__device__ __forceinline__ void xcd_barrier(const XcdBarrier& b) {
    asm volatile("s_waitcnt vmcnt(0)" ::: "memory");
    __syncthreads();
    if (threadIdx.x == 0) {
        unsigned* bar = b.bar;
        __builtin_amdgcn_s_waitcnt(0);
        unsigned nloc = b.st[0], nx = b.st[1];
        if (nloc == 0u) { xcd_barrier_complete(bar, b.x, nloc, nx); b.st[0] = nloc; b.st[1] = nx; }
        const unsigned old = xb_add(&bar[XB_XSUB(b.x)], 1u);
        const unsigned gen = old / nloc;
        if (old + 1u == (gen + 1u) * nloc) {
            __builtin_amdgcn_fence(__ATOMIC_RELEASE, "agent");
            asm volatile("s_waitcnt vmcnt(0)" ::: "memory");
            const unsigned og = xb_add(&bar[XB_TOP], 1u);
            const unsigned tg = og / nx;
            if (og + 1u == (tg + 1u) * nx) xb_add(&bar[XB_TOPGEN], 1u);
            else XB_SPIN(xb_ld(&bar[XB_TOPGEN]) == tg, bar);
            __builtin_amdgcn_fence(__ATOMIC_ACQUIRE, "agent");
            xb_add(&bar[XB_XGEN(b.x)], 1u);
            asm volatile("s_waitcnt vmcnt(0)" ::: "memory");
        } else {
            XB_SPIN(xb_ld(&bar[XB_XGEN(b.x)]) == gen, bar);
            __builtin_amdgcn_fence(__ATOMIC_ACQUIRE, "agent");
            asm volatile("s_waitcnt vmcnt(0)" ::: "memory");
        }
    }
    __syncthreads();
}

constexpr int NWAVES = 8;
using pg8::MP; using pg8::MS; using pg8::MV; using pg8::MPAD; using pg8::RWIN; using pg8::DFW; using pg8::FF; using pg8::FF2; using pg8::DM; using pg8::INDIM;
using pg8::O_YP; using pg8::O_YS; using pg8::O_KP; using pg8::O_VP; using pg8::O_SHP; using pg8::O_WKVP; using pg8::O_FCP; using pg8::O_KS; using pg8::O_VS; using pg8::O_SHS; using pg8::O_WKVS; using pg8::O_FCS;
typedef unsigned u32x2 __attribute__((ext_vector_type(2)));
typedef float f32x2 __attribute__((ext_vector_type(2)));

constexpr size_t MiB = 1u << 20;
constexpr size_t WS_CTL = 0, CTL_ZERO_BYTES = 32768;
constexpr size_t WS_WIN = 2 * MiB, WS_WOUT = 9 * MiB, WS_WUP = 11 * MiB, WS_WDN = 22 * MiB;
constexpr size_t WS_WWT = 28 * MiB, WS_WAT = WS_WWT + 65536, WS_WGT = WS_WAT + 65536;
constexpr size_t WS_ROPE = 28 * MiB + 512 * 1024;
constexpr size_t WS_XN = 30 * MiB;
constexpr size_t WS_PRW = 95 * MiB;
constexpr size_t WS_QB = 208 * MiB, WS_KB = 240 * MiB, WS_VB = 272 * MiB;
constexpr size_t WS_QS = 304 * MiB, WS_KS = 306 * MiB, WS_VS = 339 * MiB;
constexpr size_t WS_MT2 = 372 * MiB;
constexpr size_t WS_END = 512 * MiB;
constexpr int CW_TMO = 0, CW_CODE = 1, CW_BAR = 4096;

constexpr int RING_OFF = 0, RING_BYTES = 131072;
constexpr int LDSCTL_OFF = 159744, MISC_OFF = LDSCTL_OFF + 320;
constexpr int LDS_BYTES = 163840;

struct Frame {
    LAS unsigned char* lds;
    volatile LAS unsigned* MISC;
    gu32* ctl;
    int tid, lane, wave;
    int vcu, G;
    __device__ __forceinline__ const float* inp(int i) const { return ((const float* const __attribute__((address_space(4)))*)__builtin_amdgcn_kernarg_segment_ptr())[i]; }
    float* out;
    unsigned char* ws;
};
enum { I_XP = 0, I_XS, I_CK, I_CV, I_SSH, I_SWKV, I_SFC, I_N1G, I_WIN, I_MU, I_W0, I_WW2, I_A0, I_AW2, I_GW2, I_KK, I_KA, I_RK, I_GNG, I_GNB,
       I_QG, I_KG, I_LQ1, I_LK1, I_LQ2, I_LK2, I_SUBG, I_WOUT, I_N2G, I_WUP, I_CW, I_CB, I_WDN };

__device__ __forceinline__ float wave_sum(float v) {
#pragma unroll
    for (int o = 1; o < 64; o <<= 1) v += __shfl_xor(v, o);
    return v;
}

__device__ __forceinline__ void p0_transpose_item(const float* W, int K, int N, bf16* WT, int k0, int n0_src, int n0_dst, const float* gain, LAS float* scr, int lane) {
#pragma unroll 8
    for (int i = 0; i < 32; ++i) { const int kk = 2 * i + (lane >> 5); float w = W[(size_t)(k0 + kk) * N + n0_src + (lane & 31)]; if (gain) w *= gain[k0 + kk]; scr[kk * 33 + (lane & 31)] = w; }
    LDS_WAIT(); asm volatile("" ::: "memory");
    const int c = lane & 7;
#pragma unroll
    for (int j = 0; j < 4; ++j) { const int n = (lane >> 3) + 8 * j; const LAS float* s = scr + (8 * c) * 33 + n;
        v4u o; o.x = pk2(s[0 * 33], s[1 * 33]); o.y = pk2(s[2 * 33], s[3 * 33]); o.z = pk2(s[4 * 33], s[5 * 33]); o.w = pk2(s[6 * 33], s[7 * 33]);
        *(GAS v4u*)(WT + (size_t)(n0_dst + n) * K + k0 + 8 * c) = o; }
    LDS_WAIT(); asm volatile("" ::: "memory");
}
__device__ __forceinline__ void rms_row_to_bf16(int lane, const float* xrow, bf16* orow) {
    const GAS f32x4* xr = (const GAS f32x4*)xrow + lane;
    f32x4 v[4]; float s = 0.f;
#pragma unroll
    for (int j = 0; j < 4; ++j) { v[j] = xr[64 * j]; s += (v[j].x * v[j].x + v[j].y * v[j].y) + (v[j].z * v[j].z + v[j].w * v[j].w); }
    const float rstd = 1.f / sqrtf(wave_sum(s) * (1.f / 1024.f) + 1e-6f);
    GAS unsigned long long* o8 = (GAS unsigned long long*)orow + lane;
#pragma unroll
    for (int j = 0; j < 4; ++j) o8[64 * j] = (unsigned long long)pk2(v[j].x * rstd, v[j].y * rstd) | ((unsigned long long)pk2(v[j].z * rstd, v[j].w * rstd) << 32);
}
__device__ __forceinline__ void rms_row2_to_bf16(int lane, const float* x0, bf16* o0, const float* x1, bf16* o1) {
    const GAS f32x4* xa = (const GAS f32x4*)x0 + lane; const GAS f32x4* xb = (const GAS f32x4*)x1 + lane;
    f32x4 va[4], vb[4]; float sa = 0.f, sb = 0.f;
#pragma unroll
    for (int j = 0; j < 4; ++j) { va[j] = xa[64 * j]; vb[j] = xb[64 * j]; }
#pragma unroll
    for (int j = 0; j < 4; ++j) { sa += (va[j].x * va[j].x + va[j].y * va[j].y) + (va[j].z * va[j].z + va[j].w * va[j].w); sb += (vb[j].x * vb[j].x + vb[j].y * vb[j].y) + (vb[j].z * vb[j].z + vb[j].w * vb[j].w); }
    const float ra = 1.f / sqrtf(wave_sum(sa) * (1.f / 1024.f) + 1e-6f), rb = 1.f / sqrtf(wave_sum(sb) * (1.f / 1024.f) + 1e-6f);
    GAS unsigned long long* pa = (GAS unsigned long long*)o0 + lane; GAS unsigned long long* pb = (GAS unsigned long long*)o1 + lane;
#pragma unroll
    for (int j = 0; j < 4; ++j) { pa[64 * j] = (unsigned long long)pk2(va[j].x * ra, va[j].y * ra) | ((unsigned long long)pk2(va[j].z * ra, va[j].w * ra) << 32);
        pb[64 * j] = (unsigned long long)pk2(vb[j].x * rb, vb[j].y * rb) | ((unsigned long long)pk2(vb[j].z * rb, vb[j].w * rb) << 32); }
}
__device__ __forceinline__ void sincos_d(double a, float& sn, float& cs) {
    const double k = __builtin_rint(a * 0.3183098861837907);
    const double r = __builtin_fma(-k, 3.141592653589793, a) - k * 1.2246467991473532e-16;
    const double r2 = r * r;
    double s = -1.0 / 121645100408832000.0;
    s = s * r2 + 1.0 / 355687428096000.0;
    s = s * r2 - 1.0 / 1307674368000.0;
    s = s * r2 + 1.0 / 6227020800.0;
    s = s * r2 - 1.0 / 39916800.0;
    s = s * r2 + 1.0 / 362880.0;
    s = s * r2 - 1.0 / 5040.0;
    s = s * r2 + 1.0 / 120.0;
    s = s * r2 - 1.0 / 6.0;
    s = s * r2 + 1.0; s = s * r;
    double c = -1.0 / 6402373705728000.0;
    c = c * r2 + 1.0 / 20922789888000.0;
    c = c * r2 - 1.0 / 87178291200.0;
    c = c * r2 + 1.0 / 479001600.0;
    c = c * r2 - 1.0 / 3628800.0;
    c = c * r2 + 1.0 / 40320.0;
    c = c * r2 - 1.0 / 720.0;
    c = c * r2 + 1.0 / 24.0;
    c = c * r2 - 0.5;
    c = c * r2 + 1.0;
    const bool odd = (((long long)k) & 1) != 0;
    sn = (float)(odd ? -s : s); cs = (float)(odd ? -c : c);
}
__device__ __forceinline__ void p0_urgent(Frame& F) {
    LAS float* scr = (LAS float*)(F.lds + RING_OFF + F.wave * 16384);
    const int gw = F.vcu * NWAVES + F.wave, NGW = F.G * NWAVES;
    bf16* Win_t = (bf16*)(F.ws + WS_WIN);
    constexpr int I_IN = 16 * 104;
    for (int r = gw; r < I_IN; r += NGW) { const int kb = r / 104, nb = r % 104, pn = nb >> 3, pb = nb & 7; const int sb = (pn < 7) ? nb : 8 * pn + 2 * (pb & 3) + (pb >> 2);
        p0_transpose_item(F.inp(I_WIN), 1024, INDIM, Win_t, 64 * kb, 32 * sb, 32 * nb, F.inp(I_N1G), scr, F.lane); }
    bf16* XN = (bf16*)(F.ws + WS_XN);
    {   const float* xp = F.inp(I_XP); const float* xs = F.inp(I_XS);
        int m = gw;
        for (; m + NGW < MP; m += 2 * NGW) rms_row2_to_bf16(F.lane, xp + (size_t)m * DM, XN + (size_t)m * DM, xp + (size_t)(m + NGW) * DM, XN + (size_t)(m + NGW) * DM);
        for (; m < MPAD; m += NGW) {
            if (m < MP) rms_row_to_bf16(F.lane, xp + (size_t)m * DM, XN + (size_t)m * DM);
            else if (m < MV) rms_row_to_bf16(F.lane, xs + (size_t)(m - MP) * DM, XN + (size_t)m * DM);
            else { GAS v4u* o = (GAS v4u*)(XN + (size_t)m * DM) + F.lane; o[0] = (v4u){0u, 0u, 0u, 0u}; o[64] = (v4u){0u, 0u, 0u, 0u}; }
        }
    }
    const int gt = (F.vcu * NWAVES + F.wave) * 64 + F.lane, NGT = NGW * 64;
    {
        bf16* Ks = (bf16*)(F.ws + WS_KS); bf16* Vs = (bf16*)(F.ws + WS_VS);
        constexpr int NZ = 8 * 112 * 64;
        for (int it = gt; it < 2 * NZ; it += NGT) { const int w = it >= NZ, i = w ? it - NZ : it; const int rowi = i >> 6, ch = i & 63, b = rowi / 112, p = 4112 + rowi % 112;
            *(GAS v4u*)((w ? Vs : Ks) + ((size_t)b * 4224 + p) * 512 + ch * 8) = (v4u){0u, 0u, 0u, 0u}; }
        bf16* Qs = (bf16*)(F.ws + WS_QS);
        constexpr int NQ = 8 * 240 * 64;
        for (int it = gt; it < NQ; it += NGT) { const int rowi = it >> 6, ch = it & 63, b = rowi / 240, p = 16 + rowi % 240;
            *(GAS v4u*)(Qs + ((size_t)b * 256 + p) * 512 + ch * 8) = (v4u){0u, 0u, 0u, 0u}; }
    }
    {   bf16* WwT = (bf16*)(F.ws + WS_WWT); bf16* WaT = (bf16*)(F.ws + WS_WAT); bf16* WgT = (bf16*)(F.ws + WS_WGT);
        for (int it = gt; it < 512 * 64; it += NGT) { const int ch = it >> 6, m = it & 63; WwT[it] = (bf16)f2bf(F.inp(I_WW2)[(size_t)m * 512 + ch]); WaT[it] = (bf16)f2bf(F.inp(I_AW2)[(size_t)m * 512 + ch]); }
        for (int it = gt; it < 512 * 128; it += NGT) { const int ch = it >> 7, m = it & 127; WgT[it] = (bf16)f2bf(F.inp(I_GW2)[(size_t)m * 512 + ch]); }
    }
    {   float* cs = (float*)(F.ws + WS_ROPE);
        for (int it = gt; it < 8192 * 8; it += NGT) { const int pos = it >> 3, i = it & 7;
            const double inv = i == 0 ? 1.0 : i == 1 ? 0.19392274474868576 : i == 2 ? 0.03760603093086393 : i == 3 ? 0.007292664737217109 : i == 4 ? 0.001414213562373095 : i == 5 ? 0.0002742481756762073 : i == 6 ? 5.318295896944988e-05 : 1.031338537721246e-05;
            float sn, c; sincos_d((double)pos * inv, sn, c); cs[pos * 16 + i] = c; cs[pos * 16 + 8 + i] = sn; }
    }
}
constexpr int CACHE_ITEMS = 2 * 8 * 4096 * 64, CACHE_SPLIT = (CACHE_ITEMS / 100) * 55;
__device__ __forceinline__ void cache_convert(Frame& F, int part, int nparts, int lo, int hi) {
    const int gt = (part * NWAVES + F.wave) * 64 + F.lane, NGT = nparts * NWAVES * 64;
    bf16* Ks = (bf16*)(F.ws + WS_KS); bf16* Vs = (bf16*)(F.ws + WS_VS);
    constexpr int NIT = 8 * 4096 * 64;
    const float* ck = F.inp(I_CK); const float* cv = F.inp(I_CV);
    for (int it0 = lo + gt; it0 < hi; it0 += 4 * NGT) {
        f32x4 a[4], c[4];
#pragma unroll
        for (int q = 0; q < 4; ++q) { const int it = it0 + q * NGT; if (it < hi) { const int w = it >= NIT, i = w ? it - NIT : it; const GAS f32x4* src = (const GAS f32x4*)((w ? cv : ck) + (size_t)i * 8); a[q] = src[0]; c[q] = src[1]; } }
#pragma unroll
        for (int q = 0; q < 4; ++q) { const int it = it0 + q * NGT; if (it < hi) { const int w = it >= NIT, i = w ? it - NIT : it; const int rowi = i >> 6, ch = i & 63, b = rowi >> 12, p = rowi & 4095;
            v4u o; o.x = pk2(a[q].x, a[q].y); o.y = pk2(a[q].z, a[q].w); o.z = pk2(c[q].x, c[q].y); o.w = pk2(c[q].z, c[q].w);
            *(GAS v4u*)((w ? Vs : Ks) + ((size_t)b * 4224 + p) * 512 + ch * 8) = o; } }
    }
}
__device__ __forceinline__ void p0_deferred(Frame& F, int part, int nparts) {
    LAS float* scr = (LAS float*)(F.lds + RING_OFF + F.wave * 16384);
    const int gw = part * NWAVES + F.wave, NGW = nparts * NWAVES;
    bf16* Wout_t = (bf16*)(F.ws + WS_WOUT); bf16* Wup_t = (bf16*)(F.ws + WS_WUP); bf16* Wdn_t = (bf16*)(F.ws + WS_WDN);
    constexpr int I_OUT = 16 * 32, I_UP = 16 * 176, I_DN = 44 * 32, NITEMS = I_OUT + I_UP + I_DN;
    for (int it = gw; it < NITEMS; it += NGW) {
        int r = it;
        if (r < I_OUT) { const int kb = r / 32, nb = r % 32; p0_transpose_item(F.inp(I_WOUT), 1024, 1024, Wout_t, 64 * kb, 32 * nb, 32 * nb, nullptr, scr, F.lane); continue; } r -= I_OUT;
        if (r < I_UP) { const int kb = r / 176, nb = r % 176, pn = nb >> 3, pb = nb & 7; const int sb = (pb >> 2) * 88 + 4 * pn + (pb & 3);
            p0_transpose_item(F.inp(I_WUP), 1024, FF2, Wup_t, 64 * kb, 32 * sb, 32 * nb, F.inp(I_N2G), scr, F.lane); continue; } r -= I_UP;
        { const int kb = r / 32, nb = r % 32; p0_transpose_item(F.inp(I_WDN), FF, 1024, Wdn_t, 64 * kb, 32 * nb, 32 * nb, nullptr, scr, F.lane); }
    }
}

namespace rw {
constexpr int NUNIT = 4096 + 64;
constexpr int TP = 80, TB = 64 * TP * 2;
constexpr int GP = 144;
constexpr int MT_BYTES = TB, MD_BYTES = MT_BYTES + 17408;
constexpr size_t WS_QT = 372 * MiB, WS_YL = 413 * MiB, WS_S0 = 446 * MiB;
constexpr size_t WS_G = WS_XN, WS_E1 = WS_XN + (size_t)MPAD * 512 * 2;
constexpr int MISC = 14 * TB;
static_assert(MISC + 2304 <= LDSCTL_OFF, "rwkv LDS map");
constexpr int PT_OFF = MISC + 2304, PT_W0 = 1536, PT_A0 = 2048, PT_KK = 2560, PTK_OFF = LDS_BYTES - 2048;
static_assert(PT_OFF + 3072 * 4 <= LDSCTL_OFF && PTK_OFF >= MISC_OFF + 256, "rwkv parameter table");
static_assert(WS_S0 + (size_t)NUNIT * TB <= WS_END && WS_QT + (size_t)NUNIT * TB <= WS_YL && WS_YL + (size_t)NUNIT * 8192 <= WS_S0, "rwkv ws map");
static_assert((size_t)NUNIT * MD_BYTES <= (size_t)33554432 * 4, "MD records fit the y_prompt region of d_out");

constexpr size_t WS_A2 = 488 * MiB;
static_assert(WS_A2 + (size_t)MPAD * 256 * 2 <= WS_END, "A2 fits");
typedef unsigned short ub16;
#define RW_TILE(i) ((LAS ub16*)(lds + (i) * rw::TB))
__device__ __forceinline__ float sigmoidf_(float x) { return __builtin_amdgcn_rcpf(1.0f + __expf(-x)); }
typedef float f32x2_t __attribute__((ext_vector_type(2))); typedef __bf16 bf16x2_t __attribute__((ext_vector_type(2)));
__device__ __forceinline__ unsigned cvtpk(float lo, float hi) { f32x2_t v = {lo, hi}; bf16x2_t b = __builtin_convertvector(v, bf16x2_t); return __builtin_bit_cast(unsigned, b); }
__device__ __forceinline__ float bflo(unsigned w) { return __uint_as_float(w << 16); }
__device__ __forceinline__ float bfhi(unsigned w) { return __uint_as_float(w & 0xffff0000u); }
__device__ __forceinline__ f32x4 unpack4(u32x2 w) { return (f32x4){bflo(w.x), bfhi(w.x), bflo(w.y), bfhi(w.y)}; }
__device__ __forceinline__ u32x2 pack4(f32x4 v) { u32x2 w; w.x = cvtpk(v[0], v[1]); w.y = cvtpk(v[2], v[3]); return w; }

template <int KS>
__device__ __forceinline__ void mm(f32x4 (&acc)[2], const LAS ub16* A, int lda, const LAS ub16* Bt, int ldb, int mt, int nh, int fr, int fq) {
#pragma unroll
    for (int ks = 0; ks < KS; ++ks) {
        const bf16x8 af = *(const LAS bf16x8*)(A + (16 * mt + fr) * lda + 32 * ks + 8 * fq);
#pragma unroll
        for (int nt = 0; nt < 2; ++nt) {
            const bf16x8 bfr = *(const LAS bf16x8*)(Bt + (32 * nh + 16 * nt + fr) * ldb + 32 * ks + 8 * fq);
            acc[nt] = __builtin_amdgcn_mfma_f32_16x16x32_bf16(bfr, af, acc[nt], 0, 0, 0);
        }
    }
}
struct FrA { bf16x8 k[2]; };
struct FrB { bf16x8 k[2][2]; };
__device__ __forceinline__ void ldA(FrA& f, const LAS ub16* A, int mt, int fr, int fq) {
#pragma unroll
    for (int ks = 0; ks < 2; ++ks) f.k[ks] = *(const LAS bf16x8*)(A + (16 * mt + fr) * TP + 32 * ks + 8 * fq);
}
__device__ __forceinline__ void ldB(FrB& f, const LAS ub16* Bt, int nh, int fr, int fq) {
#pragma unroll
    for (int ks = 0; ks < 2; ++ks)
#pragma unroll
        for (int nt = 0; nt < 2; ++nt) f.k[ks][nt] = *(const LAS bf16x8*)(Bt + (32 * nh + 16 * nt + fr) * TP + 32 * ks + 8 * fq);
}
__device__ __forceinline__ void mmf(f32x4 (&acc)[2], const FrA& a, const FrB& b) {
#pragma unroll
    for (int ks = 0; ks < 2; ++ks)
#pragma unroll
        for (int nt = 0; nt < 2; ++nt) acc[nt] = __builtin_amdgcn_mfma_f32_16x16x32_bf16(b.k[ks][nt], a.k[ks], acc[nt], 0, 0, 0);
}
#define RW_FENCE() __builtin_amdgcn_sched_barrier(0)
#define RW_ZERO(acc) do { acc[0] = (f32x4){0.f, 0.f, 0.f, 0.f}; acc[1] = (f32x4){0.f, 0.f, 0.f, 0.f}; } while (0)
#define RW_BAR() do { asm volatile("s_waitcnt lgkmcnt(0)" ::: "memory"); __builtin_amdgcn_s_barrier(); asm volatile("" ::: "memory"); } while (0)
#ifdef DBG_R1CHK
#define RW_CHK(acc, bit) do { bool ok_ = true; _Pragma("unroll") for (int q_ = 0; q_ < 2; ++q_) _Pragma("unroll") for (int e_ = 0; e_ < 4; ++e_) ok_ = ok_ && (fabsf(acc[q_][e_]) < 1e30f); if (!ok_) atomicOr((unsigned*)(F.ctl + 9), (unsigned)(bit)); } while (0)
#else
#define RW_CHK(acc, bit) do {} while (0)
#endif
template <int CTRL> __device__ __forceinline__ float dpp_shr0(float x) { return __builtin_bit_cast(float, __builtin_amdgcn_update_dpp(0, __builtin_bit_cast(int, x), CTRL, 0xf, 0xf, true)); }
__device__ __forceinline__ u32x2 quad_tr(u32x2 w, int fr) {
    const unsigned sel = (fr & 1) ? 0x03020706u : 0x05040100u;
    const unsigned a = (unsigned)__builtin_amdgcn_update_dpp(0, (int)w.x, 0xB1, 0xf, 0xf, false);
    const unsigned b = (unsigned)__builtin_amdgcn_update_dpp(0, (int)w.y, 0xB1, 0xf, 0xf, false);
    const unsigned u0 = __builtin_amdgcn_perm(a, w.x, sel), u1 = __builtin_amdgcn_perm(b, w.y, sel);
    const unsigned t0 = (unsigned)__builtin_amdgcn_update_dpp(0, (int)u0, 0x4E, 0xf, 0xf, false);
    const unsigned t1 = (unsigned)__builtin_amdgcn_update_dpp(0, (int)u1, 0x4E, 0xf, 0xf, false);
    u32x2 y; y.x = (fr & 2) ? t1 : u0; y.y = (fr & 2) ? u1 : t0; return y;
}
__device__ __forceinline__ void st_tile(LAS ub16* T, const f32x4 (&acc)[2], int m, int n0) {
#pragma unroll
    for (int nt = 0; nt < 2; ++nt) *(LAS u32x2*)(T + m * TP + n0 + 16 * nt) = pack4(acc[nt]);
}

__device__ __forceinline__ void st_tile_T(LAS ub16* T, const f32x4 (&acc)[2], int m, int n0, int fr) {
#pragma unroll
    for (int nt = 0; nt < 2; ++nt) { const u32x2 w = quad_tr(pack4(acc[nt]), fr); *(LAS u32x2*)(T + (n0 + 16 * nt + (fr & 3)) * TP + (m & ~3)) = w; }
}

__device__ __forceinline__ void a2_pass(Frame& F) {
    const int gt = (F.vcu * NWAVES + F.wave) * 64 + F.lane, NGT = F.G * NWAVES * 64;
    const ub16* Prw = (const ub16*)(F.ws + WS_PRW); ub16* A2 = (ub16*)(F.ws + WS_A2);
    const float* mu = F.inp(I_MU) + 1536; const float* ssh = F.inp(I_SSH);
    for (int it = gt; it < MV * 32; it += NGT) {
        const int r = it >> 5, cgp = it & 31, col = 8 * cgp;
        const bool samp = r >= MP; const int t = samp ? ((r - MP) & 15) : (r & 8191);
        const v4u cw = *(const GAS v4u*)(Prw + (size_t)r * RWIN + 1536 + col);
        float cur[8] = {bflo(cw.x), bfhi(cw.x), bflo(cw.y), bfhi(cw.y), bflo(cw.z), bfhi(cw.z), bflo(cw.w), bfhi(cw.w)};
        float prv[8];
        if (t > 0) { const v4u pw = *(const GAS v4u*)(Prw + (size_t)(r - 1) * RWIN + 1536 + col); prv[0] = bflo(pw.x); prv[1] = bfhi(pw.x); prv[2] = bflo(pw.y); prv[3] = bfhi(pw.y); prv[4] = bflo(pw.z); prv[5] = bfhi(pw.z); prv[6] = bflo(pw.w); prv[7] = bfhi(pw.w); }
        else if (samp) { const float* sp = ssh + (size_t)((r - MP) >> 4) * RWIN + 1536 + col;
#pragma unroll
            for (int e = 0; e < 8; ++e) prv[e] = sp[e]; }
        else {
#pragma unroll
            for (int e = 0; e < 8; ++e) prv[e] = 0.f; }
        const f32x4 m0 = *(const GAS f32x4*)(mu + col), m1 = *(const GAS f32x4*)(mu + col + 4);
        float z[8];
#pragma unroll
        for (int e = 0; e < 8; ++e) { const float m_ = e < 4 ? m0[e] : m1[e - 4]; z[e] = cur[e] + (prv[e] - cur[e]) * m_;
            if (col < 64) { const float ex = __expf(2.0f * z[e]); z[e] = 1.0f - 2.0f / (ex + 1.0f); }
            else if (col >= 128) z[e] = sigmoidf_(z[e]); }
        v4u o; o.x = cvtpk(z[0], z[1]); o.y = cvtpk(z[2], z[3]); o.z = cvtpk(z[4], z[5]); o.w = cvtpk(z[6], z[7]);
        *(GAS v4u*)(A2 + (size_t)r * 256 + col) = o;
    }
}

__device__ __forceinline__ void r1_param_table(Frame& F) {
    LAS float* pt = (LAS float*)(F.lds + PT_OFF); LAS float* pk = (LAS float*)(F.lds + PTK_OFF);
    const int tid = F.tid;
    const float* mu = F.inp(I_MU);
    pt[tid] = mu[tid]; pt[512 + tid] = mu[512 + tid]; pt[1024 + tid] = mu[1024 + tid];
    pt[PT_W0 + tid] = F.inp(I_W0)[tid]; pt[PT_A0 + tid] = F.inp(I_A0)[tid]; pt[PT_KK + tid] = F.inp(I_KK)[tid]; pk[tid] = F.inp(I_KA)[tid];
    __syncthreads();
}
__device__ __forceinline__ void lora_inputs(Frame& F, bool samp, int sb, int c, int row0, v4u (&xq)[4]) {
    const int tid = F.tid, tl = tid >> 3, cg = tid & 7; const bool hp = samp ? (tl > 0) : (c > 0 || tl > 0);
    const ub16* pr = (const ub16*)(F.ws + WS_PRW) + (size_t)(row0 + tl) * RWIN + 1536 + 32 * cg;
    const float* mu = F.inp(I_MU) + 1536 + 32 * cg;
#pragma unroll
    for (int q = 0; q < 4; ++q) {
        const v4u cw = *(const GAS v4u*)(pr + 8 * q);
        float cur[8] = {bflo(cw.x), bfhi(cw.x), bflo(cw.y), bfhi(cw.y), bflo(cw.z), bfhi(cw.z), bflo(cw.w), bfhi(cw.w)};
        float prv[8];
        if (hp) { const v4u pw = *(const GAS v4u*)(pr - RWIN + 8 * q); prv[0] = bflo(pw.x); prv[1] = bfhi(pw.x); prv[2] = bflo(pw.y); prv[3] = bfhi(pw.y); prv[4] = bflo(pw.z); prv[5] = bfhi(pw.z); prv[6] = bflo(pw.w); prv[7] = bfhi(pw.w); }
        else if (samp) { const float* sp = F.inp(I_SSH) + (size_t)sb * RWIN + 1536 + 32 * cg + 8 * q;
#pragma unroll
            for (int e = 0; e < 8; ++e) prv[e] = sp[e]; }
        else {
#pragma unroll
            for (int e = 0; e < 8; ++e) prv[e] = 0.f; }
        const f32x4 m0 = *(const GAS f32x4*)(mu + 8 * q), m1 = *(const GAS f32x4*)(mu + 8 * q + 4);
        float z[8];
#pragma unroll
        for (int e = 0; e < 8; ++e) { const float m_ = e < 4 ? m0[e] : m1[e - 4]; z[e] = cur[e] + (prv[e] - cur[e]) * m_;
            const float sg = __builtin_amdgcn_rcpf(1.0f + __expf(cg < 2 ? -2.0f * z[e] : -z[e]));
            z[e] = (cg < 2) ? 2.0f * sg - 1.0f : ((cg >= 4) ? sg : z[e]); }
        v4u o; o.x = cvtpk(z[0], z[1]); o.y = cvtpk(z[2], z[3]); o.z = cvtpk(z[4], z[5]); o.w = cvtpk(z[6], z[7]);
        xq[q] = o;
    }
}

struct R1Raw { u32x2 cur[2][3], prv[2][3]; v4u wts[4]; };
__device__ __forceinline__ void r1_decode(int u, bool& samp, int& sb, int& h, int& c, int& row0) {
    samp = u >= 4096; const int us = u - 4096;
    sb = samp ? (us >> 3) : (u >> 10); h = samp ? (us & 7) : ((u >> 7) & 7); c = samp ? 0 : (u & 127);
    row0 = samp ? (MP + 16 * sb) : (sb * 8192 + 64 * c);
}
__device__ __forceinline__ void r1_load(Frame& F, int u, R1Raw& R) {
    const int tid = F.tid, w = F.wave, lane = F.lane, mt = w >> 1, nh = w & 1, fr = lane & 15, fq = lane >> 4;
    bool samp; int sb, h, c, row0; r1_decode(u, samp, sb, h, c, row0);
    const ub16* Prw = (const ub16*)(F.ws + WS_PRW);
    const int t = 16 * mt + fr, n0 = 32 * nh + 4 * fq;
    const bool hasprev = samp ? (t > 0) : (c > 0 || t > 0);
    const ub16* pr = Prw + (size_t)(row0 + t) * RWIN + h * 64 + n0;
    const ub16* pp = hasprev ? pr - RWIN : pr;
#pragma unroll
    for (int nt = 0; nt < 2; ++nt)
#pragma unroll
        for (int x = 0; x < 3; ++x) { R.cur[nt][x] = *(const GAS u32x2*)(pr + x * 512 + 16 * nt); R.prv[nt][x] = *(const GAS u32x2*)(pp + x * 512 + 16 * nt); }
    const int wrow = tid >> 3, wch = tid & 7;
    R.wts[0] = *(const GAS v4u*)((const ub16*)(F.ws + WS_WWT) + (size_t)(h * 64 + wrow) * 64 + 8 * wch);
    R.wts[1] = *(const GAS v4u*)((const ub16*)(F.ws + WS_WAT) + (size_t)(h * 64 + wrow) * 64 + 8 * wch);
    R.wts[2] = *(const GAS v4u*)((const ub16*)(F.ws + WS_WGT) + (size_t)(h * 64 + wrow) * 128 + 8 * wch);
    R.wts[3] = *(const GAS v4u*)((const ub16*)(F.ws + WS_WGT) + (size_t)(h * 64 + wrow) * 128 + 64 + 8 * wch);
}
__device__ __forceinline__ void r1_unit(Frame& F, int u, R1Raw& R, int unext, const v4u (&xq)[4], const int cut = 99, const int cit = 0) {
    LAS unsigned char* lds = F.lds;
    int lane = F.lane; asm volatile("" : "+v"(lane));
    const int w = F.wave, tid = w * 64 + lane, mt = w >> 1, nh = w & 1, fr = lane & 15, fq = lane >> 4;
    bool samp; int sb, h, c, row0; r1_decode(u, samp, sb, h, c, row0);
    const int t = 16 * mt + fr, n0 = 32 * nh + 4 * fq;
    const bool valid = !samp || t < 16;
    const bool hasprev = samp ? (t > 0) : (c > 0 || t > 0);
    f32x4 r_[2], k_[2], v_[2];
#pragma unroll
    for (int nt = 0; nt < 2; ++nt)
#pragma unroll
        for (int x = 0; x < 3; ++x) {
            const int col = x * 512 + h * 64 + n0 + 16 * nt;
            const f32x4 cur = unpack4(R.cur[nt][x]);
            f32x4 prv = unpack4(R.prv[nt][x]);
            if (samp || c == 0) { if (!hasprev) prv = (f32x4){0.f, 0.f, 0.f, 0.f}; }
            if (samp && t == 0) prv = *(const GAS f32x4*)(F.inp(I_SSH) + (size_t)sb * RWIN + col);
            const f32x4 mu = *(const LAS f32x4*)((LAS float*)(lds + PT_OFF) + col);
            const f32x4 z = cur + (prv - cur) * mu;
            if (x == 0) r_[nt] = z; else if (x == 1) k_[nt] = z; else v_[nt] = z;
        }
    {   const int tl = tid >> 3, cg = tid & 7;
        LAS ub16* dst = (cg < 2) ? RW_TILE(0) + tl * TP + 32 * cg : (cg < 4) ? RW_TILE(1) + tl * TP + 32 * (cg - 2) : RW_TILE(2) + tl * GP + 32 * (cg - 4);
#pragma unroll
        for (int q = 0; q < 4; ++q) *(LAS v4u*)(dst + 8 * q) = xq[q];
        const int wrow = tid >> 3, wch = tid & 7;
        *(LAS v4u*)(RW_TILE(4) + wrow * TP + 8 * wch) = R.wts[0]; *(LAS v4u*)(RW_TILE(5) + wrow * TP + 8 * wch) = R.wts[1];
        *(LAS v4u*)(RW_TILE(6) + wrow * GP + 8 * wch) = R.wts[2]; *(LAS v4u*)(RW_TILE(6) + wrow * GP + 64 + 8 * wch) = R.wts[3];
    }
    f32x4 prk[2], pgg[2], pgb[2];
#pragma unroll
    for (int nt = 0; nt < 2; ++nt) { const int hc = h * 64 + n0 + 16 * nt;
        prk[nt] = *(const GAS f32x4*)(F.inp(I_RK) + hc); pgg[nt] = *(const GAS f32x4*)(F.inp(I_GNG) + hc); pgb[nt] = *(const GAS f32x4*)(F.inp(I_GNB) + hc); }
    __builtin_amdgcn_sched_barrier(0);
    r1_load(F, unext >= 0 ? unext : u, R);
    RW_BAR();
    if (cut <= 1) { RW_BAR(); return; }
    f32x4 lwa[2], laa[2], ga[2];
    RW_ZERO(lwa); RW_ZERO(laa); RW_ZERO(ga);
    mm<2>(lwa, RW_TILE(0), TP, RW_TILE(4), TP, mt, nh, fr, fq);
    mm<2>(laa, RW_TILE(1), TP, RW_TILE(5), TP, mt, nh, fr, fq);
    mm<4>(ga, RW_TILE(2), GP, RW_TILE(6), GP, mt, nh, fr, fq);
    if (cut <= 2) { if (lwa[0][0] + laa[1][1] + ga[0][2] == 1.2345f) F.MISC[1] = 1; RW_BAR(); return; }
    LAS float* red = (LAS float*)(lds + MISC); LAS float* tot = red + 256; LAS float* gC = tot + 256;
    f32x4 pw0[2], pa0[2], pkk[2], pka[2];
#pragma unroll
    for (int nt = 0; nt < 2; ++nt) { const int hc = h * 64 + n0 + 16 * nt; LAS float* pt = (LAS float*)(lds + PT_OFF);
        pw0[nt] = *(const LAS f32x4*)(pt + PT_W0 + hc); pa0[nt] = *(const LAS f32x4*)(pt + PT_A0 + hc); pkk[nt] = *(const LAS f32x4*)(pt + PT_KK + hc); pka[nt] = *(const LAS f32x4*)((LAS float*)(lds + PTK_OFF) + hc); }
    f32x4 lw[2], a_[2], kk[2], kp[2], g_[2], L[2];
    float ssq = 0.f, bcs = 0.f;
#pragma unroll
    for (int nt = 0; nt < 2; ++nt) {
        const f32x4 zw = pw0[nt] + lwa[nt], za = pa0[nt] + laa[nt];
        f32x4 sw, sa;
#pragma unroll
        for (int e = 0; e < 4; ++e) { sw[e] = sigmoidf_(zw[e]); sa[e] = sigmoidf_(za[e]); }
        lw[nt] = sw * -0.6065306597126334f; a_[nt] = sa;
        kk[nt] = k_[nt] * pkk[nt];
        kp[nt] = k_[nt] * ((sa - 1.0f) * pka[nt] + 1.0f);
        g_[nt] = ga[nt];
    }
    if (samp) {
#pragma unroll
        for (int nt = 0; nt < 2; ++nt)
#pragma unroll
            for (int e = 0; e < 4; ++e) if (!valid) { lw[nt][e] = 0.f; kk[nt][e] = 0.f; kp[nt][e] = 0.f; g_[nt][e] = 0.f; a_[nt][e] = 0.f; r_[nt][e] = 0.f; v_[nt][e] = 0.f; }
    }
#pragma unroll
    for (int nt = 0; nt < 2; ++nt) {
        const f32x4 k2 = kk[nt] * kk[nt], rb = r_[nt] * kp[nt] * prk[nt];
        ssq += (k2[0] + k2[1]) + (k2[2] + k2[3]); bcs += (rb[0] + rb[1]) + (rb[2] + rb[3]);
#pragma unroll
        for (int e = 0; e < 4; ++e) {
            float x = lw[nt][e];
            x += dpp_shr0<0x111>(x); x += dpp_shr0<0x112>(x); x += dpp_shr0<0x114>(x); x += dpp_shr0<0x118>(x);
            L[nt][e] = x;
            if (fr == 15) tot[mt * 64 + n0 + 16 * nt + e] = x;
        }
    }
    ssq += __shfl_xor(ssq, 16); ssq += __shfl_xor(ssq, 32); bcs += __shfl_xor(bcs, 16); bcs += __shfl_xor(bcs, 32);
    if (fq == 0) { red[((mt * 2 + nh) * 16 + fr) * 2] = ssq; red[((mt * 2 + nh) * 16 + fr) * 2 + 1] = bcs; }
    RW_BAR();
    if (cut <= 3) { if (L[0][0] + L[1][3] == 1.2345f) F.MISC[1] = 1; RW_BAR(); return; }
    const float ss = red[((mt * 2 + 0) * 16 + fr) * 2] + red[((mt * 2 + 1) * 16 + fr) * 2], bc = red[((mt * 2 + 0) * 16 + fr) * 2 + 1] + red[((mt * 2 + 1) * 16 + fr) * 2 + 1];
    const float rn = __builtin_amdgcn_rcpf(fmaxf(__builtin_amdgcn_sqrtf(ss), 1e-12f));
    ub16* Gb = (ub16*)(F.ws + WS_G); ub16* E1b = (ub16*)(F.ws + WS_E1);
    f32x4 Rq[2];
#pragma unroll
    for (int nt = 0; nt < 2; ++nt) {
        const int ch = n0 + 16 * nt, hc = h * 64 + ch;
        const f32x4 t0 = *(const LAS f32x4*)(tot + ch), t1 = *(const LAS f32x4*)(tot + 64 + ch), t2 = *(const LAS f32x4*)(tot + 128 + ch), t3 = *(const LAS f32x4*)(tot + 192 + ch);
        f32x4 Gv, Ev, vAc, vRc, vBc, vKc, tA, tB, tK;
        {
#define RW_EX4(X) ({ const f32x4 x_ = (X) * 1.4426950408889634f; (f32x4){__builtin_amdgcn_exp2f(x_[0]), __builtin_amdgcn_exp2f(x_[1]), __builtin_amdgcn_exp2f(x_[2]), __builtin_amdgcn_exp2f(x_[3])}; })
            const f32x4 z4 = (f32x4){0.f, 0.f, 0.f, 0.f};
            const f32x4 off = (mt > 0 ? t0 : z4) + (mt > 1 ? t1 : z4) + (mt > 2 ? t2 : z4);
            const f32x4 Lt = L[nt] + off, Lp = Lt - lw[nt], Lmid = t0 + t1, LC = Lmid + t2 + t3;
            const f32x4 kkn = kk[nt] * rn, bv = kkn * a_[nt];
            Gv = g_[nt] * pgg[nt]; Ev = (pgb[nt] + v_[nt] * bc) * g_[nt];
            vAc = -kkn * RW_EX4(Lp - Lmid); vRc = r_[nt] * RW_EX4(Lt - Lmid);
            const f32x4 em = RW_EX4(Lmid - Lt); vBc = bv * em; vKc = kp[nt] * em;
            const f32x4 ec = RW_EX4(LC - Lt);
            tA = -kkn * RW_EX4(Lp); tB = bv * ec; tK = kp[nt] * ec;
            Rq[nt] = r_[nt] * RW_EX4(Lt);
            if (t == 0) *(LAS f32x4*)(gC + ch) = RW_EX4(LC);
#undef RW_EX4
        }
        {
            const int qi = fr & 3, tq = t & ~3;
            const u32x2 wA = quad_tr(pack4(tA), fr), wB = quad_tr(pack4(tB), fr), wK = quad_tr(pack4(tK), fr), wV = quad_tr(pack4(v_[nt]), fr);
            *(LAS u32x2*)(RW_TILE(4) + (ch + qi) * TP + tq) = wA; *(LAS u32x2*)(RW_TILE(5) + (ch + qi) * TP + tq) = wB;
            *(LAS u32x2*)(RW_TILE(6) + (ch + qi) * TP + tq) = wK; *(LAS u32x2*)(RW_TILE(7) + (ch + qi) * TP + tq) = wV; }
        *(LAS u32x2*)(RW_TILE(0) + t * TP + ch) = pack4(vAc); *(LAS u32x2*)(RW_TILE(1) + t * TP + ch) = pack4(vRc);
        *(LAS u32x2*)(RW_TILE(2) + t * TP + ch) = pack4(vBc); *(LAS u32x2*)(RW_TILE(3) + t * TP + ch) = pack4(vKc);
        if (valid) { *(GAS u32x2*)(Gb + (size_t)(row0 + t) * 512 + hc) = pack4(Gv); *(GAS u32x2*)(E1b + (size_t)(row0 + t) * 512 + hc) = pack4(Ev); }
    }
    RW_BAR();
    if (cut <= 4) { if (Rq[0][0] + Rq[1][3] == 1.2345f) F.MISC[1] = 1; RW_BAR(); return; }
    const int citem = cit + tid;
    const f32x4 cka = *(const GAS f32x4*)(F.inp(I_CK) + (size_t)citem * 8), ckb = *(const GAS f32x4*)(F.inp(I_CK) + (size_t)citem * 8 + 4);
    const int m = 16 * mt + fr;
    f32x4 acc[2];
#define RW_MASK2(A, COND) do { _Pragma("unroll") for (int nt = 0; nt < 2; ++nt) _Pragma("unroll") for (int e = 0; e < 4; ++e) { const int n = n0 + 16 * nt + e; A[nt][e] = (COND) ? A[nt][e] : 0.f; } } while (0)
#define RW_TINIT(A, Ti) do { A[0] = unpack4(*(const LAS u32x2*)(RW_TILE(Ti) + m * TP + n0)); A[1] = unpack4(*(const LAS u32x2*)(RW_TILE(Ti) + m * TP + n0 + 16)); } while (0)
    f32x4 Tacc[2];
    {   FrA a0, a1; FrB b2, b3;
        ldA(a0, RW_TILE(0), mt, fr, fq); ldB(b2, RW_TILE(2), nh, fr, fq); ldB(b3, RW_TILE(3), nh, fr, fq); ldA(a1, RW_TILE(1), mt, fr, fq);
        RW_FENCE();
        f32x4 aN[2], aAK[2], aRB[2], aRK[2], tv[2];
        RW_ZERO(aN); RW_ZERO(aAK); RW_ZERO(aRB); RW_ZERO(aRK);
        mmf(aN, a0, b2); mmf(aAK, a0, b3); mmf(aRB, a1, b2); mmf(aRK, a1, b3);
        RW_MASK2(aN, n < m);
#pragma unroll
        for (int nt = 0; nt < 2; ++nt)
#pragma unroll
            for (int e = 0; e < 4; ++e) tv[nt][e] = aN[nt][e] + ((n0 + 16 * nt + e == m) ? 1.0f : 0.f);
        st_tile(RW_TILE(8), aN, m, n0); st_tile_T(RW_TILE(9), aN, m, n0, fr); st_tile(RW_TILE(13), tv, m, n0); Tacc[0] = tv[0]; Tacc[1] = tv[1];
        RW_MASK2(aAK, n < m); st_tile(RW_TILE(10), aAK, m, n0);
        RW_MASK2(aRB, n <= m); st_tile(RW_TILE(11), aRB, m, n0);
        RW_MASK2(aRK, n <= m); st_tile(RW_TILE(12), aRK, m, n0);
    }
#undef RW_MASK2
    RW_BAR();
    if (cut <= 5) { RW_BAR(); return; }
#define RW_SQTUP(Pi, PTi, Po, PTo, Ti, To) do { FrA aP_, aT_; FrB bPT_; f32x4 rP_[2]; \
        ldA(aP_, RW_TILE(Pi), mt, fr, fq); ldB(bPT_, RW_TILE(PTi), nh, fr, fq); ldA(aT_, RW_TILE(Ti), mt, fr, fq); acc[0] = Tacc[0]; acc[1] = Tacc[1]; \
        RW_FENCE(); RW_ZERO(rP_); \
        mmf(rP_, aP_, bPT_); mmf(acc, aT_, bPT_); \
        Tacc[0] = acc[0]; Tacc[1] = acc[1]; st_tile(RW_TILE(Po), rP_, m, n0); st_tile_T(RW_TILE(PTo), rP_, m, n0, fr); st_tile(RW_TILE(To), acc, m, n0); } while (0)
    {
        FrA a8, a7; FrB b9, b10; f32x4 r2[2];
        ldA(a8, RW_TILE(8), mt, fr, fq); ldB(b9, RW_TILE(9), nh, fr, fq); ldA(a7, RW_TILE(7), mt, fr, fq); ldB(b10, RW_TILE(10), nh, fr, fq);
        RW_FENCE(); RW_ZERO(acc); RW_ZERO(r2);
        mmf(acc, a8, b9); mmf(r2, a7, b10);
        st_tile(RW_TILE(0), acc, m, n0); st_tile_T(RW_TILE(1), acc, m, n0, fr); st_tile(RW_TILE(3), r2, m, n0); }
    RW_BAR();
    RW_SQTUP(0, 1, 8, 9, 13, 2);  RW_BAR();
    RW_SQTUP(8, 9, 0, 1, 2, 13);  RW_BAR();
    RW_SQTUP(0, 1, 8, 9, 13, 2);  RW_BAR();
    {
        FrA a8, a2; FrB b9; f32x4 r1[2];
        ldA(a2, RW_TILE(2), mt, fr, fq); ldB(b9, RW_TILE(9), nh, fr, fq); acc[0] = Tacc[0]; acc[1] = Tacc[1]; ldA(a8, RW_TILE(8), mt, fr, fq);
        RW_FENCE(); RW_ZERO(r1);
        mmf(acc, a2, b9); mmf(r1, a8, b9); Tacc[0] = acc[0]; Tacc[1] = acc[1];
        st_tile(RW_TILE(13), acc, m, n0); st_tile_T(RW_TILE(1), r1, m, n0, fr); }
    RW_BAR();
    {
        FrA a13; FrB b1;
        ldA(a13, RW_TILE(13), mt, fr, fq); ldB(b1, RW_TILE(1), nh, fr, fq); acc[0] = Tacc[0]; acc[1] = Tacc[1];
        RW_FENCE();
        mmf(acc, a13, b1); st_tile(RW_TILE(2), acc, m, n0); }
    RW_BAR();
#undef RW_SQTUP
    {
        FrA a4, a3; FrB b2; f32x4 r1[2];
        ldA(a4, RW_TILE(4), mt, fr, fq); ldB(b2, RW_TILE(2), nh, fr, fq); ldA(a3, RW_TILE(3), mt, fr, fq);
        RW_FENCE(); RW_ZERO(acc); RW_ZERO(r1);
        mmf(acc, a4, b2); mmf(r1, a3, b2);
        st_tile(RW_TILE(0), acc, m, n0); st_tile(RW_TILE(8), r1, m, n0); }
    RW_BAR();
    unsigned char* md = (unsigned char*)F.out + (size_t)u * MD_BYTES;
    {   FrA a5, a11; FrB b0;
        ldA(a5, RW_TILE(5), mt, fr, fq); ldB(b0, RW_TILE(0), nh, fr, fq); ldA(a11, RW_TILE(11), mt, fr, fq);
        FrA a8, a7; FrB b5, b6;
        ldA(a8, RW_TILE(8), mt, fr, fq); ldB(b5, RW_TILE(5), nh, fr, fq); ldA(a7, RW_TILE(7), mt, fr, fq); ldB(b6, RW_TILE(6), nh, fr, fq);
        RW_FENCE();
        f32x4 rM[2], rQ[2];
        RW_ZERO(rM); rQ[0] = Rq[0]; rQ[1] = Rq[1];
        mmf(rM, a5, b0); mmf(rQ, a11, b0);
        RW_ZERO(acc); mmf(acc, a8, b5); mmf(acc, a7, b6);
        RW_FENCE();
        FrA a12; FrB b8, b7;
        ldB(b8, RW_TILE(8), nh, fr, fq); ldA(a12, RW_TILE(12), mt, fr, fq); ldB(b7, RW_TILE(7), nh, fr, fq);
        RW_FENCE();
        ub16* qt = (ub16*)(F.ws + WS_QT) + (size_t)u * (64 * TP);
#pragma unroll
        for (int nt = 0; nt < 2; ++nt) {
#pragma unroll
            for (int e = 0; e < 4; ++e) { const int n = n0 + 16 * nt + e; if (n == m) rM[nt][e] += gC[n]; }
            *(GAS u32x2*)((ub16*)md + m * TP + n0 + 16 * nt) = pack4(rM[nt]);
            *(GAS u32x2*)(qt + m * TP + n0 + 16 * nt) = pack4(rQ[nt]);
            *(GAS f32x4*)((float*)(md + MT_BYTES) + m * 68 + n0 + 16 * nt) = acc[nt]; }
        f32x4 rY[2]; RW_ZERO(rY); mmf(rY, a11, b8); mmf(rY, a12, b7);
        ub16* yl = (ub16*)(F.ws + WS_YL) + (size_t)u * 4096;
#pragma unroll
        for (int nt = 0; nt < 2; ++nt) *(GAS u32x2*)(yl + m * 64 + n0 + 16 * nt) = pack4(rY[nt]); }
#undef RW_TINIT
    {   const int rowi = citem >> 6, ch = citem & 63, cb_ = rowi >> 12, cp_ = rowi & 4095;
        v4u o; o.x = cvtpk(cka[0], cka[1]); o.y = cvtpk(cka[2], cka[3]); o.z = cvtpk(ckb[0], ckb[1]); o.w = cvtpk(ckb[2], ckb[3]);
        *(GAS v4u*)((ub16*)(F.ws + WS_KS) + ((size_t)cb_ * 4224 + cp_) * 512 + ch * 8) = o; }
    RW_BAR();
}

__device__ __forceinline__ void r2_chain(Frame& F, int chain) {
    LAS unsigned char* lds = F.lds;
    int lane = F.lane; asm volatile("" : "+v"(lane));
    const int w = F.wave, tid = w * 64 + lane, fr = lane & 15, fq = lane >> 4;
    const bool samp = chain >= 32; const int nsteps = samp ? 1 : 128; const int u0 = samp ? 4096 + (chain - 32) : chain * 128;
    const unsigned char* rec0 = (const unsigned char*)F.out + (size_t)u0 * MD_BYTES;
    constexpr int NPIECE = MD_BYTES / 16;
    f32x4 S[4];
    {   const int cs = chain - 32;
#pragma unroll
        for (int nt = 0; nt < 4; ++nt) S[nt] = (samp && w < 4) ? *(const GAS f32x4*)(F.inp(I_SWKV) + (size_t)cs * 4096 + (16 * w + fr) * 64 + 16 * nt + 4 * fq) : (f32x4){0.f, 0.f, 0.f, 0.f};
    }
    asm volatile("s_waitcnt vmcnt(0)" ::: "memory");
    v4u q[6][4];
    const unsigned po3 = 16u * (unsigned)(tid + 1536 < NPIECE ? tid + 1536 : NPIECE - 1), po0 = 16u * (unsigned)tid;
#define R2_LOAD(k, step) do { const int st_ = (step) < nsteps ? (step) : nsteps - 1; const unsigned char* rb_ = rec0 + (size_t)st_ * MD_BYTES; \
        q[k][0] = *(const GAS v4u*)(rb_ + po0); q[k][1] = *(const GAS v4u*)(rb_ + 8192 + po0); q[k][2] = *(const GAS v4u*)(rb_ + 16384 + po0); q[k][3] = *(const GAS v4u*)(rb_ + po3); } while (0)
#pragma unroll
    for (int k = 0; k < 6; ++k) R2_LOAD(k, k);
    ub16* S0b = (ub16*)(F.ws + WS_S0);
#define R2_STEP(k, COMPUTE, RELOAD) do { const int c_ = c0 + (k); \
        LAS unsigned char* slot = lds + (c_ & 1) * MD_BYTES; \
        _Pragma("unroll") for (int i_ = 0; i_ < 4; ++i_) { const int p_ = tid + 512 * i_; if (p_ < NPIECE) *(LAS v4u*)(slot + 16 * p_) = q[k][i_]; } \
        if (RELOAD) R2_LOAD(k, c_ + 6); \
        RW_BAR(); \
        if (COMPUTE) { \
              \
              \
            f32x4 d_[4]; u32x2 ma_[4][4]; \
            _Pragma("unroll") for (int nt = 0; nt < 4; ++nt) { \
                d_[nt] = *(const LAS f32x4*)(slot + MT_BYTES + ((16 * w + fr) * 68 + 16 * nt + 4 * fq) * 4); \
                const LAS ub16* mr_ = (const LAS ub16*)slot + (16 * nt + fr) * TP + 4 * fq; \
                ma_[nt][0] = *(const LAS u32x2*)(mr_); ma_[nt][1] = *(const LAS u32x2*)(mr_ + 16); ma_[nt][2] = *(const LAS u32x2*)(mr_ + 32); ma_[nt][3] = *(const LAS u32x2*)(mr_ + 48); } \
            __builtin_amdgcn_sched_barrier(0); \
            ub16* s0 = S0b + (size_t)(u0 + c_) * (64 * TP) + (16 * w + fr) * TP + 4 * fq; \
            const u32x2 p0_ = pack4(S[0]), p1_ = pack4(S[1]), p2_ = pack4(S[2]), p3_ = pack4(S[3]); \
            *(GAS u32x2*)(s0) = p0_; *(GAS u32x2*)(s0 + 16) = p1_; *(GAS u32x2*)(s0 + 32) = p2_; *(GAS u32x2*)(s0 + 48) = p3_; \
            const v4u sa0u_ = {p0_.x, p0_.y, p1_.x, p1_.y}, sa1u_ = {p2_.x, p2_.y, p3_.x, p3_.y}; \
            const bf16x8 sa0 = __builtin_bit_cast(bf16x8, sa0u_), sa1 = __builtin_bit_cast(bf16x8, sa1u_); \
            asm volatile("s_waitcnt lgkmcnt(0)" ::: "memory"); __builtin_amdgcn_sched_barrier(0); \
            _Pragma("unroll") for (int nt = 0; nt < 4; ++nt) { \
                const v4u m0u_ = {ma_[nt][0].x, ma_[nt][0].y, ma_[nt][1].x, ma_[nt][1].y}, m1u_ = {ma_[nt][2].x, ma_[nt][2].y, ma_[nt][3].x, ma_[nt][3].y}; \
                f32x4 acc_ = __builtin_amdgcn_mfma_f32_16x16x32_bf16(__builtin_bit_cast(bf16x8, m0u_), sa0, d_[nt], 0, 0, 0); \
                acc_ = __builtin_amdgcn_mfma_f32_16x16x32_bf16(__builtin_bit_cast(bf16x8, m1u_), sa1, acc_, 0, 0, 0); S[nt] = acc_; } \
        } } while (0)
    const int nfull = (nsteps / 6) * 6;
    if (w < 4) {
        int c0 = 0;
        for (; c0 < nfull; c0 += 6) { R2_STEP(0, true, true); R2_STEP(1, true, true); R2_STEP(2, true, true); R2_STEP(3, true, true); R2_STEP(4, true, true); R2_STEP(5, true, true); }
        if (c0 + 0 < nsteps) R2_STEP(0, true, false); if (c0 + 1 < nsteps) R2_STEP(1, true, false); if (c0 + 2 < nsteps) R2_STEP(2, true, false);
        if (c0 + 3 < nsteps) R2_STEP(3, true, false); if (c0 + 4 < nsteps) R2_STEP(4, true, false);
    } else {
        int c0 = 0;
        for (; c0 < nfull; c0 += 6) { R2_STEP(0, false, true); R2_STEP(1, false, true); R2_STEP(2, false, true); R2_STEP(3, false, true); R2_STEP(4, false, true); R2_STEP(5, false, true); }
        if (c0 + 0 < nsteps) R2_STEP(0, false, false); if (c0 + 1 < nsteps) R2_STEP(1, false, false); if (c0 + 2 < nsteps) R2_STEP(2, false, false);
        if (c0 + 3 < nsteps) R2_STEP(3, false, false); if (c0 + 4 < nsteps) R2_STEP(4, false, false);
    }
#undef R2_STEP
#undef R2_LOAD
    if (w < 4) {
        float* dst = samp ? F.out + O_WKVS + (size_t)(chain - 32) * 4096 : F.out + O_WKVP + (size_t)chain * 4096;
#pragma unroll
        for (int nt = 0; nt < 4; ++nt) *(GAS f32x4*)(dst + (16 * w + fr) * 64 + 16 * nt + 4 * fq) = S[nt];
    }
    RW_BAR();
}

struct R3Raw { v4u qs[5]; u32x2 yl[4], g[4], e[4]; };
__device__ __forceinline__ void r3_load(Frame& F, int uA, int uB, R3Raw& R) {
    const int tid = F.tid, w = F.wave, lane = F.lane, fr = lane & 15, fq = lane >> 4;
#pragma unroll
    for (int i = 0; i < 5; ++i) { const int p = tid + 512 * i, tix = p / (TB / 16), off = (p % (TB / 16)) * 16; const int u = (tix < 2) ? uA : uB;
        const unsigned char* src = F.ws + ((tix & 1) ? WS_S0 : WS_QT) + (size_t)(u < 0 ? uA : u) * TB + off; R.qs[i] = *(const GAS v4u*)src; }
    const int u = (w < 4) ? uA : (uB < 0 ? uA : uB);
    bool samp; int sb, h, c, row0; r1_decode(u, samp, sb, h, c, row0);
    const int t = 16 * (w & 3) + fr;
    const ub16* yl = (const ub16*)(F.ws + WS_YL) + (size_t)u * 4096 + t * 64 + 4 * fq;
    const int rr = (!samp || t < 16) ? row0 + t : row0;
    const ub16* Gb = (const ub16*)(F.ws + WS_G) + (size_t)rr * 512 + h * 64 + 4 * fq; const ub16* Eb = (const ub16*)(F.ws + WS_E1) + (size_t)rr * 512 + h * 64 + 4 * fq;
#pragma unroll
    for (int nt = 0; nt < 4; ++nt) { R.yl[nt] = *(const GAS u32x2*)(yl + 16 * nt); R.g[nt] = *(const GAS u32x2*)(Gb + 16 * nt); R.e[nt] = *(const GAS u32x2*)(Eb + 16 * nt); }
}
__device__ __forceinline__ void r3_pair(Frame& F, int uA, int uB, ub16* YMIX, R3Raw& R, int nA, int nB, bool has_next, int par) {
    LAS unsigned char* lds = F.lds + par * 4 * TB;
    int lane = F.lane; asm volatile("" : "+v"(lane));
    const int w = F.wave, tid = w * 64 + lane, fr = lane & 15, fq = lane >> 4;
#pragma unroll
    for (int i = 0; i < 5; ++i) *(LAS v4u*)(lds + 16 * (tid + 512 * i)) = R.qs[i];
    const int u = (w < 4) ? uA : uB;
    bool samp; int sb, h, c, row0; r1_decode(u < 0 ? uA : u, samp, sb, h, c, row0);
    const int t = 16 * (w & 3) + fr;
    const bool valid = (u >= 0) && (!samp || t < 16);
    f32x4 acc[4], G[4], E[4];
#pragma unroll
    for (int nt = 0; nt < 4; ++nt) { acc[nt] = unpack4(R.yl[nt]); G[nt] = unpack4(R.g[nt]); E[nt] = unpack4(R.e[nt]); }
    if (has_next) r3_load(F, nA, nB, R);
    RW_BAR();
    {   const LAS ub16* Qt = (const LAS ub16*)(lds + (w < 4 ? 0 : 2 * TB)); const LAS ub16* S0 = (const LAS ub16*)(lds + (w < 4 ? TB : 3 * TB));
#pragma unroll
        for (int ks = 0; ks < 2; ++ks) {
            const bf16x8 af = *(const LAS bf16x8*)(Qt + (16 * (w & 3) + fr) * TP + 32 * ks + 8 * fq);
#pragma unroll
            for (int nt = 0; nt < 4; ++nt) { const bf16x8 bfr = *(const LAS bf16x8*)(S0 + (16 * nt + fr) * TP + 32 * ks + 8 * fq);
                acc[nt] = __builtin_amdgcn_mfma_f32_16x16x32_bf16(bfr, af, acc[nt], 0, 0, 0); }
        }
    }
    float s1 = 0.f, s2 = 0.f;
#pragma unroll
    for (int nt = 0; nt < 4; ++nt)
#pragma unroll
        for (int e = 0; e < 4; ++e) { s1 += acc[nt][e]; s2 += acc[nt][e] * acc[nt][e]; }
    s1 += __shfl_xor(s1, 16); s1 += __shfl_xor(s1, 32); s2 += __shfl_xor(s2, 16); s2 += __shfl_xor(s2, 32);
    const float mean = s1 * (1.0f / 64.0f), var = fmaxf(s2 * (1.0f / 64.0f) - mean * mean, 0.f), rstd = 1.0f / sqrtf(var + 64e-5f);
    if (valid) {
#pragma unroll
        for (int nt = 0; nt < 4; ++nt) { const f32x4 y = (acc[nt] - mean) * rstd * G[nt] + E[nt];
            *(GAS u32x2*)(YMIX + (size_t)(row0 + t) * DM + h * 64 + 4 * fq + 16 * nt) = pack4(y); }
    }
}
#undef RW_TILE
}

constexpr size_t WS_O0 = WS_PRW, WS_O1 = WS_PRW + 32 * MiB, WS_OS0 = WS_PRW + 64 * MiB, WS_OS1 = WS_PRW + 66 * MiB;
constexpr size_t WS_YMIX = WS_QB;
static_assert(WS_OS1 + 2 * MiB <= WS_QB && WS_YMIX + (size_t)MPAD * 1024 * 2 <= WS_QS, "ws overlays");
constexpr int Q_ITEMS = 12 + 128 + 16 + 128;
constexpr int CW_QHEAD = 1024;
__device__ __forceinline__ void attn_item(Frame& F, char* ldsg, int g, int a) {
    using attn_body::bf16;
    if (a >= 128 && a < 144) {
        const int idx = a - 128, vh = idx & 1, c = (idx >> 1) & 1, h = (idx >> 2) & 3, b = g;
        const bf16* Qs = (const bf16*)(F.ws + WS_QS); const bf16* Ks = (const bf16*)(F.ws + WS_KS); const bf16* Vs = (const bf16*)(F.ws + WS_VS);
        bf16* Os = (bf16*)(F.ws + (c ? WS_OS1 : WS_OS0));
        attn_body::attn_unit<8>(Qs + (size_t)b * 256 * 512 + h * 128 + c * 64, Ks + (size_t)b * 4224 * 512 + h * 128 + c * 64, Vs + (size_t)b * 4224 * 512 + h * 128 + vh * 64,
                                Os + (size_t)b * 256 * 512 + h * 128 + vh * 64, 66, 1, ldsg);
        return;
    }
    const int a2 = a < 128 ? a : a - 16, qb = 31 - (a2 >> 3), pr = 8 * g + (a2 & 7);
    const int vh = pr & 1, c = (pr >> 1) & 1, bh = pr >> 2, b = bh >> 2, h = bh & 3;
    const bf16* Qb = (const bf16*)(F.ws + WS_QB); const bf16* Kb = (const bf16*)(F.ws + WS_KB); const bf16* Vb = (const bf16*)(F.ws + WS_VB);
    bf16* Ob = (bf16*)(F.ws + (c ? WS_O1 : WS_O0));
    const size_t rq = (size_t)b * 8192 + (size_t)qb * 256, rk = (size_t)b * 8192;
    attn_body::attn_unit<8>(Qb + rq * 512 + h * 128 + c * 64, Kb + rk * 512 + h * 128 + c * 64, Vb + rk * 512 + h * 128 + vh * 64, Ob + rq * 512 + h * 128 + vh * 64, 4 * qb + 4, 0, ldsg);
}
constexpr int Q_ITEMS2 = 12 + 64 + 8 + 64;
__device__ __forceinline__ void attn_item2(Frame& F, char* ldsg, int g, int a, int ocsel = -1, int kmask = -1) {
    using attn2::bf16;
    if (a >= 64 && a < 72) {
        const int idx = a - 64, c = idx & 1, h = idx >> 1, b = g, oc = ocsel >= 0 ? ocsel : c;
        const bf16* Qs = (const bf16*)(F.ws + WS_QS); const bf16* Ks = (const bf16*)(F.ws + WS_KS); const bf16* Vs = (const bf16*)(F.ws + WS_VS);
        bf16* Os = (bf16*)(F.ws + (oc ? WS_OS1 : WS_OS0));
        attn2::unit(Qs + (size_t)b * 256 * 512 + h * 128 + c * 64, Ks + (size_t)b * 4224 * 512 + h * 128 + c * 64, Vs + (size_t)b * 4224 * 512 + h * 128, Os + (size_t)b * 256 * 512 + h * 128, 66, 1, ldsg);
        return;
    }
    const int a2 = a < 64 ? a : a - 8, qb = 31 - (a2 >> 2), combo = a2 & 3, bh = 2 * g + (combo >> 1), c = combo & 1, b = bh >> 2, h = bh & 3, oc = ocsel >= 0 ? ocsel : c;
    const bf16* Qb = (const bf16*)(F.ws + WS_QB); const bf16* Kb = (const bf16*)(F.ws + WS_KB); const bf16* Vb = (const bf16*)(F.ws + WS_VB);
    bf16* Ob = (bf16*)(F.ws + (oc ? WS_O1 : WS_O0));
    const size_t rq = (size_t)b * 8192 + (size_t)qb * 256, rk = (size_t)b * 8192;
    attn2::unit(Qb + rq * 512 + h * 128 + c * 64, Kb + rk * 512 + h * 128 + c * 64, Vb + rk * 512 + h * 128, Ob + rq * 512 + h * 128, 4 * qb + 4, 0, ldsg);
}
__device__ __forceinline__ void phase3_queue(Frame& F, char* ldsg, int li) {
    const int g = F.vcu >> 5;
    gu32* head = F.ctl + CW_QHEAD + 64 * g;
    if (F.tid == 0) F.MISC[0] = __hip_atomic_fetch_add(head, 1u, __ATOMIC_RELAXED, __HIP_MEMORY_SCOPE_AGENT);
    __syncthreads();
    int it = (int)F.MISC[0];
    __syncthreads();
    while (it < Q_ITEMS2) {
        unsigned nxt = 0u;
        if (F.tid == 0) nxt = __hip_atomic_fetch_add(head, 1u, __ATOMIC_RELAXED, __HIP_MEMORY_SCOPE_AGENT);
        if (it < 4) rw::r2_chain(F, 4 * g + it);
        else if (it < 12) rw::r2_chain(F, 32 + 8 * g + (it - 4));
#ifdef DBG_R2_ONLY_IN_DUP
        else if (li == 0) attn_item2(F, ldsg, g, it - 12);
#else
        else attn_item2(F, ldsg, g, it - 12);
#endif
        if (F.tid == 0) F.MISC[0] = nxt;
        __syncthreads();
        it = (int)F.MISC[0];
        __syncthreads();
    }
}

__device__ __forceinline__ void combine_rows(Frame& F) {
    const int gw = F.vcu * NWAVES + F.wave, NGW = F.G * NWAVES, lane = F.lane;
    float d1 = F.inp(I_LQ1)[lane] * F.inp(I_LK1)[lane], d2 = F.inp(I_LQ2)[lane] * F.inp(I_LK2)[lane];
    d1 = wave_sum(d1); d2 = wave_sum(d2);
    const float lam = __expf(d1) - __expf(d2) + 0.2f;
    const f32x4 g0 = *(const GAS f32x4*)(F.inp(I_SUBG) + (lane & 15) * 8), g1 = *(const GAS f32x4*)(F.inp(I_SUBG) + (lane & 15) * 8 + 4);
    bf16* YMIX = (bf16*)(F.ws + WS_YMIX);
    for (int r0 = gw; r0 < MV; r0 += 2 * NGW) {
        v4u a[2], b[2];
#pragma unroll
        for (int q = 0; q < 2; ++q) { const int r = r0 + q * NGW; if (r < MV) {
            const bf16 *o0, *o1;
            if (r < MP) { o0 = (const bf16*)(F.ws + WS_O0) + (size_t)r * 512; o1 = (const bf16*)(F.ws + WS_O1) + (size_t)r * 512; }
            else { const int rs = r - MP; const size_t ro = ((size_t)(rs >> 4) * 256 + (rs & 15)) * 512; o0 = (const bf16*)(F.ws + WS_OS0) + ro; o1 = (const bf16*)(F.ws + WS_OS1) + ro; }
            a[q] = *(const GAS v4u*)(o0 + lane * 8); b[q] = *(const GAS v4u*)(o1 + lane * 8); } }
#pragma unroll
        for (int q = 0; q < 2; ++q) { const int r = r0 + q * NGW; if (r < MV) {
            float d[8];
            d[0] = rw::bflo(a[q].x) - lam * rw::bflo(b[q].x); d[1] = rw::bfhi(a[q].x) - lam * rw::bfhi(b[q].x); d[2] = rw::bflo(a[q].y) - lam * rw::bflo(b[q].y); d[3] = rw::bfhi(a[q].y) - lam * rw::bfhi(b[q].y);
            d[4] = rw::bflo(a[q].z) - lam * rw::bflo(b[q].z); d[5] = rw::bfhi(a[q].z) - lam * rw::bfhi(b[q].z); d[6] = rw::bflo(a[q].w) - lam * rw::bflo(b[q].w); d[7] = rw::bfhi(a[q].w) - lam * rw::bfhi(b[q].w);
            float ss = 0.f;
#pragma unroll
            for (int e = 0; e < 8; ++e) ss += d[e] * d[e];
            ss += __shfl_xor(ss, 1); ss += __shfl_xor(ss, 2); ss += __shfl_xor(ss, 4); ss += __shfl_xor(ss, 8);
            const float sc = 0.8f / sqrtf(ss * (1.0f / 128.0f) + 1e-6f);
            v4u o; o.x = rw::cvtpk(d[0] * sc * g0[0], d[1] * sc * g0[1]); o.y = rw::cvtpk(d[2] * sc * g0[2], d[3] * sc * g0[3]); o.z = rw::cvtpk(d[4] * sc * g1[0], d[5] * sc * g1[1]); o.w = rw::cvtpk(d[6] * sc * g1[2], d[7] * sc * g1[3]);
            *(GAS v4u*)(YMIX + (size_t)r * DM + 512 + lane * 8) = o; } }
    }
    { const float* xs = F.inp(I_XS); for (int i = gw * 64 + lane; i < MS * DM / 4; i += NGW * 64) *(GAS f32x4*)(F.out + (size_t)MP * DM + 4 * (size_t)i) = *(const GAS f32x4*)(xs + 4 * (size_t)i); }
    for (int r = MV + gw; r < MPAD; r += NGW) { GAS v4u* o = (GAS v4u*)(YMIX + (size_t)r * DM) + lane; o[0] = (v4u){0u, 0u, 0u, 0u}; o[64] = (v4u){0u, 0u, 0u, 0u}; }
}

constexpr size_t WS_HRAW = 95 * MiB, WS_HS = 108 * MiB, WS_ACT = 274 * MiB;
static_assert(WS_HRAW + (size_t)129 * 4 * FF2 * 4 <= WS_HS && WS_ACT + (size_t)MPAD * FF * 2 <= WS_END, "ffn ws map");
__device__ __forceinline__ void h2_rows(Frame& F) {
    const int gw = F.vcu * NWAVES + F.wave, NGW = F.G * NWAVES;
    bf16* H2 = (bf16*)(F.ws + WS_XN);
    int m = gw;
    for (; m + NGW < MV; m += 2 * NGW) rms_row2_to_bf16(F.lane, F.out + (size_t)m * DM, H2 + (size_t)m * DM, F.out + (size_t)(m + NGW) * DM, H2 + (size_t)(m + NGW) * DM);
    for (; m < MPAD; m += NGW) {
        if (m < MV) rms_row_to_bf16(F.lane, F.out + (size_t)m * DM, H2 + (size_t)m * DM);
        else { GAS v4u* o = (GAS v4u*)(H2 + (size_t)m * DM) + F.lane; o[0] = (v4u){0u, 0u, 0u, 0u}; o[64] = (v4u){0u, 0u, 0u, 0u}; }
    }
}
__device__ __forceinline__ void conv_fixup(Frame& F) {
    const int gt = (F.vcu * NWAVES + F.wave) * 64 + F.lane, NGT = F.G * NWAVES * 64;
    const float* Hraw = (const float*)(F.ws + WS_HRAW); const float* Hs = (const float*)(F.ws + WS_HS); bf16* ACT = (bf16*)(F.ws + WS_ACT);
    const float* cw = F.inp(I_CW); const float* cb = F.inp(I_CB);
    for (int it = gt; it < 136 * 352; it += NGT) {
        const int pr = it / 352, jc = it % 352, j = jc * 8, pc = 256 * (j >> 7) + (j & 127);
        const float *r0g, *r1g, *r2g, *r3g; int o0, o1, orow0; bool phys0, phys1;
        if (pr < 128) { const int pm = pr; if (pm == 0 || (pm & 31) == 0) continue;
            r0g = Hraw + ((size_t)(pm - 1) * 4 + 2) * FF2; r1g = Hraw + ((size_t)(pm - 1) * 4 + 3) * FF2; r2g = Hraw + ((size_t)pm * 4 + 0) * FF2; r3g = Hraw + ((size_t)pm * 4 + 1) * FF2; phys0 = true; phys1 = true; orow0 = pm * 256; }
        else { const int b = pr - 128; r0g = F.inp(I_SFC) + ((size_t)b * 2 + 0) * FF2; r1g = F.inp(I_SFC) + ((size_t)b * 2 + 1) * FF2; r2g = Hs + ((size_t)b * 2 + 0) * FF2; r3g = Hs + ((size_t)b * 2 + 1) * FF2; phys0 = false; phys1 = false; orow0 = MP + 16 * b; }
        o0 = phys0 ? pc : j; o1 = phys1 ? pc : j;
        const int up0 = phys0 ? 128 : FF, up1 = phys1 ? 128 : FF;
        float a0[8], a1[8];
#pragma unroll
        for (int e = 0; e < 8; ++e) {
            const float g0 = r0g[o0 + e], g1 = r1g[o1 + e], g2 = r2g[pc + e], g3 = r3g[pc + e];
            const float u0 = r0g[o0 + up0 + e], u1 = r1g[o1 + up1 + e], u2 = r2g[pc + 128 + e], u3 = r3g[pc + 128 + e];
            const float wg0 = cw[j + e], wg1 = cw[FF2 + j + e], wg2 = cw[2 * FF2 + j + e], bg = cb[j + e];
            const float wu0 = cw[FF + j + e], wu1 = cw[FF2 + FF + j + e], wu2 = cw[2 * FF2 + FF + j + e], bu = cb[FF + j + e];
            const float xg0 = bg + wg0 * g0 + wg1 * g1 + wg2 * g2, xu0 = bu + wu0 * u0 + wu1 * u1 + wu2 * u2;
            const float xg1 = bg + wg0 * g1 + wg1 * g2 + wg2 * g3, xu1 = bu + wu0 * u1 + wu1 * u2 + wu2 * u3;
            a0[e] = xg0 / (1.0f + __expf(-xg0)) * xu0; a1[e] = xg1 / (1.0f + __expf(-xg1)) * xu1;
        }
        v4u w0, w1; w0.x = rw::cvtpk(a0[0], a0[1]); w0.y = rw::cvtpk(a0[2], a0[3]); w0.z = rw::cvtpk(a0[4], a0[5]); w0.w = rw::cvtpk(a0[6], a0[7]);
        w1.x = rw::cvtpk(a1[0], a1[1]); w1.y = rw::cvtpk(a1[2], a1[3]); w1.z = rw::cvtpk(a1[4], a1[5]); w1.w = rw::cvtpk(a1[6], a1[7]);
        *(GAS v4u*)(ACT + (size_t)orow0 * FF + j) = w0; *(GAS v4u*)(ACT + (size_t)(orow0 + 1) * FF + j) = w1;
    }
    for (int it = gt; it < (MPAD - MV) * 352; it += NGT) { const int r = MV + it / 352, jc = it % 352; *(GAS v4u*)(ACT + (size_t)r * FF + jc * 8) = (v4u){0u, 0u, 0u, 0u}; }
}

template <int NB, int KB>
__device__ __forceinline__ void skinny_gemm(Frame& F, const bf16* A, int lda, const bf16* Wt, int K) {
    const int n0 = 16 * (F.vcu >> 2), kq = (F.vcu & 3) * (K >> 2), w = F.wave, fr = F.lane & 15, fq = F.lane >> 4;
    const bf16* ap = A + (size_t)(MP + 16 * w + fr) * lda + kq + 8 * fq; const bf16* bp = Wt + (size_t)(n0 + fr) * K + kq + 8 * fq;
    f32x4 acc0 = (f32x4){0.f, 0.f, 0.f, 0.f}, acc1 = (f32x4){0.f, 0.f, 0.f, 0.f};
#pragma unroll
    for (int b = 0; b < NB; ++b) {
        bf16x8 af[KB], bfr[KB];
#pragma unroll
        for (int i = 0; i < KB; ++i) { af[i] = *(const GAS bf16x8*)(ap + (b * KB + i) * 32); bfr[i] = *(const GAS bf16x8*)(bp + (b * KB + i) * 32); }
#pragma unroll
        for (int i = 0; i < KB; ++i) { if (i & 1) acc1 = __builtin_amdgcn_mfma_f32_16x16x32_bf16(bfr[i], af[i], acc1, 0, 0, 0); else acc0 = __builtin_amdgcn_mfma_f32_16x16x32_bf16(bfr[i], af[i], acc0, 0, 0, 0); }
    }
    const f32x4 acc = acc0 + acc1;
    float* o = F.out + (size_t)(MP + 16 * w + fr) * DM + n0 + 4 * fq;
#pragma unroll
    for (int e = 0; e < 4; ++e) atomicAdd(o + e, acc[e]);
}
#ifdef DBG_ATTN_CMP
__device__ __forceinline__ void dbg_attn_cmp(Frame& F, char* ldsg) {
    const int g = F.vcu >> 5, s = F.vcu & 31;
    for (int a = s; a < 272; a += 32) {
        const bool samp = a >= 128 && a < 144; int c;
        if (samp) c = ((a - 128) >> 1) & 1; else { const int a2 = a < 128 ? a : a - 16; c = ((8 * g + (a2 & 7)) >> 1) & 1; }
        if (c == 0) attn_item(F, ldsg, g, a);
    }
    for (int a = s; a < 136; a += 32) {
        const bool samp = a >= 64 && a < 72; int c;
        if (samp) c = (a - 64) & 1; else { const int a2 = a < 64 ? a : a - 8; c = a2 & 1; }
        if (c == 0) attn_item2(F, ldsg, g, a, 1);
    }
}
__device__ __forceinline__ void dbg_attn_report(Frame& F) {
    const int gt = (F.vcu * NWAVES + F.wave) * 64 + F.lane, NGT = F.G * NWAVES * 64;
    const bf16* o0 = (const bf16*)(F.ws + WS_O0); const bf16* o1 = (const bf16*)(F.ws + WS_O1); float e = 0.f;
    for (int i = gt; i < MP * 512; i += NGT) e = fmaxf(e, fabsf(__uint_as_float((unsigned)o0[i] << 16) - __uint_as_float((unsigned)o1[i] << 16)));
    const bf16* s0 = (const bf16*)(F.ws + WS_OS0); const bf16* s1 = (const bf16*)(F.ws + WS_OS1);
    for (int i = gt; i < 8 * 16 * 512; i += NGT) { const int b = i / (16 * 512), r = (i / 512) & 15, cc = i & 511; const size_t o = ((size_t)b * 256 + r) * 512 + cc;
        e = fmaxf(e, fabsf(__uint_as_float((unsigned)s0[o] << 16) - __uint_as_float((unsigned)s1[o] << 16))); }
    if (!(e == e)) e = 9.0f;
    atomicMax((unsigned*)(F.ctl + 10), __float_as_uint(e));
}
#endif

#ifndef MK_SP2
#define MK_SP2 true
#endif
#ifndef MK_PH_HI
#define MK_PH_HI 99
#endif
struct Args { const float* in[33]; float* out; unsigned char* ws; int ph_lo, ph_hi, li, pad; };
__global__ void __launch_bounds__(NWAVES * 64, 2) hymba_fwd(Args args) {
    extern __shared__ __attribute__((aligned(16))) unsigned char lds[];
    Frame F;
    F.lds = (LAS unsigned char*)lds;
    F.MISC = (volatile LAS unsigned*)(F.lds + MISC_OFF);
    F.tid = threadIdx.x; F.lane = F.tid & 63; F.wave = __builtin_amdgcn_readfirstlane(F.tid >> 6);
    F.G = gridDim.x; { const int bx = blockIdx.x; F.vcu = (F.G % 8 == 0) ? (bx % 8) * (F.G / 8) + bx / 8 : bx; }
    F.ws = args.ws; F.out = args.out; F.ctl = (gu32*)(args.ws + WS_CTL);
    for (int u = F.tid; u < (LDS_BYTES - LDSCTL_OFF) / 4; u += NWAVES * 64) ((LAS unsigned*)(F.lds + LDSCTL_OFF))[u] = 0u;
    __syncthreads();
    XcdBarrier bar = xcd_barrier_post((unsigned*)(F.ctl + CW_BAR), F.MISC + 8);
    const int lo = args.ph_lo, hi = args.ph_hi;
#define IN(k) (lo <= (k) && (k) < hi)
#define GRID_BAR() xcd_barrier(bar)

    if (IN(0)) { p0_urgent(F); cache_convert(F, F.vcu, F.G, F.G == 256 ? CACHE_ITEMS / 2 : 0, CACHE_SPLIT); GRID_BAR(); }

    if (IN(1)) {
        pg8::Gemm g{(const bf16*)(F.ws + WS_XN), (const bf16*)(F.ws + WS_WIN), MPAD, INDIM, 1024}; pg8::StaticOrder S; S.init(MPAD, INDIM, F.G, (int)blockIdx.x);
        pg8::EpiInProj E{(bf16*)(F.ws + WS_PRW), (bf16*)(F.ws + WS_QB), (bf16*)(F.ws + WS_KB), (bf16*)(F.ws + WS_VB), (bf16*)(F.ws + WS_QS), (bf16*)(F.ws + WS_KS), (bf16*)(F.ws + WS_VS),
                         F.out, F.inp(I_QG), F.inp(I_KG), (const float*)(F.ws + WS_ROPE)};
        pg8::gemm_phase<pg8::EpiInProj, pg8::StaticOrder, true, MK_SP2>(F.lds + RING_OFF, g, S, E);
        {
            const int rem = ((MPAD / 256) * (INDIM / 256)) % F.G;
            if (rem == 0) cache_convert(F, (int)blockIdx.x, F.G, CACHE_SPLIT, CACHE_ITEMS); else if ((int)blockIdx.x >= rem) cache_convert(F, (int)blockIdx.x - rem, F.G - rem, CACHE_SPLIT, CACHE_ITEMS);
        }
        GRID_BAR();
    }
    if (IN(2)) {
        constexpr int R1_FULL = rw::NUNIT % 256;
        {   rw::R1Raw R; v4u xq[4];
            const int nq = (512 - F.vcu + F.G - 1) / F.G, nsamp = (F.vcu < 64 && F.G == 256) ? 1 : 0;
            const int ntot = 8 * nq + nsamp;
            auto unit_of = [&](int k) -> int { if (k < 8 * nq) { const int q = F.vcu + (k >> 3) * F.G, h = k & 7; return ((q >> 7) * 8 + h) * 128 + (q & 127); } return 4096 + F.vcu; };
            if (ntot > 0) rw::r1_load(F, unit_of(0), R);
            rw::r1_param_table(F);
            for (int k = 0; k < ntot; ++k) {
                const int u = unit_of(k);
                if ((k & 7) == 0) { bool samp; int sb, h, c, row0; rw::r1_decode(u, samp, sb, h, c, row0); rw::lora_inputs(F, samp, sb, c, row0, xq); }
                rw::r1_unit(F, u, R, k + 1 < ntot ? unit_of(k + 1) : -1, xq, (args.li == 0) ? DBG_R1_CUT : 99, (F.vcu * 16 + (k < 16 ? k : 15)) * 512);
            }
            if (F.G != 256) for (int us = F.vcu; us < 64; us += F.G) { const int u = 4096 + us; bool samp; int sb, h, c, row0; rw::r1_decode(u, samp, sb, h, c, row0); rw::lora_inputs(F, samp, sb, c, row0, xq); rw::r1_load(F, u, R); rw::r1_unit(F, u, R, -1, xq); }
        }
        if (F.G == 256 && F.vcu >= R1_FULL) p0_deferred(F, F.vcu - R1_FULL, 256 - R1_FULL); else if (F.G != 256) p0_deferred(F, F.vcu, F.G);
        GRID_BAR();
    }
    if (IN(3)) {
#ifdef DBG_ATTN_CMP
        dbg_attn_cmp(F, (char*)lds + RING_OFF); GRID_BAR(); dbg_attn_report(F); GRID_BAR();
        { const float v_ = 1e4f * __uint_as_float(__hip_atomic_load((unsigned*)(F.ctl + 10), __ATOMIC_RELAXED, __HIP_MEMORY_SCOPE_AGENT)); const size_t gt_ = (size_t)(F.vcu * NWAVES + F.wave) * 64 + F.lane; if (gt_ < 7168) F.out[O_SHP + gt_] = v_; }
#else
        phase3_queue(F, (char*)lds + RING_OFF, args.li);
#endif
        GRID_BAR();
    }
    if (IN(4)) {
        {
            rw::R3Raw R; const int n = (rw::NUNIT - F.vcu + F.G - 1) / F.G; int par = 0;
            auto uof = [&](int k) -> int { return k < n ? F.vcu + k * F.G : -1; };
            if (n > 0) rw::r3_load(F, uof(0), uof(1), R);
            for (int k = 0; k < n; k += 2, par ^= 1) rw::r3_pair(F, uof(k), uof(k + 1), (rw::ub16*)(F.ws + WS_YMIX), R, uof(k + 2), uof(k + 3), k + 2 < n, par);
            __syncthreads();
        }
        combine_rows(F);
        GRID_BAR();
    }
    if (IN(5)) {
        skinny_gemm<1, 8>(F, (const bf16*)(F.ws + WS_YMIX), DM, (const bf16*)(F.ws + WS_WOUT), 1024);
        pg8::Gemm g{(const bf16*)(F.ws + WS_YMIX), (const bf16*)(F.ws + WS_WOUT), MP, 1024, 1024}; pg8::StaticOrder S; S.init(MP, 1024, F.G, (int)blockIdx.x);
        pg8::EpiResid E{F.inp(I_XP), F.inp(I_XS), F.out};
        pg8::gemm_phase<pg8::EpiResid, pg8::StaticOrder, true, MK_SP2>(F.lds + RING_OFF, g, S, E);
        GRID_BAR();
    }
    if (IN(6)) { h2_rows(F); GRID_BAR(); }
    if (IN(7)) {
        pg8::Gemm g{(const bf16*)(F.ws + WS_XN), (const bf16*)(F.ws + WS_WUP), MPAD, FF2, 1024};
        pg8::EpiUpConv E{(bf16*)(F.ws + WS_ACT), F.out, (float*)(F.ws + WS_HRAW), (float*)(F.ws + WS_HS), F.inp(I_CW), F.inp(I_CB), (LAS float*)(F.lds + RING_BYTES)};
        { pg8::RowTileOrder S1{MP / 256, FF2 / 256, (int)blockIdx.x}; pg8::gemm_phase<pg8::EpiUpConv, pg8::RowTileOrder, true, MK_SP2, true>(F.lds + RING_OFF, g, S1, E); }
        pg8::StaticOrder S; S.init(MP, FF2, F.G, (int)blockIdx.x);
        pg8::gemm_phase<pg8::EpiUpConv, pg8::StaticOrder, true, MK_SP2>(F.lds + RING_OFF, g, S, E);
        GRID_BAR();
    }
    if (IN(8)) { conv_fixup(F); GRID_BAR(); }
#ifdef DBG_CHECK_ACT
    dbg_check_act(F);
#endif
    if (IN(11)) {
        skinny_gemm<2, 11>(F, (const bf16*)(F.ws + WS_ACT), FF, (const bf16*)(F.ws + WS_WDN), FF);
        pg8::Gemm g{(const bf16*)(F.ws + WS_ACT), (const bf16*)(F.ws + WS_WDN), MP, 1024, FF}; pg8::StaticOrder S; S.init(MP, 1024, F.G, (int)blockIdx.x);
        pg8::EpiAccum E{F.out};
        pg8::gemm_phase<pg8::EpiAccum, pg8::StaticOrder, true, MK_SP2>(F.lds + RING_OFF, g, S, E);
    }
#ifdef PHASES_REST_DEFINED
    PHASES_REST
#endif
#undef IN
}

extern "C" void kernel_launch(void* const* d_in, const int* in_sizes, int n_in, void* d_out, int out_size, void* d_ws, size_t ws_size, hipStream_t stream) {
    static int grid = 0;
    if (grid == 0) {
        if (n_in != 33 || in_sizes[0] != MP * DM || (size_t)out_size != pg8::O_END || ws_size < WS_END) {
            fprintf(stderr, "kernel_launch: unexpected problem: n_in %d in0 %d out %d ws %zu (need %zu)\n", n_in, n_in > 0 ? in_sizes[0] : -1, out_size, ws_size, (size_t)WS_END); grid = -1; return; }
        int dev = 0, cus = 0, per_cu = 0;
        if (hipGetDevice(&dev) != hipSuccess || hipDeviceGetAttribute(&cus, hipDeviceAttributeMultiprocessorCount, dev) != hipSuccess) { fprintf(stderr, "kernel_launch: device query failed\n"); grid = -1; return; }
        if (hipFuncSetAttribute((const void*)hymba_fwd, hipFuncAttributeMaxDynamicSharedMemorySize, LDS_BYTES) != hipSuccess) { fprintf(stderr, "kernel_launch: hipFuncSetAttribute failed\n"); grid = -1; return; }
        if (hipOccupancyMaxActiveBlocksPerMultiprocessor(&per_cu, (const void*)hymba_fwd, NWAVES * 64, LDS_BYTES) != hipSuccess || per_cu < 1) { fprintf(stderr, "kernel_launch: occupancy query says %d blocks per CU\n", per_cu); per_cu = 1; }
        (void)hipGetLastError();
        grid = cus;
        fprintf(stderr, "kernel_launch: grid %d (per_cu %d)\n", grid, per_cu);
    }
    if (grid < 0) return;
    Args a{};
    for (int i = 0; i < 33; ++i) a.in[i] = (const float*)d_in[i];
    a.out = (float*)d_out; a.ws = (unsigned char*)d_ws; a.li = 0; a.pad = 0;
#ifdef TIME_PH
    const int nl = 2; const int los[2] = {0, TIME_PH}, his[2] = {TIME_PH + 1, MK_PH_HI};
#else
    const int nl = 1; const int los[1] = {0}, his[1] = {MK_PH_HI};
#endif
    for (int li = 0; li < nl; ++li) {
        if (hipMemsetAsync((char*)d_ws + WS_CTL, 0, CTL_ZERO_BYTES, stream) != hipSuccess) { fprintf(stderr, "kernel_launch: memset failed\n"); return; }
        a.ph_lo = los[li]; a.ph_hi = his[li]; a.li = li;
        void* kargs[] = {&a};
        hipError_t e = hipLaunchCooperativeKernel((const void*)hymba_fwd, dim3(grid), dim3(NWAVES * 64), kargs, LDS_BYTES, stream);
        if (e != hipSuccess) fprintf(stderr, "kernel_launch: cooperative launch failed: %s (grid %d)\n", hipGetErrorString(e), grid);
    }
}
```
